# Optimizing an MI355X kernel written in HIP

```python
import math
import jax, jax.numpy as jnp
from jax import lax
import numpy as np


D_MODEL = 1024
BATCH = 8
SEQ = 2048
DEPTH = 1
DEC_BATCH = 32
DEC_SEQ = 8
PAST_LEN = 16384
PAGE_SIZE = 128

D_LRU = D_MODEL
N_LRU_BLOCKS = 8
LRU_BLOCK = D_LRU // N_LRU_BLOCKS
CONV_WIDTH = 4
LRU_C = 8.0
HEAD_DIM = 128
HEADS_PER_GROUP = 4
WINDOWS = (128, 512, 2048)
DILATIONS = (1, 4, 16)
N_GROUPS = 3
N_ATTN_HEADS = N_GROUPS * HEADS_PER_GROUP
N_BACK = 128
N_SLOTS = N_BACK + 1
BLK = 128
D_QKV = N_ATTN_HEADS * HEAD_DIM
D_ATTN_OUT = HEADS_PER_GROUP * HEAD_DIM
ATTN_SCALE = HEAD_DIM ** -0.5
N_BUCKETS = 32
MAX_DISTANCE = 2048
NORM_EPS = 1e-6
D_IN = 2 * D_LRU + 3 * D_QKV + D_ATTN_OUT + 2 * D_MODEL

kernel_name = 'hybrid_rglru_dilated_swa_decode_step'


def rms_norm(x, g):
    xf = x.astype(jnp.float32)
    y = xf * lax.rsqrt(jnp.mean(xf * xf, axis=-1, keepdims=True) + NORM_EPS)
    return (y * g.astype(jnp.float32)).astype(x.dtype)


def t5_bucket(dist):
    max_exact = N_BUCKETS // 2
    df = jnp.maximum(dist, 1).astype(jnp.float32)
    large = max_exact + (jnp.log(df / max_exact) / math.log(MAX_DISTANCE / max_exact)
                         * (N_BUCKETS - max_exact)).astype(jnp.int32)
    return jnp.where(dist < max_exact, dist, jnp.minimum(large, N_BUCKETS - 1))


def slot_bias(rel_bias, g):
    dist = jnp.arange(N_SLOTS, dtype=jnp.int32) * DILATIONS[g]
    return rel_bias[t5_bucket(dist), g * HEADS_PER_GROUP:(g + 1) * HEADS_PER_GROUP].astype(jnp.float32)


def softmax_stats(s, valid):
    s = jnp.where(valid, s, -jnp.inf)
    m = jnp.max(s, axis=-1, keepdims=True)
    p = jnp.exp(s - m)
    den = jnp.sum(p, axis=-1, keepdims=True)
    return p / den, (m + jnp.log(den))[..., 0]


def dilated_group_prompt(q, k, v, bias, dil):
    B, S, H, HD = q.shape
    span = dil * BLK
    s_pad = -(-S // span) * span
    m_len = s_pad // dil
    n_blk = m_len // BLK

    def classes(t):
        t = jnp.pad(t, ((0, 0), (0, s_pad - S), (0, 0), (0, 0))).reshape(B, m_len, dil, H, HD)
        return jnp.moveaxis(t, 2, 1).reshape(B, dil, n_blk, BLK, H, HD)

    def with_prev(t):
        prev = jnp.pad(t, ((0, 0), (0, 0), (1, 0), (0, 0), (0, 0), (0, 0)))[:, :, :-1]
        return jnp.concatenate([prev, t], axis=3)

    qc = classes(q)
    kb = with_prev(classes(k))
    vb = with_prev(classes(v))
    qi = jnp.arange(BLK)[:, None]
    ki = jnp.arange(2 * BLK)[None, :]
    dist = qi + BLK - ki
    in_band = (dist >= 0) & (dist <= N_BACK)
    has_prev = jnp.arange(n_blk)[:, None, None] > 0
    valid = in_band[None] & (has_prev | (ki >= BLK)[None])
    b = jnp.transpose(bias[jnp.clip(dist, 0, N_BACK)], (2, 0, 1))
    s = jnp.einsum('brnqhe,brnkhe->brnhqk', qc, kb, preferred_element_type=jnp.float32)
    s = s * ATTN_SCALE + b
    p, lse = softmax_stats(s, valid[None, None, :, None])
    o = jnp.einsum('brnhqk,brnkhe->brnqhe', p.astype(vb.dtype), vb)
    o = jnp.moveaxis(o.reshape(B, dil, m_len, H, HD), 1, 2).reshape(B, s_pad, H, HD)[:, :S]
    lse = jnp.moveaxis(jnp.moveaxis(lse, 3, 4).reshape(B, dil, m_len, H), 1, 2).reshape(B, s_pad, H)[:, :S]
    return o, lse


def dilated_group_sample(q, k, v, kv_buf, bias, dil):
    L = kv_buf.shape[1]
    T = q.shape[1]
    kc = jnp.concatenate([kv_buf[:, :, 0], k.astype(kv_buf.dtype)], axis=1)
    vc = jnp.concatenate([kv_buf[:, :, 1], v.astype(kv_buf.dtype)], axis=1)
    idx = L + jnp.arange(T)[:, None] - dil * jnp.arange(N_SLOTS)[None, :]
    valid = idx >= 0
    idx = jnp.maximum(idx, 0)
    kg = kc[:, idx]
    vg = vc[:, idx]
    s = jnp.einsum('bthe,btjhe->bthj', q, kg, preferred_element_type=jnp.float32)
    s = s * ATTN_SCALE + bias.T
    p, lse = softmax_stats(s, valid[None, :, None, :])
    o = jnp.einsum('bthj,btjhe->bthe', p.astype(vg.dtype), vg)
    new_buf = jnp.stack([kc, vc], axis=2)[:, T:]
    return o, lse, new_buf


def causal_conv(x, buf, w, b):
    T = x.shape[1]
    xc = jnp.concatenate([buf.astype(x.dtype), x], axis=1)
    y = b + sum(xc[:, j:j + T] * w[j] for j in range(CONV_WIDTH))
    return y, xc[:, T:]


def rg_lru(x, h0, w_a, b_a, w_x, b_x, lam):
    B, T, _ = x.shape
    f32 = jnp.float32
    xf = x.astype(f32)
    xb = xf.reshape(B, T, N_LRU_BLOCKS, LRU_BLOCK)
    gate_a = jnp.einsum('btni,nij->btnj', xb, w_a.astype(f32)).reshape(B, T, D_LRU) + b_a.astype(f32)
    gate_x = jnp.einsum('btni,nij->btnj', xb, w_x.astype(f32)).reshape(B, T, D_LRU) + b_x.astype(f32)
    r = jax.nn.sigmoid(gate_a)
    i = jax.nn.sigmoid(gate_x)
    log_a = -LRU_C * r * jax.nn.softplus(-lam.astype(f32))
    a = jnp.exp(log_a)
    u = jnp.sqrt(-jnp.expm1(2.0 * log_a)) * (i * xf)

    def step(h, au):
        a_t, u_t = au
        h = a_t * h + u_t
        return h, h

    h_last, hs = lax.scan(step, h0.astype(f32), (jnp.moveaxis(a, 1, 0), jnp.moveaxis(u, 1, 0)))
    return jnp.moveaxis(hs, 0, 1), h_last


def mixer_layer(x, conv_buf, h0, kv_bufs, g_norm, w_in, b_merge, conv_w, conv_b,
                lru_w_a, lru_b_a, lru_w_x, lru_b_x, lru_lambda, g_q, g_k, rel_bias,
                w_lru_proj, w_attn_proj, w_out):
    B, T, _ = x.shape
    f32 = jnp.float32
    u = rms_norm(x, g_norm)
    z = jnp.einsum('btd,de->bte', u, w_in)
    o1 = D_LRU
    o2 = 2 * D_LRU
    o3 = o2 + D_QKV
    o4 = o3 + D_QKV
    o5 = o4 + D_QKV
    o6 = o5 + D_ATTN_OUT
    xa, ga, q, k, v, gb, gm = jnp.split(z, [o1, o2, o3, o4, o5, o6], axis=-1)

    xa, new_conv = causal_conv(xa, conv_buf, conv_w, conv_b)
    hs, h_last = rg_lru(xa, h0, lru_w_a, lru_b_a, lru_w_x, lru_b_x, lru_lambda)
    ya = jnp.einsum('bte,ed->btd', (hs * jax.nn.silu(ga.astype(f32))).astype(x.dtype), w_lru_proj)

    q = rms_norm(q.reshape(B, T, N_ATTN_HEADS, HEAD_DIM), g_q)
    k = rms_norm(k.reshape(B, T, N_ATTN_HEADS, HEAD_DIM), g_k)
    v = v.reshape(B, T, N_ATTN_HEADS, HEAD_DIM)
    outs, lses, new_bufs = [], [], []
    for g in range(N_GROUPS):
        sl = slice(g * HEADS_PER_GROUP, (g + 1) * HEADS_PER_GROUP)
        bias = slot_bias(rel_bias, g)
        qg, kg, vg = q[:, :, sl], k[:, :, sl], v[:, :, sl]
        if kv_bufs is None:
            o, lse = dilated_group_prompt(qg, kg, vg, bias, DILATIONS[g])
            keep = min(WINDOWS[g], T)
            nb = jnp.stack([kg, vg], axis=2)[:, T - keep:]
        else:
            o, lse, nb = dilated_group_sample(qg, kg, vg, kv_bufs[g], bias, DILATIONS[g])
        outs.append(o.astype(f32))
        lses.append(lse)
        new_bufs.append(nb)
    alpha = jax.nn.softmax(jnp.stack(lses, axis=0), axis=0)
    ob = jnp.sum(alpha[..., None] * jnp.stack(outs, axis=0), axis=0).reshape(B, T, D_ATTN_OUT)
    yb = jnp.einsum('bte,ed->btd', (ob * jax.nn.silu(gb.astype(f32))).astype(x.dtype), w_attn_proj)

    gates = jax.nn.sigmoid((gm + b_merge).astype(f32))
    merged = gates[..., :D_MODEL] * ya.astype(f32) + gates[..., D_MODEL:] * yb.astype(f32)
    y = x + jnp.einsum('btd,de->bte', merged.astype(x.dtype), w_out)
    return y, new_conv, h_last.astype(x.dtype), new_bufs


def setup_inputs(seed: int = 0) -> dict:
    key = jax.random.key(seed)
    ks = jax.random.split(key, 24)

    def nrm(k, shape, scale):
        return scale * jax.random.normal(k, shape, jnp.float32)

    kv_shape = lambda w: (DEPTH, DEC_BATCH, min(w, PAST_LEN), 2, HEADS_PER_GROUP, HEAD_DIM)
    u_lam = jax.random.uniform(ks[16], (DEPTH, D_LRU), jnp.float32, minval=0.9, maxval=0.999)
    s_lam = u_lam ** (1.0 / LRU_C)
    lru_lambda = jnp.log(s_lam) - jnp.log1p(-s_lam)
    return {
        'x_prompt': nrm(ks[0], (BATCH, SEQ, D_MODEL), 1.0),
        'x_sample': nrm(ks[1], (DEC_BATCH, DEC_SEQ, D_MODEL), 1.0),
        'cache_kv_w128': nrm(ks[2], kv_shape(WINDOWS[0]), 1.0),
        'cache_kv_w512': nrm(ks[3], kv_shape(WINDOWS[1]), 1.0),
        'cache_kv_w2048': nrm(ks[4], kv_shape(WINDOWS[2]), 1.0),
        'state_conv': nrm(ks[5], (DEPTH, DEC_BATCH, CONV_WIDTH - 1, D_LRU), 1.0),
        'state_h': nrm(ks[6], (DEPTH, DEC_BATCH, D_LRU), 0.5),
        'g_norm': 1.0 + nrm(ks[7], (DEPTH, D_MODEL), 0.05),
        'w_in': nrm(ks[8], (DEPTH, D_MODEL, D_IN), D_MODEL ** -0.5),
        'b_merge': nrm(ks[9], (DEPTH, 2 * D_MODEL), 0.1),
        'conv_w': nrm(ks[10], (DEPTH, CONV_WIDTH, D_LRU), CONV_WIDTH ** -0.5),
        'conv_b': nrm(ks[11], (DEPTH, D_LRU), 0.02),
        'lru_w_a': nrm(ks[12], (DEPTH, N_LRU_BLOCKS, LRU_BLOCK, LRU_BLOCK), LRU_BLOCK ** -0.5),
        'lru_b_a': nrm(ks[13], (DEPTH, D_LRU), 0.1),
        'lru_w_x': nrm(ks[14], (DEPTH, N_LRU_BLOCKS, LRU_BLOCK, LRU_BLOCK), LRU_BLOCK ** -0.5),
        'lru_b_x': nrm(ks[15], (DEPTH, D_LRU), 0.1),
        'lru_lambda': lru_lambda,
        'g_q': 1.0 + nrm(ks[17], (DEPTH, HEAD_DIM), 0.05),
        'g_k': 1.0 + nrm(ks[18], (DEPTH, HEAD_DIM), 0.05),
        'rel_bias': nrm(ks[19], (N_BUCKETS, N_ATTN_HEADS), 0.5),
        'w_lru_proj': nrm(ks[20], (DEPTH, D_LRU, D_MODEL), D_LRU ** -0.5),
        'w_attn_proj': nrm(ks[21], (DEPTH, D_ATTN_OUT, D_MODEL), D_ATTN_OUT ** -0.5),
        'w_out': nrm(ks[22], (DEPTH, D_MODEL, D_MODEL), D_MODEL ** -0.5),
    }


def reference(x_prompt, x_sample, cache_kv_w128, cache_kv_w512, cache_kv_w2048, state_conv, state_h,
              g_norm, w_in, b_merge, conv_w, conv_b, lru_w_a, lru_b_a, lru_w_x, lru_b_x, lru_lambda,
              g_q, g_k, rel_bias, w_lru_proj, w_attn_proj, w_out):
    yp, ys = x_prompt, x_sample
    bp = x_prompt.shape[0]
    kv_p = [[], [], []]
    kv_s = [[], [], []]
    conv_p, h_p, conv_s, h_s = [], [], [], []
    for l in range(DEPTH):
        params = (g_norm[l], w_in[l], b_merge[l], conv_w[l], conv_b[l], lru_w_a[l], lru_b_a[l],
                  lru_w_x[l], lru_b_x[l], lru_lambda[l], g_q[l], g_k[l], rel_bias,
                  w_lru_proj[l], w_attn_proj[l], w_out[l])
        yp, cp, hp, bufs_p = mixer_layer(
            yp, jnp.zeros((bp, CONV_WIDTH - 1, D_LRU), yp.dtype), jnp.zeros((bp, D_LRU), jnp.float32),
            None, *params)
        ys, cs, hsm, bufs_s = mixer_layer(
            ys, state_conv[l], state_h[l], (cache_kv_w128[l], cache_kv_w512[l], cache_kv_w2048[l]), *params)
        for g in range(N_GROUPS):
            kv_p[g].append(bufs_p[g])
            kv_s[g].append(bufs_s[g])
        conv_p.append(cp)
        h_p.append(hp)
        conv_s.append(cs)
        h_s.append(hsm)
    kv128_p, kv512_p, kv2048_p = (jnp.stack(t, axis=0) for t in kv_p)
    kv128_s, kv512_s, kv2048_s = (jnp.stack(t, axis=0) for t in kv_s)
    conv_prompt = jnp.stack(conv_p, axis=0)
    h_prompt = jnp.stack(h_p, axis=0)
    conv_sample = jnp.stack(conv_s, axis=0)
    h_sample = jnp.stack(h_s, axis=0)
    return (yp, ys, kv128_p, kv512_p, kv2048_p, conv_prompt, h_prompt,
            kv128_s, kv512_s, kv2048_s, conv_sample, h_sample)
```

```cpp
#include <hip/hip_runtime.h>
#include <cstdio>
#include <cstdint>
#include <cmath>
namespace pg8 {
#define PG8_LAS __attribute__((address_space(3)))
typedef unsigned short bf16_t;
typedef short bf16x8 __attribute__((ext_vector_type(8)));
typedef float f32x4 __attribute__((ext_vector_type(4)));
typedef unsigned u32x4 __attribute__((ext_vector_type(4)));
constexpr int BM = 256, BK = 64, HALF = 128, HTB = HALF * BK * 2  , STAGE_BYTES = 8 * HTB, NXCD = 8, WGM = 8;

__host__ __device__ __forceinline__ int lds_byte(int r, int c) { const int st = (r >> 4) * 2 + (c >> 5), rr = r & 15, cc = c & 31, ob = rr * 64 + cc * 2; return st * 1024 + (ob ^ (((ob >> 9) & 1) << 5)); }
__host__ __device__ __forceinline__ void stage_rc(int b, int& R, int& C) { const int st = b / 1024, sb = b % 1024, swz = sb ^ (((sb >> 9) & 1) << 5); R = (st >> 1) * 16 + swz / 64; C = (st & 1) * 32 + (swz % 64) / 2; }
__host__ __device__ __forceinline__ int perm32(int rho) { const int n = rho >> 4, i = rho & 15; return 8 * (i >> 2) + 4 * n + (i & 3); }

struct Unit { int pm, pn; };
struct Gemm { const bf16_t* A; const bf16_t* Bt; int M, N, K; };

struct StaticOrder {
    int nM, nN, nwg, G, c;
    __host__ __device__ void init(int M, int N, int G_, int c_) { nM = M / BM; nN = N / BM; nwg = nM * nN; G = G_; c = c_; }
    __host__ __device__ bool next(int i, Unit& u) const {
        const long L = (long)i * G + c; if (L >= nwg) return false;
        int wgid = (int)L; { const int q = nwg / NXCD, r = nwg % NXCD, xcd = wgid % NXCD, off = wgid / NXCD; wgid = (xcd < r ? xcd * (q + 1) : r * (q + 1) + (xcd - r) * q) + off; }
        const int nig = WGM * nN, gid = wgid / nig, fm = gid * WGM, gsz = (nM - fm) < WGM ? (nM - fm) : WGM;
        u.pm = fm + ((wgid % nig) % gsz); u.pn = (wgid % nig) / gsz; return true;
    }
    __device__ __forceinline__ void a_ready(const Unit&) const {}
    __device__ __forceinline__ void done(const Unit&) const {}
};


__device__ __forceinline__ unsigned cvt_pk_bf16(float lo, float hi) { unsigned r; asm volatile("v_cvt_pk_bf16_f32 %0, %1, %2" : "=v"(r) : "v"(lo), "v"(hi)); return r; }
__device__ __forceinline__ float bf_lo(unsigned w) { return __uint_as_float(w << 16); }
__device__ __forceinline__ float bf_hi(unsigned w) { return __uint_as_float(w & 0xffff0000u); }
__device__ __forceinline__ float sigmoid_f(float x) { return __builtin_amdgcn_rcpf(1.0f + __builtin_amdgcn_exp2f(-1.4426950408889634f * x)); }
__device__ __forceinline__ float silu_f(float x) { return x * sigmoid_f(x); }
__device__ __forceinline__ u32x4 pack8(const f32x4& a, const f32x4& b) { u32x4 w; w.x = cvt_pk_bf16(a[0], a[1]); w.y = cvt_pk_bf16(a[2], a[3]); w.z = cvt_pk_bf16(b[0], b[1]); w.w = cvt_pk_bf16(b[2], b[3]); return w; }

constexpr int MP_ = 16384;
struct EpiIn {
    static constexpr bool PERM = true, AFTER_DRAIN = false;
    bf16_t *XA, *SGA, *Q, *Kb, *Vb, *SGB, *GM;
    float* out;
    const float *b_merge, *g_q, *g_k;
    PG8_LAS float* scr;
    float qscale;
    size_t o_kv128p, o_kv512p, o_kv2048p, o_convp, o_kv128s, o_kv512s, o_kv2048s, o_convs;
    __device__ __forceinline__ void operator()(const f32x4 (&acc)[2][2][4][2], const Unit& u, int wr, int wc, int fr, int fq) const {
        const int pn = u.pn, pm = u.pm;
        const int rowl0 = wr * 64 + fr;
        const int cl0 = wc * 32 + 8 * fq;
        if (pn >= 8 && pn < 20) {
            const bool isk = pn >= 14;
#pragma unroll
            for (int ai = 0; ai < 2; ++ai)
#pragma unroll
                for (int m = 0; m < 4; ++m)
#pragma unroll
                    for (int bj = 0; bj < 2; ++bj) {
                        const f32x4 a = acc[ai][bj][m][0], b = acc[ai][bj][m][1];
                        float s = (a[0] * a[0] + a[1] * a[1]) + (a[2] * a[2] + a[3] * a[3]) + (b[0] * b[0] + b[1] * b[1]) + (b[2] * b[2] + b[3] * b[3]);
                        s += __shfl_xor(s, 16); s += __shfl_xor(s, 32);
                        if (fq == 0) scr[((ai * 128 + rowl0 + m * 16) * 2 + bj) * 4 + wc] = s;
                    }
            asm volatile("s_waitcnt lgkmcnt(0)" ::: "memory"); __builtin_amdgcn_s_barrier(); asm volatile("" ::: "memory");
            const float* gw = isk ? g_k : g_q;
            const f32x4 g0 = *(const f32x4*)(gw + cl0), g1 = *(const f32x4*)(gw + cl0 + 4);
            const float sc = isk ? 1.0f : qscale;
            const int colt = (pn - (isk ? 14 : 8)) * 256;
            bf16_t* dst = isk ? Kb : Q;
            const int grp = colt / 512;
#pragma unroll
            for (int ai = 0; ai < 2; ++ai)
#pragma unroll
                for (int m = 0; m < 4; ++m) {
                    const int rl = ai * 128 + rowl0 + m * 16; const int row = pm * 256 + rl;
                    float* kvrow = nullptr;
                    if (isk) {
                        if (row < MP_) { const int b = row >> 11, t = row & 2047;
                            if (grp == 0) { if (t >= 1920) kvrow = out + o_kv128p + ((size_t)(b * 128 + (t - 1920))) * 1024; }
                            else if (grp == 1) { if (t >= 1536) kvrow = out + o_kv512p + ((size_t)(b * 512 + (t - 1536))) * 1024; }
                            else kvrow = out + o_kv2048p + ((size_t)(b * 2048 + t)) * 1024;
                        } else { const int rs = row - MP_, db = rs >> 3, t = rs & 7;
                            if (grp == 0) kvrow = out + o_kv128s + ((size_t)(db * 128 + 120 + t)) * 1024;
                            else if (grp == 1) kvrow = out + o_kv512s + ((size_t)(db * 512 + 504 + t)) * 1024;
                            else kvrow = out + o_kv2048s + ((size_t)(db * 2048 + 2040 + t)) * 1024;
                        }
                    }
#pragma unroll
                    for (int bj = 0; bj < 2; ++bj) {
                        const f32x4 p = *(const PG8_LAS f32x4*)(scr + (rl * 2 + bj) * 4);
                        const float rs_ = __builtin_amdgcn_rsqf(((p[0] + p[1]) + (p[2] + p[3])) * (1.0f / 128.0f) + 1e-6f);
                        f32x4 a = acc[ai][bj][m][0] * rs_ * g0, b = acc[ai][bj][m][1] * rs_ * g1;
                        if (kvrow) { float* kp = kvrow + ((colt & 511) + bj * 128 + cl0); *(f32x4*)kp = a; *(f32x4*)(kp + 4) = b; }
                        a = a * sc; b = b * sc;
                        *(u32x4*)(dst + (size_t)row * 1536 + colt + bj * 128 + cl0) = pack8(a, b);
                    }
                }
            return;
        }
        int mode, ld, colt; bf16_t* dst;
        if (pn < 4)       { mode = 0; dst = XA;  ld = 1024; colt = pn * 256; }
        else if (pn < 8)  { mode = 1; dst = SGA; ld = 1024; colt = (pn - 4) * 256; }
        else if (pn < 26) { mode = 2; dst = Vb;  ld = 1536; colt = (pn - 20) * 256; }
        else if (pn < 28) { mode = 1; dst = SGB; ld = 512;  colt = (pn - 26) * 256; }
        else              { mode = 3; dst = GM;  ld = 2048; colt = (pn - 28) * 256; }
        f32x4 bm[2][2];
#pragma unroll
        for (int bj = 0; bj < 2; ++bj)
#pragma unroll
            for (int n = 0; n < 2; ++n) bm[bj][n] = (mode == 3) ? *(const f32x4*)(b_merge + colt + bj * 128 + cl0 + 4 * n) : (f32x4){0.f, 0.f, 0.f, 0.f};
        const int grp = colt / 512;
#pragma unroll
        for (int ai = 0; ai < 2; ++ai)
#pragma unroll
            for (int m = 0; m < 4; ++m) {
                const int rl = ai * 128 + rowl0 + m * 16; const int row = pm * 256 + rl;
                float* frow = nullptr;
                if (mode == 2) {
                    if (row < MP_) { const int b = row >> 11, t = row & 2047;
                        if (grp == 0) { if (t >= 1920) frow = out + o_kv128p + ((size_t)(b * 128 + (t - 1920))) * 1024; }
                        else if (grp == 1) { if (t >= 1536) frow = out + o_kv512p + ((size_t)(b * 512 + (t - 1536))) * 1024; }
                        else frow = out + o_kv2048p + ((size_t)(b * 2048 + t)) * 1024;
                    } else { const int rs = row - MP_, db = rs >> 3, t = rs & 7;
                        if (grp == 0) frow = out + o_kv128s + ((size_t)(db * 128 + 120 + t)) * 1024;
                        else if (grp == 1) frow = out + o_kv512s + ((size_t)(db * 512 + 504 + t)) * 1024;
                        else frow = out + o_kv2048s + ((size_t)(db * 2048 + 2040 + t)) * 1024;
                    }
                    if (frow) frow += 512 + (colt & 511);
                } else if (mode == 0) {
                    if (row < MP_) { const int b = row >> 11, t = row & 2047; if (t >= 2045) frow = out + o_convp + ((size_t)(b * 3 + (t - 2045))) * 1024 + colt; }
                    else { const int rs = row - MP_, db = rs >> 3, t = rs & 7; if (t >= 5) frow = out + o_convs + ((size_t)(db * 3 + (t - 5))) * 1024 + colt; }
                }
#pragma unroll
                for (int bj = 0; bj < 2; ++bj) {
                    f32x4 a = acc[ai][bj][m][0], b = acc[ai][bj][m][1];
                    if (frow) { float* kp = frow + bj * 128 + cl0; *(f32x4*)kp = a; *(f32x4*)(kp + 4) = b; }
                    if (mode == 1) {
#pragma unroll
                        for (int e = 0; e < 4; ++e) { a[e] = silu_f(a[e]); b[e] = silu_f(b[e]); }
                    } else if (mode == 3) {
                        a = a + bm[bj][0]; b = b + bm[bj][1];
#pragma unroll
                        for (int e = 0; e < 4; ++e) { a[e] = sigmoid_f(a[e]); b[e] = sigmoid_f(b[e]); }
                    }
                    *(u32x4*)(dst + (size_t)row * ld + colt + bj * 128 + cl0) = pack8(a, b);
                }
            }
    }
};

struct EpiG1 {
    static constexpr bool PERM = true, AFTER_DRAIN = false;
    const bf16_t* GM; float* T1;
    __device__ __forceinline__ void operator()(const f32x4 (&acc)[2][2][4][2], const Unit& u, int wr, int wc, int fr, int fq) const {
        const int row0 = u.pm * 256 + wr * 64 + fr, col0 = u.pn * 256 + wc * 32 + 8 * fq;
#pragma unroll
        for (int ai = 0; ai < 2; ++ai)
#pragma unroll
            for (int m = 0; m < 4; ++m) { const int row = row0 + ai * 128 + m * 16;
#pragma unroll
                for (int bj = 0; bj < 2; ++bj) { const int col = col0 + bj * 128;
                    const u32x4 g = *(const u32x4*)(GM + (size_t)row * 2048 + col);
                    f32x4 a = acc[ai][bj][m][0], b = acc[ai][bj][m][1];
                    a[0] *= bf_lo(g.x); a[1] *= bf_hi(g.x); a[2] *= bf_lo(g.y); a[3] *= bf_hi(g.y);
                    b[0] *= bf_lo(g.z); b[1] *= bf_hi(g.z); b[2] *= bf_lo(g.w); b[3] *= bf_hi(g.w);
                    float* p = T1 + (size_t)row * 1024 + col; *(f32x4*)p = a; *(f32x4*)(p + 4) = b; } }
    }
};
struct EpiG2 {
    static constexpr bool PERM = true, AFTER_DRAIN = false;
    const bf16_t* GM; const float* T1; bf16_t* MG;
    __device__ __forceinline__ void operator()(const f32x4 (&acc)[2][2][4][2], const Unit& u, int wr, int wc, int fr, int fq) const {
        const int row0 = u.pm * 256 + wr * 64 + fr, col0 = u.pn * 256 + wc * 32 + 8 * fq;
#pragma unroll
        for (int ai = 0; ai < 2; ++ai)
#pragma unroll
            for (int m = 0; m < 4; ++m) { const int row = row0 + ai * 128 + m * 16;
#pragma unroll
                for (int bj = 0; bj < 2; ++bj) { const int col = col0 + bj * 128;
                    const u32x4 g = *(const u32x4*)(GM + (size_t)row * 2048 + 1024 + col);
                    const float* p = T1 + (size_t)row * 1024 + col; f32x4 a = *(const f32x4*)p, b = *(const f32x4*)(p + 4);
                    const f32x4 x = acc[ai][bj][m][0], y = acc[ai][bj][m][1];
                    a[0] += x[0] * bf_lo(g.x); a[1] += x[1] * bf_hi(g.x); a[2] += x[2] * bf_lo(g.y); a[3] += x[3] * bf_hi(g.y);
                    b[0] += y[0] * bf_lo(g.z); b[1] += y[1] * bf_hi(g.z); b[2] += y[2] * bf_lo(g.w); b[3] += y[3] * bf_hi(g.w);
                    *(u32x4*)(MG + (size_t)row * 1024 + col) = pack8(a, b); } }
    }
};
struct EpiOut {
    static constexpr bool PERM = true, AFTER_DRAIN = false;
    const float *xp, *xs; float* y;
    __device__ __forceinline__ void operator()(const f32x4 (&acc)[2][2][4][2], const Unit& u, int wr, int wc, int fr, int fq) const {
        const int row0 = u.pm * 256 + wr * 64 + fr, col0 = u.pn * 256 + wc * 32 + 8 * fq;
        const float* xb = (u.pm < 64) ? xp : (xs - (size_t)MP_ * 1024);
#pragma unroll
        for (int ai = 0; ai < 2; ++ai)
#pragma unroll
            for (int m = 0; m < 4; ++m) { const int row = row0 + ai * 128 + m * 16;
#pragma unroll
                for (int bj = 0; bj < 2; ++bj) { const size_t off = (size_t)row * 1024 + col0 + bj * 128;
                    const f32x4 a = *(const f32x4*)(xb + off) + acc[ai][bj][m][0], b = *(const f32x4*)(xb + off + 4) + acc[ai][bj][m][1];
                    *(f32x4*)(y + off) = a; *(f32x4*)(y + off + 4) = b; } }
    }
};

template <class Epi, class Sched, bool ALIGN_EPI = false, bool SP2 = false>
__device__ __forceinline__ void gemm_phase(PG8_LAS unsigned char* lds, const Gemm g, const Sched& S, const Epi& E) {
    const int tid = threadIdx.x, wid = __builtin_amdgcn_readfirstlane(tid >> 6), lane = tid & 63, wr = wid >> 2, wc = wid & 3, fr = lane & 15, fq = lane >> 4;
    const int K = g.K, nt = K / BK;
    unsigned voffA[2], voffB[2];
#pragma unroll
    for (int i = 0; i < 2; ++i) { int R, C; stage_rc(tid * 16 + i * 8192, R, C); const int Rb = Epi::PERM ? ((R & ~31) + perm32(R & 31)) : R;
        voffA[i] = (unsigned)(R * K + C) * 2u; voffB[i] = (unsigned)(Rb * K + C) * 2u; }
    const size_t kstep = (size_t)(BK * 2);
    const size_t hstep = (size_t)HALF * K * 2;
    const size_t tstep = 2 * hstep;
    const unsigned ldsw = (unsigned)wid * 1024u;
    const int aoff = lds_byte(wr * 64 + fr, fq * 8), boff = lds_byte(wc * 32 + fr, fq * 8);
#define PG8_SA(b, h) (((b) * 2 + (h)) * HTB)
#define PG8_SB(b, h) ((4 + (b) * 2 + (h)) * HTB)
#define PG8_STAGE(bufoff, gbase, voff) do { _Pragma("unroll") for (int _i = 0; _i < 2; ++_i) \
        __builtin_amdgcn_global_load_lds((const unsigned*)((const char*)(gbase) + (voff)[_i]), (PG8_LAS unsigned*)(lds + (bufoff) + ldsw + _i * 8192), 16, 0, 0); } while (0)
#define PG8_LDA(dst, b, h) do { _Pragma("unroll") for (int m = 0; m < 4; ++m) _Pragma("unroll") for (int k = 0; k < 2; ++k) dst[m][k] = *(const PG8_LAS bf16x8*)(lds + PG8_SA(b, h) + aoff + m * 2048 + k * 1024); } while (0)
#define PG8_LDB(dst, b, h) do { _Pragma("unroll") for (int n = 0; n < 2; ++n) _Pragma("unroll") for (int k = 0; k < 2; ++k) dst[n][k] = *(const PG8_LAS bf16x8*)(lds + PG8_SB(b, h) + boff + n * 2048 + k * 1024); } while (0)
#define PG8_MMA(ai, bj, At, Bt) do { __builtin_amdgcn_s_setprio(1); _Pragma("unroll") for (int m = 0; m < 4; ++m) _Pragma("unroll") for (int n = 0; n < 2; ++n) _Pragma("unroll") for (int k = 0; k < 2; ++k) \
        acc[ai][bj][m][n] = __builtin_amdgcn_mfma_f32_16x16x32_bf16(Bt[n][k], At[m][k], acc[ai][bj][m][n], 0, 0, 0); __builtin_amdgcn_s_setprio(0); } while (0)
#define PG8_WAIT_V(n) asm volatile("s_waitcnt vmcnt(" #n ")" ::: "memory")
#define PG8_WAIT_L(n) asm volatile("s_waitcnt lgkmcnt(" #n ")" ::: "memory")
#define PG8_BAR __builtin_amdgcn_s_barrier()
#define PG8_SCHED __builtin_amdgcn_sched_barrier(0)
    Unit cur, nxt; int ui = 0;
    if (!S.next(0, cur)) return;
    f32x4 acc[2][2][4][2];
#pragma unroll
    for (int a = 0; a < 2; ++a)
#pragma unroll
        for (int b = 0; b < 2; ++b)
#pragma unroll
            for (int m = 0; m < 4; ++m)
#pragma unroll
                for (int n = 0; n < 2; ++n) acc[a][b][m][n] = (f32x4){0.f, 0.f, 0.f, 0.f};
    bf16x8 At[4][2], B0[2][2], B1[2][2];
    const char* cA = (const char*)g.A + (size_t)cur.pm * tstep; const char* cB = (const char*)g.Bt + (size_t)cur.pn * tstep;
    S.a_ready(cur);
    if constexpr (SP2) {
        PG8_STAGE(PG8_SB(0, 0), cB, voffB); PG8_STAGE(PG8_SB(0, 1), cB + hstep, voffB); PG8_STAGE(PG8_SA(0, 0), cA, voffA); PG8_STAGE(PG8_SA(0, 1), cA + hstep, voffA);
        if (wr == 1) PG8_BAR;
        PG8_WAIT_V(2); PG8_BAR;
        PG8_STAGE(PG8_SB(1, 0), cB + kstep, voffB); PG8_STAGE(PG8_SA(1, 0), cA + kstep, voffA); PG8_STAGE(PG8_SB(1, 1), cB + hstep + kstep, voffB);
        PG8_WAIT_V(6); PG8_BAR;
    } else {
        PG8_STAGE(PG8_SB(0, 0), cB, voffB); PG8_STAGE(PG8_SA(0, 0), cA, voffA); PG8_STAGE(PG8_SB(0, 1), cB + hstep, voffB); PG8_STAGE(PG8_SA(0, 1), cA + hstep, voffA);
        if (wr == 1) PG8_BAR;
        PG8_WAIT_V(4); PG8_BAR;
        PG8_STAGE(PG8_SB(1, 0), cB + kstep, voffB); PG8_STAGE(PG8_SA(1, 0), cA + kstep, voffA); PG8_STAGE(PG8_SB(1, 1), cB + hstep + kstep, voffB);
        PG8_WAIT_V(6); PG8_BAR;
    }
    for (;;) {
        const bool has_next = S.next(ui + 1, nxt);
        const char* nA = has_next ? (const char*)g.A + (size_t)nxt.pm * tstep : cA; const char* nB = has_next ? (const char*)g.Bt + (size_t)nxt.pn * tstep : cB;
        for (int t = 0; t < nt; t += 2) {
            const bool last = (t == nt - 2);
            const char* a1 = cA + (size_t)(t + 1) * kstep;
            const char* a2 = last ? nA : cA + (size_t)(t + 2) * kstep; const char* b2 = last ? nB : cB + (size_t)(t + 2) * kstep;
            const char* a3 = a2 + kstep; const char* b3 = b2 + kstep;
            if (last && has_next) S.a_ready(nxt);
            if constexpr (SP2) {
            PG8_LDB(B0, 0, 0); PG8_LDB(B1, 0, 1); PG8_SCHED; PG8_LDA(At, 0, 0); PG8_STAGE(PG8_SA(1, 1), a1 + hstep, voffA);
            PG8_WAIT_V(8); PG8_WAIT_L(0); PG8_BAR; PG8_MMA(0, 0, At, B0); PG8_MMA(0, 1, At, B1); PG8_BAR; PG8_SCHED;
            PG8_LDA(At, 0, 1); PG8_STAGE(PG8_SB(0, 0), b2, voffB); PG8_STAGE(PG8_SB(0, 1), b2 + hstep, voffB); PG8_STAGE(PG8_SA(0, 0), a2, voffA);
            PG8_WAIT_V(8); PG8_WAIT_L(0); PG8_BAR; PG8_MMA(1, 0, At, B0); PG8_MMA(1, 1, At, B1); PG8_BAR; PG8_SCHED;
            PG8_LDB(B0, 1, 0); PG8_LDB(B1, 1, 1); PG8_SCHED; PG8_LDA(At, 1, 0); PG8_STAGE(PG8_SA(0, 1), a2 + hstep, voffA);
            PG8_WAIT_V(8); PG8_WAIT_L(0); PG8_BAR; PG8_MMA(0, 0, At, B0); PG8_MMA(0, 1, At, B1); PG8_BAR; PG8_SCHED;
            PG8_LDA(At, 1, 1); PG8_STAGE(PG8_SB(1, 0), b3, voffB); PG8_STAGE(PG8_SB(1, 1), b3 + hstep, voffB); PG8_STAGE(PG8_SA(1, 0), a3, voffA);
            PG8_WAIT_V(8); PG8_WAIT_L(0); PG8_BAR; PG8_MMA(1, 0, At, B0); PG8_MMA(1, 1, At, B1); PG8_BAR; PG8_SCHED;
            } else {
            PG8_LDB(B0, 0, 0); PG8_SCHED; PG8_LDA(At, 0, 0); PG8_STAGE(PG8_SA(1, 1), a1 + hstep, voffA);
            PG8_WAIT_L(8); PG8_BAR; PG8_WAIT_L(0); PG8_MMA(0, 0, At, B0); PG8_BAR; PG8_SCHED;
            PG8_LDB(B1, 0, 1); PG8_STAGE(PG8_SB(0, 0), b2, voffB);
            PG8_BAR; PG8_WAIT_L(0); PG8_MMA(0, 1, At, B1); PG8_BAR;
            PG8_LDA(At, 0, 1); PG8_STAGE(PG8_SA(0, 0), a2, voffA);
            PG8_BAR; PG8_WAIT_L(0); PG8_MMA(1, 0, At, B0); PG8_BAR; PG8_SCHED;
            PG8_STAGE(PG8_SB(0, 1), b2 + hstep, voffB);
            PG8_WAIT_V(6); PG8_BAR; PG8_MMA(1, 1, At, B1); PG8_BAR;
            PG8_LDB(B0, 1, 0); PG8_SCHED; PG8_LDA(At, 1, 0); PG8_STAGE(PG8_SA(0, 1), a2 + hstep, voffA);
            PG8_WAIT_L(8); PG8_BAR; PG8_WAIT_L(0); PG8_MMA(0, 0, At, B0); PG8_BAR; PG8_SCHED;
            PG8_LDB(B1, 1, 1); PG8_STAGE(PG8_SB(1, 0), b3, voffB);
            PG8_BAR; PG8_WAIT_L(0); PG8_MMA(0, 1, At, B1); PG8_BAR;
            PG8_LDA(At, 1, 1); PG8_STAGE(PG8_SA(1, 0), a3, voffA);
            PG8_BAR; PG8_WAIT_L(0); PG8_MMA(1, 0, At, B0); PG8_BAR; PG8_SCHED;
            PG8_STAGE(PG8_SB(1, 1), b3 + hstep, voffB);
            PG8_WAIT_V(6); PG8_BAR; PG8_MMA(1, 1, At, B1); PG8_BAR;
            }
        }
        if constexpr (ALIGN_EPI) { if (wr == 0) PG8_BAR; }
        if constexpr (!Epi::AFTER_DRAIN) { E(acc, cur, wr, wc, fr, fq); S.done(cur); }
        if (!has_next) break;
#pragma unroll
        for (int a = 0; a < 2; ++a)
#pragma unroll
            for (int b = 0; b < 2; ++b)
#pragma unroll
                for (int m = 0; m < 4; ++m)
#pragma unroll
                    for (int n = 0; n < 2; ++n) acc[a][b][m][n] = (f32x4){0.f, 0.f, 0.f, 0.f};
        cur = nxt; cA = nA; cB = nB; ++ui;
        if constexpr (ALIGN_EPI) { if (wr == 1) PG8_BAR; }
    }
    PG8_WAIT_V(0);
    if constexpr (!ALIGN_EPI) { if (wr == 0) PG8_BAR; }
    PG8_BAR;
    if constexpr (Epi::AFTER_DRAIN) { E.fused(acc, cur, wr, wc, fr, fq, lds, wid, lane); S.done(cur); }
#undef PG8_SA
#undef PG8_SB
#undef PG8_STAGE
#undef PG8_LDA
#undef PG8_LDB
#undef PG8_MMA
#undef PG8_WAIT_V
#undef PG8_WAIT_L
#undef PG8_BAR
#undef PG8_SCHED
}
}
#define GAS __attribute__((address_space(1)))
#define LAS __attribute__((address_space(3)))
typedef unsigned short bf16;
typedef unsigned v4u __attribute__((ext_vector_type(4)));
typedef float f32x4 __attribute__((ext_vector_type(4)));
typedef short bf16x8 __attribute__((ext_vector_type(8)));
typedef GAS unsigned gu32;
typedef GAS unsigned long long gu64;
#define RLX_AGENT __ATOMIC_RELAXED, __HIP_MEMORY_SCOPE_AGENT
#define LDS_WAIT() asm volatile("s_waitcnt lgkmcnt(0)" ::: "memory")
#define VM_WAIT() asm volatile("s_waitcnt vmcnt(0)" ::: "memory")
__device__ __forceinline__ unsigned long long rt() { return __builtin_amdgcn_s_memrealtime(); }
__device__ __forceinline__ unsigned f2bf(float f) { unsigned u = __builtin_bit_cast(unsigned, f); return (u + 0x7fffu + ((u >> 16) & 1u)) >> 16; }
__device__ __forceinline__ unsigned pk2(float lo, float hi) { return f2bf(lo) | (f2bf(hi) << 16); }
#define XB_TMO      128
#define XB_XCNT(j)  (256  + 64 * (j))
#define XB_XSUB(j)  (1280 + 64 * (j))
#define XB_XGEN(j)  (2304 + 64 * (j))
#define XB_TOP      3328
#define XB_TOPGEN   3392
#define XCD_BAR_WORDS 3456
#define XB_SPIN_CAP (1u << 18)

__device__ __forceinline__ unsigned xb_ld(unsigned* p)              { return __hip_atomic_load(p, __ATOMIC_RELAXED, __HIP_MEMORY_SCOPE_AGENT); }
__device__ __forceinline__ unsigned xb_add(unsigned* p, unsigned v) { return __hip_atomic_fetch_add(p, v, __ATOMIC_RELAXED, __HIP_MEMORY_SCOPE_AGENT); }
__device__ __forceinline__ unsigned xb_xcc_id() { return (unsigned)__builtin_amdgcn_s_getreg((3 << 11) | 20) & 0xFu; }
#define XB_SPIN(cond, bar) do { unsigned _sp = 0; while (cond) { __builtin_amdgcn_s_sleep(1); \
    if ((++_sp & 255u) == 0u) { if (xb_ld(&(bar)[XB_TMO])) break; if (_sp > XB_SPIN_CAP) { atomicAdd(&(bar)[XB_TMO], 1u); break; } } } } while (0)

struct XcdBarrier {
    unsigned* bar; unsigned x;
    volatile LAS unsigned* st;
};

__device__ __forceinline__ XcdBarrier xcd_barrier_post(unsigned* bar, volatile LAS unsigned* st) {
    XcdBarrier b; b.bar = bar; b.x = xb_xcc_id(); b.st = st;
    if (threadIdx.x == 0) (void)xb_add(&bar[XB_XCNT(b.x)], 1u);
    return b;
}
__device__ __forceinline__ void xcd_barrier_complete(unsigned* bar, unsigned x, unsigned& nloc, unsigned& nx) {
    const unsigned G = gridDim.x * gridDim.y * gridDim.z;
    unsigned sum, cnt, mine, sp = 0u;
    for (;;) {
        sum = 0u; cnt = 0u; mine = 0u;
#pragma unroll
        for (unsigned j = 0; j < 16; ++j) { const unsigned c = xb_ld(&bar[XB_XCNT(j)]); sum += c; cnt += (c > 0u) ? 1u : 0u; mine = (j == x) ? c : mine; }
        if (sum == G) break;
        __builtin_amdgcn_s_sleep(1);
        if ((++sp & 255u) == 0u) { if (xb_ld(&bar[XB_TMO])) break; if (sp > XB_SPIN_CAP) { atomicAdd(&bar[XB_TMO], 1u); break; } }
    }
    nloc = mine > 0u ? mine : 1u; nx = cnt > 0u ? cnt : 1u;
}

__device__ __forceinline__ void xcd_barrier(const XcdBarrier& b) {
    asm volatile("s_waitcnt vmcnt(0)" ::: "memory");
    __syncthreads();
    if (threadIdx.x == 0) {
        unsigned* bar = b.bar;
        __builtin_amdgcn_s_waitcnt(0);
        unsigned nloc = b.st[0], nx = b.st[1];
        if (nloc == 0u) { xcd_barrier_complete(bar, b.x, nloc, nx); b.st[0] = nloc; b.st[1] = nx; }
        const unsigned old = xb_add(&bar[XB_XSUB(b.x)], 1u);
        const unsigned gen = old / nloc;
        if (old + 1u == (gen + 1u) * nloc) {
            __builtin_amdgcn_fence(__ATOMIC_RELEASE, "agent");
            asm volatile("s_waitcnt vmcnt(0)" ::: "memory");
            const unsigned og = xb_add(&bar[XB_TOP], 1u);
            const unsigned tg = og / nx;
            if (og + 1u == (tg + 1u) * nx) xb_add(&bar[XB_TOPGEN], 1u);
            else XB_SPIN(xb_ld(&bar[XB_TOPGEN]) == tg, bar);
            __builtin_amdgcn_fence(__ATOMIC_ACQUIRE, "agent");
            xb_add(&bar[XB_XGEN(b.x)], 1u);
            asm volatile("s_waitcnt vmcnt(0)" ::: "memory");
        } else {
            XB_SPIN(xb_ld(&bar[XB_XGEN(b.x)]) == gen, bar);
            __builtin_amdgcn_fence(__ATOMIC_ACQUIRE, "agent");
            asm volatile("s_waitcnt vmcnt(0)" ::: "memory");
        }
    }
    __syncthreads();
}

constexpr int NWAVES = 8;
constexpr int MP = 16384, MS = 256, MT = MP + MS;
constexpr int DMOD = 1024, DIN = 9216, DQKV = 1536, DAO = 512, NHEAD = 12;
constexpr float LOG2E = 1.4426950408889634f, LN2 = 0.6931471805599453f;
constexpr float QSCALE = 0.08838834764831845f * LOG2E;
constexpr int TABW = 192;
constexpr size_t O_YP = 0, O_YS = O_YP + (size_t)MP * 1024, O_KV128P = O_YS + (size_t)MS * 1024, O_KV512P = O_KV128P + (size_t)8 * 128 * 1024,
                 O_KV2048P = O_KV512P + (size_t)8 * 512 * 1024, O_CONVP = O_KV2048P + (size_t)8 * 2048 * 1024, O_HP = O_CONVP + 8 * 3 * 1024,
                 O_KV128S = O_HP + 8 * 1024, O_KV512S = O_KV128S + (size_t)32 * 128 * 1024, O_KV2048S = O_KV512S + (size_t)32 * 512 * 1024,
                 O_CONVS = O_KV2048S + (size_t)32 * 2048 * 1024, O_HS = O_CONVS + 32 * 3 * 1024, O_END = O_HS + 32 * 1024;
constexpr size_t MiB = 1u << 20;
constexpr size_t WS_CTL = 0, CTL_ZERO_BYTES = 64 * 1024;
constexpr size_t WS_BT = 1 * MiB, WS_WIN = 2 * MiB, WS_WLRU = 20 * MiB, WS_WATT = 22 * MiB, WS_WOUT = 23 * MiB, WS_WA = 25 * MiB, WS_WX = 25 * MiB + 512 * 1024,
                 WS_PEND = 26 * MiB, WS_HEND = 27 * MiB, WS_LSE = 28 * MiB,
                 WS_XN = 32 * MiB, WS_XA = 65 * MiB, WS_SGA = 98 * MiB, WS_Q = 131 * MiB, WS_K = 180 * MiB, WS_V = 229 * MiB, WS_SGB = 278 * MiB, WS_GM = 295 * MiB,
                 WS_O = 360 * MiB, WS_HL = 409 * MiB, WS_PP = 442 * MiB, WS_A1 = 475 * MiB, WS_A2 = 508 * MiB, WS_T1 = 525 * MiB, WS_MG = 590 * MiB, WS_END = 623 * MiB;
constexpr int CW_BAR = 1024;
static_assert((CW_BAR + XCD_BAR_WORDS) * 4 <= (int)CTL_ZERO_BYTES, "ctl");
constexpr int RING_OFF = 0, RING_BYTES = 131072, EPI_OFF = 131072, TAB_OFF = EPI_OFF + 8192, MISC_OFF = TAB_OFF + 1024, LDS_BYTES = 147456;
static_assert(MISC_OFF + 128 <= LDS_BYTES, "LDS map");

typedef unsigned u32x2 __attribute__((ext_vector_type(2)));
typedef short v4i16_t __attribute__((ext_vector_type(4)));
typedef float f32x2 __attribute__((ext_vector_type(2)));

struct Args {
    const float* in[23]; float* out; unsigned char* ws; int ph_lo, ph_hi;
};
struct Frame {
    LAS unsigned char* lds; int tid, lane, wave, vcu, G;
};
__device__ __forceinline__ float wave_sum(float v) {
#pragma unroll
    for (int o = 1; o < 64; o <<= 1) v += __shfl_xor(v, o);
    return v;
}
__device__ __forceinline__ unsigned cvtpk(float lo, float hi) { return pg8::cvt_pk_bf16(lo, hi); }
__device__ __forceinline__ float bflo(unsigned w) { return __uint_as_float(w << 16); }
__device__ __forceinline__ float bfhi(unsigned w) { return __uint_as_float(w & 0xffff0000u); }
__device__ __forceinline__ unsigned off_b(unsigned row, unsigned ch) { return 256u * row + 16u * (ch ^ (((row & 3u) << 2) | ((row >> 2) & 3u))); }

__device__ __forceinline__ void p0_transpose_item(const float* W, int K, int N, bf16* WT, LAS float* scr, int item, int lane) {
    const int nblk = N / 32, kb = item / nblk, nb = item % nblk, k0 = 64 * kb, n0 = 32 * nb;
#pragma unroll 8
    for (int i = 0; i < 32; ++i) { const int kk = 2 * i + (lane >> 5); scr[kk * 33 + (lane & 31)] = W[(size_t)(k0 + kk) * N + n0 + (lane & 31)]; }
    LDS_WAIT(); asm volatile("" ::: "memory");
    const int c = lane & 7;
#pragma unroll
    for (int j = 0; j < 4; ++j) { const int n = (lane >> 3) + 8 * j; const LAS float* s = scr + (8 * c) * 33 + n;
        v4u o; o.x = pk2(s[0 * 33], s[1 * 33]); o.y = pk2(s[2 * 33], s[3 * 33]); o.z = pk2(s[4 * 33], s[5 * 33]); o.w = pk2(s[6 * 33], s[7 * 33]);
        *(GAS v4u*)(WT + (size_t)(n0 + n) * K + k0 + 8 * c) = o; }
    LDS_WAIT(); asm volatile("" ::: "memory");
}
__device__ __forceinline__ int t5_bucket(int dist) {
    if (dist < 16) return dist;
    const int large = 16 + (int)(log((double)dist / 16.0) / log(128.0) * 16.0);
    return large < 31 ? large : 31;
}
template <int L>
__device__ __forceinline__ void copy_region(const float* src, float* dst, unsigned gt, unsigned nt) {
    constexpr unsigned per = (unsigned)(L - 8) * 256u, total = 32u * per;
    for (unsigned i = gt; i < total; i += 4 * nt) {
        f32x4 v[4];
#pragma unroll
        for (int k = 0; k < 4; ++k) { const unsigned j = i + k * nt; if (j < total) { const unsigned db = j / per, rem = j - db * per; v[k] = __builtin_nontemporal_load((const f32x4*)(src + ((size_t)db * L + 8) * 1024) + rem); } }
#pragma unroll
        for (int k = 0; k < 4; ++k) { const unsigned j = i + k * nt; if (j < total) { const unsigned db = j / per, rem = j - db * per; __builtin_nontemporal_store(v[k], (f32x4*)(dst + (size_t)db * L * 1024) + rem); } }
    }
}
__device__ __forceinline__ void p0_prologue(const Frame& F, const Args& A) {
    unsigned char* ws = A.ws;
    LAS float* scr = (LAS float*)(F.lds + RING_OFF + F.wave * 16384);
    const int gw = F.vcu * NWAVES + F.wave, NGW = F.G * NWAVES;
    constexpr int I_IN = (1024 / 64) * (DIN / 32), I_LRU = 16 * 32, I_ATT = (512 / 64) * 32, I_OUT = 16 * 32, I_G = 8 * (2 * 4);
    constexpr int NITEMS = I_IN + I_LRU + I_ATT + I_OUT + 2 * I_G;
    for (int it = gw; it < NITEMS; it += NGW) {
        int r = it;
        if (r < I_IN) { p0_transpose_item(A.in[8], 1024, DIN, (bf16*)(ws + WS_WIN), scr, r, F.lane); continue; } r -= I_IN;
        if (r < I_LRU) { p0_transpose_item(A.in[20], 1024, 1024, (bf16*)(ws + WS_WLRU), scr, r, F.lane); continue; } r -= I_LRU;
        if (r < I_ATT) { p0_transpose_item(A.in[21], 512, 1024, (bf16*)(ws + WS_WATT), scr, r, F.lane); continue; } r -= I_ATT;
        if (r < I_OUT) { p0_transpose_item(A.in[22], 1024, 1024, (bf16*)(ws + WS_WOUT), scr, r, F.lane); continue; } r -= I_OUT;
        if (r < I_G) { const int n = r >> 3; p0_transpose_item(A.in[12] + n * 16384, 128, 128, (bf16*)(ws + WS_WA) + n * 16384, scr, r & 7, F.lane); continue; } r -= I_G;
        { const int n = r >> 3; p0_transpose_item(A.in[14] + n * 16384, 128, 128, (bf16*)(ws + WS_WX) + n * 16384, scr, r & 7, F.lane); }
    }
    {
        const float* gn = A.in[7]; bf16* XN = (bf16*)(ws + WS_XN);
        f32x4 gv[4];
#pragma unroll
        for (int j = 0; j < 4; ++j) gv[j] = ((const f32x4*)gn)[F.lane + 64 * j];
        for (int m = gw; m < MT; m += NGW) {
            const float* xrow = (m < MP) ? A.in[0] + (size_t)m * 1024 : A.in[1] + (size_t)(m - MP) * 1024;
            const f32x4* xr = (const f32x4*)xrow + F.lane;
            f32x4 v[4]; float s = 0.f;
#pragma unroll
            for (int j = 0; j < 4; ++j) { v[j] = xr[64 * j]; s += (v[j].x * v[j].x + v[j].y * v[j].y) + (v[j].z * v[j].z + v[j].w * v[j].w); }
            const float rs = 1.f / sqrtf(wave_sum(s) * (1.f / 1024.f) + 1e-6f);
            unsigned long long* o8 = (unsigned long long*)(XN + (size_t)m * 1024) + F.lane;
#pragma unroll
            for (int j = 0; j < 4; ++j) { const f32x4 y = v[j] * rs * gv[j]; o8[64 * j] = (unsigned long long)cvtpk(y.x, y.y) | ((unsigned long long)cvtpk(y.z, y.w) << 32); }
        }
    }
    {
        const int gt = F.vcu * 512 + F.tid;
        if (gt < NHEAD * TABW) {
            const int h = gt / TABW, idx = gt % TABW, dist = idx - 31, g = h >> 2, dil = 1 << (2 * g);
            float v = -INFINITY;
            if (dist >= 0 && dist <= 128) v = A.in[19][t5_bucket(dist * dil) * NHEAD + h] * LOG2E;
            ((float*)(ws + WS_BT))[gt] = v;
        }
    }
    {
        const unsigned gt = (unsigned)F.vcu * 512u + F.tid, nt = (unsigned)F.G * 512u;
        copy_region<128>(A.in[2], A.out + O_KV128S, gt, nt);
        copy_region<512>(A.in[3], A.out + O_KV512S, gt, nt);
        copy_region<2048>(A.in[4], A.out + O_KV2048S, gt, nt);
    }
}

constexpr int AT_K = 0, AT_V = 65536;
__device__ __forceinline__ void attn_prompt_unit(const Frame& F, const Args& A, int u) {
    unsigned char* ws = A.ws;
    const bf16* Qb = (const bf16*)(ws + WS_Q); const bf16* Kb = (const bf16*)(ws + WS_K); const bf16* Vb = (const bf16*)(ws + WS_V);
    bf16* Ob = (bf16*)(ws + WS_O); float* LSE = (float*)(ws + WS_LSE);
    const int b = u / 192, rem = u % 192, h = rem >> 4, x = rem & 15, g = h >> 2, dsh = 2 * g, dil = 1 << dsh, r = x & (dil - 1), n = x >> dsh;
    const int lane = F.lane, wave = F.wave, l15 = lane & 15, g4 = lane >> 4;
    LAS float* TAB = (LAS float*)(F.lds + TAB_OFF);
    if (F.tid < TABW) TAB[F.tid] = ((const float*)(ws + WS_BT))[h * TABW + F.tid];
    const int klo = (n == 0) ? 128 : 0;
#pragma unroll
    for (int i = 0; i < 8; ++i) {
        const int inst = wave * 8 + i, row0 = 4 * inst;
        if (row0 >= klo) {
            const int row = row0 + g4, ch = l15 ^ (((row & 3) << 2) | ((row >> 2) & 3));
            const int t = (((n - 1) * 128 + row) << dsh) + r;
            const size_t eoff = ((size_t)(b * 2048 + t) * DQKV + h * 128) + ch * 8;
            __builtin_amdgcn_global_load_lds((const unsigned*)(Kb + eoff), (LAS unsigned*)(F.lds + AT_K + inst * 1024), 16, 0, 0);
            __builtin_amdgcn_global_load_lds((const unsigned*)(Vb + eoff), (LAS unsigned*)(F.lds + AT_V + inst * 1024), 16, 0, 0);
        }
    }
    const int qi = 16 * wave + l15, tq = ((n * 128 + qi) << dsh) + r;
    const size_t qrow = (size_t)(b * 2048 + tq);
    bf16x8 qf[4];
#pragma unroll
    for (int s = 0; s < 4; ++s) qf[s] = *(const bf16x8*)(Qb + qrow * DQKV + h * 128 + 32 * s + 8 * g4);
    VM_WAIT(); __syncthreads();
    const int kb0 = 32 * (wave >> 1);
    f32x4 sc[5][2];
#pragma unroll
    for (int ss = 0; ss < 5; ++ss) {
        const int kb = kb0 + 32 * ss;
        if (kb < klo) { sc[ss][0] = (f32x4){-INFINITY, -INFINITY, -INFINITY, -INFINITY}; sc[ss][1] = sc[ss][0]; continue; }
#pragma unroll
        for (int t = 0; t < 2; ++t) {
            const unsigned key = kb + 8 * (l15 >> 2) + 4 * t + (l15 & 3);
            f32x4 acc = (f32x4){0.f, 0.f, 0.f, 0.f};
#pragma unroll
            for (int s = 0; s < 4; ++s) { const bf16x8 a = *(const LAS bf16x8*)(F.lds + AT_K + off_b(key, 4 * s + g4)); acc = __builtin_amdgcn_mfma_f32_16x16x32_bf16(a, qf[s], acc, 0, 0, 0); }
            const int d0 = qi + 128 - (kb + 8 * g4 + 4 * t) + 31;
#pragma unroll
            for (int e = 0; e < 4; ++e) acc[e] += TAB[d0 - e];
            sc[ss][t] = acc;
        }
    }
    float mx = -INFINITY;
#pragma unroll
    for (int ss = 0; ss < 5; ++ss)
#pragma unroll
        for (int t = 0; t < 2; ++t)
#pragma unroll
            for (int e = 0; e < 4; ++e) mx = fmaxf(mx, sc[ss][t][e]);
    mx = fmaxf(mx, __shfl_xor(mx, 16)); mx = fmaxf(mx, __shfl_xor(mx, 32));
    float sum = 0.f; bf16x8 pf[5];
#pragma unroll
    for (int ss = 0; ss < 5; ++ss) {
        float p[8];
#pragma unroll
        for (int t = 0; t < 2; ++t)
#pragma unroll
            for (int e = 0; e < 4; ++e) { p[4 * t + e] = __builtin_amdgcn_exp2f(sc[ss][t][e] - mx); sum += p[4 * t + e]; }
        v4u w; w.x = cvtpk(p[0], p[1]); w.y = cvtpk(p[2], p[3]); w.z = cvtpk(p[4], p[5]); w.w = cvtpk(p[6], p[7]);
        pf[ss] = __builtin_bit_cast(bf16x8, w);
    }
    sum += __shfl_xor(sum, 16); sum += __shfl_xor(sum, 32);
    const float inv = 1.0f / sum;
    const unsigned q4 = l15 >> 2, p4 = lane & 3;
#pragma unroll
    for (int c = 0; c < 8; ++c) {
        f32x4 acc = (f32x4){0.f, 0.f, 0.f, 0.f};
#pragma unroll
        for (int ss = 0; ss < 5; ++ss) {
            const int kb = kb0 + 32 * ss;
            if (kb < klo) continue;
            const unsigned a0 = AT_V + off_b(kb + 8 * g4 + q4, 2 * c + (p4 >> 1)) + 8 * (p4 & 1);
            const unsigned a1 = AT_V + off_b(kb + 8 * g4 + 4 + q4, 2 * c + (p4 >> 1)) + 8 * (p4 & 1);
            const v4i16_t lo = __builtin_amdgcn_ds_read_tr16_b64_v4i16((LAS v4i16_t*)(F.lds + a0));
            const v4i16_t hi = __builtin_amdgcn_ds_read_tr16_b64_v4i16((LAS v4i16_t*)(F.lds + a1));
            const bf16x8 vf = (bf16x8){lo[0], lo[1], lo[2], lo[3], hi[0], hi[1], hi[2], hi[3]};
            acc = __builtin_amdgcn_mfma_f32_16x16x32_bf16(vf, pf[ss], acc, 0, 0, 0);
        }
        acc = acc * inv;
        u32x2 w; w.x = cvtpk(acc[0], acc[1]); w.y = cvtpk(acc[2], acc[3]);
        *(u32x2*)(Ob + qrow * DQKV + h * 128 + 16 * c + 4 * g4) = w;
    }
    if (g4 == 0) LSE[qrow * NHEAD + h] = (mx + __builtin_amdgcn_logf(sum)) * LN2;
    __syncthreads();
}

constexpr int LR_XCF = 0, LR_XCB = 65536;
__device__ __forceinline__ void lru_item(const Frame& F, const Args& A, int it) {
    unsigned char* ws = A.ws;
    const bf16* XA = (const bf16*)(ws + WS_XA); bf16* HL = (bf16*)(ws + WS_HL); bf16* PP = (bf16*)(ws + WS_PP);
    float* PEND = (float*)(ws + WS_PEND); float* HEND = (float*)(ws + WS_HEND);
    const bool prompt = it < 1024;
    const int n = it & 7; int b = 0, c = 0, cs = 0;
    if (prompt) { b = it >> 7; c = (it >> 3) & 15; } else cs = (it - 1024) >> 3;
    const int m0 = prompt ? b * 2048 + c * 128 : MP + cs * 128, cidx = prompt ? b * 16 + c : 128 + cs;
    const int lane = F.lane, wave = F.wave, l15 = lane & 15, g4 = lane >> 4, tid = F.tid;
    LAS float* XCF = (LAS float*)(F.lds + LR_XCF);
    {
        const int tg = tid >> 4, c8 = tid & 15, ch0 = n * 128 + 8 * c8;
        float xin[7][8];
#pragma unroll
        for (int j = 0; j < 7; ++j) {
            const int trel = 4 * tg - 3 + j;
            const bool from_xa = prompt ? (c * 128 + trel >= 0) : (((tg & 1) != 0) || j >= 3);
            if (from_xa) { const v4u w = *(const v4u*)(XA + (size_t)(m0 + trel) * 1024 + ch0);
                xin[j][0] = bflo(w.x); xin[j][1] = bfhi(w.x); xin[j][2] = bflo(w.y); xin[j][3] = bfhi(w.y); xin[j][4] = bflo(w.z); xin[j][5] = bfhi(w.z); xin[j][6] = bflo(w.w); xin[j][7] = bfhi(w.w); }
            else if (!prompt) { const int db = (cs * 128 + 4 * tg) >> 3; const float* sp = A.in[5] + ((size_t)db * 3 + j) * 1024 + ch0; const f32x4 a = *(const f32x4*)sp, bq = *(const f32x4*)(sp + 4);
                xin[j][0] = a[0]; xin[j][1] = a[1]; xin[j][2] = a[2]; xin[j][3] = a[3]; xin[j][4] = bq[0]; xin[j][5] = bq[1]; xin[j][6] = bq[2]; xin[j][7] = bq[3]; }
            else {
#pragma unroll
                for (int e = 0; e < 8; ++e) xin[j][e] = 0.f; }
        }
        float cw[4][8], cb[8];
#pragma unroll
        for (int jj = 0; jj < 4; ++jj) { const f32x4 a = *(const f32x4*)(A.in[10] + jj * 1024 + ch0), bq = *(const f32x4*)(A.in[10] + jj * 1024 + ch0 + 4);
            cw[jj][0] = a[0]; cw[jj][1] = a[1]; cw[jj][2] = a[2]; cw[jj][3] = a[3]; cw[jj][4] = bq[0]; cw[jj][5] = bq[1]; cw[jj][6] = bq[2]; cw[jj][7] = bq[3]; }
        { const f32x4 a = *(const f32x4*)(A.in[11] + ch0), bq = *(const f32x4*)(A.in[11] + ch0 + 4); cb[0] = a[0]; cb[1] = a[1]; cb[2] = a[2]; cb[3] = a[3]; cb[4] = bq[0]; cb[5] = bq[1]; cb[6] = bq[2]; cb[7] = bq[3]; }
#pragma unroll
        for (int i = 0; i < 4; ++i) {
            float y[8];
#pragma unroll
            for (int e = 0; e < 8; ++e) y[e] = cb[e] + ((cw[0][e] * xin[i][e] + cw[1][e] * xin[i + 1][e]) + (cw[2][e] * xin[i + 2][e] + cw[3][e] * xin[i + 3][e]));
            const int tok = 4 * tg + i;
            *(LAS f32x4*)(XCF + tok * 128 + 8 * c8) = (f32x4){y[0], y[1], y[2], y[3]};
            *(LAS f32x4*)(XCF + tok * 128 + 8 * c8 + 4) = (f32x4){y[4], y[5], y[6], y[7]};
            v4u w; w.x = cvtpk(y[0], y[1]); w.y = cvtpk(y[2], y[3]); w.z = cvtpk(y[4], y[5]); w.w = cvtpk(y[6], y[7]);
            *(LAS v4u*)(F.lds + LR_XCB + off_b(tok, c8)) = w;
        }
    }
    const int chl = 16 * wave + l15, ch = n * 128 + chl;
    bf16x8 wa[4], wx[4];
    {
        const bf16* WA = (const bf16*)(ws + WS_WA) + n * 16384 + chl * 128 + 8 * g4; const bf16* WX = (const bf16*)(ws + WS_WX) + n * 16384 + chl * 128 + 8 * g4;
#pragma unroll
        for (int s = 0; s < 4; ++s) { wa[s] = *(const bf16x8*)(WA + 32 * s); wx[s] = *(const bf16x8*)(WX + 32 * s); }
    }
    const float ba = A.in[13][ch], bx = A.in[15][ch];
    const float lam = A.in[16][ch];
    const float sp8 = -8.0f * log1pf(expf(-lam));
    __syncthreads();
    float Hin = 0.f, Pin = 1.f;
#pragma unroll 1
    for (int tb = 0; tb < 8; ++tb) {
        f32x4 ga = (f32x4){0.f, 0.f, 0.f, 0.f}, gx = ga;
#pragma unroll
        for (int s = 0; s < 4; ++s) {
            const bf16x8 a = *(const LAS bf16x8*)(F.lds + LR_XCB + off_b(16 * tb + l15, 4 * s + g4));
            ga = __builtin_amdgcn_mfma_f32_16x16x32_bf16(a, wa[s], ga, 0, 0, 0);
            gx = __builtin_amdgcn_mfma_f32_16x16x32_bf16(a, wx[s], gx, 0, 0, 0);
        }
        float av[4], uv[4];
#pragma unroll
        for (int e = 0; e < 4; ++e) {
            const int tok = 16 * tb + 4 * g4 + e;
            const float rr = pg8::sigmoid_f(ga[e] + ba), ii = pg8::sigmoid_f(gx[e] + bx);
            const float la = sp8 * rr;
            float a = expf(la);
            const float mult = sqrtf(-expm1f(2.0f * la));
            float uu = mult * (ii * XCF[tok * 128 + chl]);
            if (!prompt && e == 0 && (g4 & 1) == 0) { const int db = (cs * 128 + tok) >> 3; uu = a * A.in[6][(size_t)db * 1024 + ch] + uu; a = 0.f; }
            av[e] = a; uv[e] = uu;
        }
        float Ac[4], Uc[4];
        Ac[0] = av[0]; Uc[0] = uv[0];
#pragma unroll
        for (int e = 1; e < 4; ++e) { Ac[e] = av[e] * Ac[e - 1]; Uc[e] = av[e] * Uc[e - 1] + uv[e]; }
        float hst = Hin, pst = Pin, hrun = Hin, prun = Pin;
#pragma unroll
        for (int gg = 0; gg < 4; ++gg) {
            const float ar = __shfl(Ac[3], l15 + 16 * gg), ur = __shfl(Uc[3], l15 + 16 * gg);
            if (g4 == gg) { hst = hrun; pst = prun; }
            hrun = ar * hrun + ur; prun = ar * prun;
        }
        Hin = hrun; Pin = prun;
#pragma unroll
        for (int e = 0; e < 4; ++e) {
            const int tok = 16 * tb + 4 * g4 + e;
            const float hh = Ac[e] * hst + Uc[e], pp = Ac[e] * pst;
            HL[(size_t)(m0 + tok) * 1024 + ch] = (bf16)(cvtpk(hh, 0.f) & 0xffffu);
            PP[(size_t)(m0 + tok) * 1024 + ch] = (bf16)(cvtpk(pp, 0.f) & 0xffffu);
            if (!prompt && e == 3 && (g4 & 1) == 1) { const int db = (cs * 128 + tok) >> 3; A.out[O_HS + (size_t)db * 1024 + ch] = hh; }
        }
    }
    if (g4 == 0) { PEND[cidx * 1024 + ch] = Pin; HEND[cidx * 1024 + ch] = Hin; }
    __syncthreads();
}

__device__ __forceinline__ void attn_sample_item(const Frame& F, const Args& A, int it) {
    unsigned char* ws = A.ws;
    const int db = it / 24, rem = it % 24, g = rem >> 3, t = rem & 7, dil = 1 << (2 * g), L = 128 * dil;
    const int lane = F.lane, wave = F.wave, hh = lane >> 4, d0 = 8 * (lane & 15);
    const float* cache = A.in[2 + g]; const float* newkv = A.out + (g == 0 ? O_KV128S : (g == 1 ? O_KV512S : O_KV2048S));
    const size_t qrow = (size_t)(MP + db * 8 + t);
    float q[8];
    { const v4u w = *(const v4u*)((const bf16*)(ws + WS_Q) + qrow * DQKV + (g * 4 + hh) * 128 + d0);
      q[0] = bflo(w.x); q[1] = bfhi(w.x); q[2] = bflo(w.y); q[3] = bfhi(w.y); q[4] = bflo(w.z); q[5] = bfhi(w.z); q[6] = bflo(w.w); q[7] = bfhi(w.w); }
    const float* bt = (const float*)(ws + WS_BT) + (g * 4 + hh) * TABW + 31;
    float m = -INFINITY, l = 0.f, o[8];
#pragma unroll
    for (int e = 0; e < 8; ++e) o[e] = 0.f;
#pragma unroll 1
    for (int jb = 0; jb < 5; ++jb) {
        f32x4 kv[4][4];
#pragma unroll
        for (int i = 0; i < 4; ++i) {
            const int j = wave + 8 * (4 * jb + i);
            if (j <= 128) {
                const int idx = L + t - dil * j;
                const float* rowp = (idx < L) ? cache + ((size_t)db * L + idx) * 1024 : newkv + ((size_t)db * L + idx - 8) * 1024;
                kv[i][0] = *(const f32x4*)(rowp + hh * 128 + d0); kv[i][1] = *(const f32x4*)(rowp + hh * 128 + d0 + 4);
                kv[i][2] = *(const f32x4*)(rowp + 512 + hh * 128 + d0); kv[i][3] = *(const f32x4*)(rowp + 512 + hh * 128 + d0 + 4);
            }
        }
#pragma unroll
        for (int i = 0; i < 4; ++i) {
            const int j = wave + 8 * (4 * jb + i);
            if (j <= 128) {
                float s = (q[0] * kv[i][0][0] + q[1] * kv[i][0][1]) + (q[2] * kv[i][0][2] + q[3] * kv[i][0][3]) + (q[4] * kv[i][1][0] + q[5] * kv[i][1][1]) + (q[6] * kv[i][1][2] + q[7] * kv[i][1][3]);
                s += __shfl_xor(s, 1); s += __shfl_xor(s, 2); s += __shfl_xor(s, 4); s += __shfl_xor(s, 8);
                s += bt[j];
                const float mn = fmaxf(m, s), corr = __builtin_amdgcn_exp2f(m - mn), p = __builtin_amdgcn_exp2f(s - mn);
                l = l * corr + p; m = mn;
#pragma unroll
                for (int e = 0; e < 4; ++e) { o[e] = o[e] * corr + p * kv[i][2][e]; o[4 + e] = o[4 + e] * corr + p * kv[i][3][e]; }
            }
        }
    }
    LAS float* MO = (LAS float*)(F.lds);
    LAS float* MM = MO + 8 * 512; LAS float* ML = MM + 32;
    *(LAS f32x4*)(MO + wave * 512 + hh * 128 + d0) = (f32x4){o[0], o[1], o[2], o[3]};
    *(LAS f32x4*)(MO + wave * 512 + hh * 128 + d0 + 4) = (f32x4){o[4], o[5], o[6], o[7]};
    if ((lane & 15) == 0) { MM[wave * 4 + hh] = m; ML[wave * 4 + hh] = l; }
    __syncthreads();
    {
        const int h2 = F.tid >> 7;
        float M = -INFINITY;
#pragma unroll
        for (int w = 0; w < 8; ++w) M = fmaxf(M, MM[w * 4 + h2]);
        float Ls = 0.f, os = 0.f;
#pragma unroll
        for (int w = 0; w < 8; ++w) { const float f = __builtin_amdgcn_exp2f(MM[w * 4 + h2] - M); Ls += ML[w * 4 + h2] * f; os += MO[w * 512 + F.tid] * f; }
        ((bf16*)(ws + WS_O))[qrow * DQKV + g * 512 + F.tid] = (bf16)(cvtpk(os / Ls, 0.f) & 0xffffu);
        if ((F.tid & 127) == 0) ((float*)(ws + WS_LSE))[qrow * NHEAD + g * 4 + h2] = (M + __builtin_amdgcn_logf(Ls)) * LN2;
    }
    __syncthreads();
}

__device__ __forceinline__ void a1_item(const Frame& F, const Args& A, int cidx) {
    unsigned char* ws = A.ws;
    const bf16* HL = (const bf16*)(ws + WS_HL); const bf16* PP = (const bf16*)(ws + WS_PP); const bf16* SGA = (const bf16*)(ws + WS_SGA); bf16* A1 = (bf16*)(ws + WS_A1);
    const float* PEND = (const float*)(ws + WS_PEND); const float* HEND = (const float*)(ws + WS_HEND);
    const bool prompt = cidx < 128; const int b = cidx >> 4, c = cidx & 15;
    const int m0 = prompt ? b * 2048 + c * 128 : MP + (cidx - 128) * 128;
    const int ch0 = 4 * (F.tid & 255), half = F.tid >> 8;
    f32x4 H = (f32x4){0.f, 0.f, 0.f, 0.f};
    if (prompt) {
        for (int cc = 0; cc < c; ++cc) { const f32x4 p = *(const f32x4*)(PEND + (b * 16 + cc) * 1024 + ch0), hh = *(const f32x4*)(HEND + (b * 16 + cc) * 1024 + ch0); H = p * H + hh; }
        if (c == 15 && half == 0) { const f32x4 p = *(const f32x4*)(PEND + cidx * 1024 + ch0), hh = *(const f32x4*)(HEND + cidx * 1024 + ch0); *(f32x4*)(A.out + O_HP + b * 1024 + ch0) = p * H + hh; }
    }
#pragma unroll 4
    for (int i = 0; i < 64; ++i) {
        const size_t off = (size_t)(m0 + half * 64 + i) * 1024 + ch0;
        const u32x2 hl = *(const u32x2*)(HL + off), pp = *(const u32x2*)(PP + off), sg = *(const u32x2*)(SGA + off);
        const float h0 = (bflo(hl.x) + bflo(pp.x) * H[0]) * bflo(sg.x), h1 = (bfhi(hl.x) + bfhi(pp.x) * H[1]) * bfhi(sg.x);
        const float h2 = (bflo(hl.y) + bflo(pp.y) * H[2]) * bflo(sg.y), h3 = (bfhi(hl.y) + bfhi(pp.y) * H[3]) * bfhi(sg.y);
        u32x2 w; w.x = cvtpk(h0, h1); w.y = cvtpk(h2, h3);
        *(u32x2*)(A1 + off) = w;
    }
}
__device__ __forceinline__ void a2_item(const Frame& F, const Args& A, int it) {
    unsigned char* ws = A.ws;
    const bf16* Ob = (const bf16*)(ws + WS_O); const float* LSE = (const float*)(ws + WS_LSE); const bf16* SGB = (const bf16*)(ws + WS_SGB); bf16* A2 = (bf16*)(ws + WS_A2);
    const int tl = F.tid >> 6, k = F.tid & 63, hh = k >> 4, d0 = 8 * (k & 15);
#pragma unroll 2
    for (int i = 0; i < 8; ++i) {
        const size_t m = (size_t)it * 64 + i * 8 + tl;
        const float l0 = LSE[m * NHEAD + hh], l1 = LSE[m * NHEAD + 4 + hh], l2 = LSE[m * NHEAD + 8 + hh];
        const float mx = fmaxf(l0, fmaxf(l1, l2));
        float w0 = __builtin_amdgcn_exp2f((l0 - mx) * LOG2E), w1 = __builtin_amdgcn_exp2f((l1 - mx) * LOG2E), w2 = __builtin_amdgcn_exp2f((l2 - mx) * LOG2E);
        const float inv = 1.0f / (w0 + w1 + w2); w0 *= inv; w1 *= inv; w2 *= inv;
        const v4u o0 = *(const v4u*)(Ob + m * DQKV + hh * 128 + d0), o1 = *(const v4u*)(Ob + m * DQKV + (4 + hh) * 128 + d0), o2 = *(const v4u*)(Ob + m * DQKV + (8 + hh) * 128 + d0);
        const v4u sg = *(const v4u*)(SGB + m * DAO + hh * 128 + d0);
        v4u w;
        w.x = cvtpk((w0 * bflo(o0.x) + w1 * bflo(o1.x) + w2 * bflo(o2.x)) * bflo(sg.x), (w0 * bfhi(o0.x) + w1 * bfhi(o1.x) + w2 * bfhi(o2.x)) * bfhi(sg.x));
        w.y = cvtpk((w0 * bflo(o0.y) + w1 * bflo(o1.y) + w2 * bflo(o2.y)) * bflo(sg.y), (w0 * bfhi(o0.y) + w1 * bfhi(o1.y) + w2 * bfhi(o2.y)) * bfhi(sg.y));
        w.z = cvtpk((w0 * bflo(o0.z) + w1 * bflo(o1.z) + w2 * bflo(o2.z)) * bflo(sg.z), (w0 * bfhi(o0.z) + w1 * bfhi(o1.z) + w2 * bfhi(o2.z)) * bfhi(sg.z));
        w.w = cvtpk((w0 * bflo(o0.w) + w1 * bflo(o1.w) + w2 * bflo(o2.w)) * bflo(sg.w), (w0 * bfhi(o0.w) + w1 * bfhi(o1.w) + w2 * bfhi(o2.w)) * bfhi(sg.w));
        *(v4u*)(A2 + m * DAO + hh * 128 + d0) = w;
    }
}

constexpr int NPHASE = 6;
#ifndef MK_N_LAUNCHES
#define MK_N_LAUNCHES 6
#endif
__global__ void __launch_bounds__(NWAVES * 64, 2) mixer_fwd(Args args) {
    extern __shared__ __attribute__((aligned(16))) unsigned char lds[];
    Frame F;
    F.lds = (LAS unsigned char*)lds;
    F.tid = threadIdx.x; F.lane = F.tid & 63; F.wave = __builtin_amdgcn_readfirstlane(F.tid >> 6);
    F.G = gridDim.x; { const int bx = blockIdx.x; F.vcu = (F.G % 8 == 0) ? (bx % 8) * (F.G / 8) + bx / 8 : bx; }
    unsigned char* ws = args.ws;
    volatile LAS unsigned* MISC = (volatile LAS unsigned*)(F.lds + MISC_OFF);
    if (F.tid < 32) MISC[F.tid] = 0u;
    __syncthreads();
    XcdBarrier bar; bar.bar = (unsigned*)(ws + WS_CTL) + CW_BAR; bar.x = 0; bar.st = nullptr;
    if (MK_N_LAUNCHES == 1) bar = xcd_barrier_post((unsigned*)(ws + WS_CTL) + CW_BAR, MISC + 8);
    const int lo = args.ph_lo, hi = args.ph_hi;
#define IN(k) (lo <= (k) && (k) < hi)
#define SEAM(k) do { if (IN(k) && IN((k) + 1)) xcd_barrier(bar); } while (0)

    if (IN(0)) { p0_prologue(F, args); }
    SEAM(0);
    if (IN(1)) {
        pg8::Gemm g{(const bf16*)(ws + WS_XN), (const bf16*)(ws + WS_WIN), MT, DIN, 1024}; pg8::StaticOrder S; S.init(MT, DIN, F.G, (int)blockIdx.x);
        pg8::EpiIn E;
        E.XA = (bf16*)(ws + WS_XA); E.SGA = (bf16*)(ws + WS_SGA); E.Q = (bf16*)(ws + WS_Q); E.Kb = (bf16*)(ws + WS_K); E.Vb = (bf16*)(ws + WS_V); E.SGB = (bf16*)(ws + WS_SGB); E.GM = (bf16*)(ws + WS_GM);
        E.out = args.out; E.b_merge = args.in[9]; E.g_q = args.in[17]; E.g_k = args.in[18]; E.scr = (LAS float*)(F.lds + EPI_OFF); E.qscale = QSCALE;
        E.o_kv128p = O_KV128P; E.o_kv512p = O_KV512P; E.o_kv2048p = O_KV2048P; E.o_convp = O_CONVP; E.o_kv128s = O_KV128S; E.o_kv512s = O_KV512S; E.o_kv2048s = O_KV2048S; E.o_convs = O_CONVS;
        pg8::gemm_phase<pg8::EpiIn, pg8::StaticOrder, true, true>(F.lds + RING_OFF, g, S, E);
    }
    SEAM(1);
    if (IN(2)) {
        for (int u = blockIdx.x; u < 1536; u += F.G) attn_prompt_unit(F, args, u);
        for (int it = (blockIdx.x + 64) % F.G; it < 1040; it += F.G) lru_item(F, args, it);
        for (int it = (blockIdx.x + 128) % F.G; it < 768; it += F.G) attn_sample_item(F, args, it);
    }
    SEAM(2);
    if (IN(3)) {
        for (int it = blockIdx.x; it < 130; it += F.G) a1_item(F, args, it);
        for (int it = (blockIdx.x + 130) % F.G; it < 260; it += F.G) a2_item(F, args, it);
    }
    SEAM(3);
    if (IN(4)) {
        { pg8::Gemm g{(const bf16*)(ws + WS_A1), (const bf16*)(ws + WS_WLRU), MT, 1024, 1024}; pg8::StaticOrder S; S.init(MT, 1024, F.G, (int)blockIdx.x);
          pg8::EpiG1 E{(const bf16*)(ws + WS_GM), (float*)(ws + WS_T1)};
          pg8::gemm_phase<pg8::EpiG1, pg8::StaticOrder, true, true>(F.lds + RING_OFF, g, S, E); }
        { pg8::Gemm g{(const bf16*)(ws + WS_A2), (const bf16*)(ws + WS_WATT), MT, 1024, 512}; pg8::StaticOrder S; S.init(MT, 1024, F.G, (int)blockIdx.x);
          pg8::EpiG2 E{(const bf16*)(ws + WS_GM), (const float*)(ws + WS_T1), (bf16*)(ws + WS_MG)};
          pg8::gemm_phase<pg8::EpiG2, pg8::StaticOrder, true, true>(F.lds + RING_OFF, g, S, E); }
    }
    SEAM(4);
    if (IN(5)) {
        pg8::Gemm g{(const bf16*)(ws + WS_MG), (const bf16*)(ws + WS_WOUT), MT, 1024, 1024}; pg8::StaticOrder S; S.init(MT, 1024, F.G, (int)blockIdx.x);
        pg8::EpiOut E{args.in[0], args.in[1], args.out};
        pg8::gemm_phase<pg8::EpiOut, pg8::StaticOrder, true, true>(F.lds + RING_OFF, g, S, E);
    }
#undef IN
#undef SEAM
}

extern "C" void kernel_launch(void* const* d_in, const int* in_sizes, int n_in, void* d_out, int out_size, void* d_ws, size_t ws_size, hipStream_t stream) {
    static int grid = 0;
    if (grid == 0) {
        if (n_in != 23 || (size_t)out_size != O_END || ws_size < WS_END) { fprintf(stderr, "kernel_launch: unexpected shapes: n_in %d out %d (want %zu) ws %zu (want >= %zu)\n", n_in, out_size, (size_t)O_END, ws_size, (size_t)WS_END); grid = -1; return; }
        int dev = 0, cus = 0;
        if (hipGetDevice(&dev) != hipSuccess || hipDeviceGetAttribute(&cus, hipDeviceAttributeMultiprocessorCount, dev) != hipSuccess) { grid = -1; return; }
        if (hipFuncSetAttribute((const void*)mixer_fwd, hipFuncAttributeMaxDynamicSharedMemorySize, LDS_BYTES) != hipSuccess) { fprintf(stderr, "kernel_launch: hipFuncSetAttribute failed\n"); grid = -1; return; }
        (void)hipGetLastError();
        grid = cus;
    }
    if (grid < 0) return;
    if (hipMemsetAsync((char*)d_ws + WS_CTL, 0, CTL_ZERO_BYTES, stream) != hipSuccess) return;
    Args a{};
    for (int i = 0; i < 23; ++i) a.in[i] = (const float*)d_in[i];
    a.out = (float*)d_out; a.ws = (unsigned char*)d_ws;
    if (MK_N_LAUNCHES == 1) { a.ph_lo = 0; a.ph_hi = NPHASE; hipLaunchKernelGGL(mixer_fwd, dim3(grid), dim3(NWAVES * 64), LDS_BYTES, stream, a); }
    else for (int p = 0; p < NPHASE; ++p) { a.ph_lo = p; a.ph_hi = p + 1; hipLaunchKernelGGL(mixer_fwd, dim3(grid), dim3(NWAVES * 64), LDS_BYTES, stream, a); }
}
```

```cpp
#include <hip/hip_runtime.h>
#include <cstdio>
#include <cstdint>
#include <cmath>
namespace pg8 {
#define PG8_LAS __attribute__((address_space(3)))
typedef unsigned short bf16_t;
typedef short bf16x8 __attribute__((ext_vector_type(8)));
typedef float f32x4 __attribute__((ext_vector_type(4)));
typedef unsigned u32x4 __attribute__((ext_vector_type(4)));
constexpr int BM = 256, BK = 64, HALF = 128, HTB = HALF * BK * 2  , STAGE_BYTES = 8 * HTB, NXCD = 8, WGM = 2;

__host__ __device__ __forceinline__ int lds_byte(int r, int c) { const int st = (r >> 4) * 2 + (c >> 5), rr = r & 15, cc = c & 31, ob = rr * 64 + cc * 2; return st * 1024 + (ob ^ (((ob >> 9) & 1) << 5)); }
__host__ __device__ __forceinline__ void stage_rc(int b, int& R, int& C) { const int st = b / 1024, sb = b % 1024, swz = sb ^ (((sb >> 9) & 1) << 5); R = (st >> 1) * 16 + swz / 64; C = (st & 1) * 32 + (swz % 64) / 2; }
__host__ __device__ __forceinline__ int perm32(int rho) { const int n = rho >> 4, i = rho & 15; return 8 * (i >> 2) + 4 * n + (i & 3); }

struct Unit { int pm, pn; };
struct Gemm { const bf16_t* A; const bf16_t* Bt; int M, N, K; };

struct StaticOrder {
    int nM, nN, nwg, G, c;
    __host__ __device__ void init(int M, int N, int G_, int c_) { nM = M / BM; nN = N / BM; nwg = nM * nN; G = G_; c = c_; }
    __host__ __device__ bool next(int i, Unit& u) const {
        const long L = (long)i * G + c; if (L >= nwg) return false;
        int wgid = (int)L; { const int q = nwg / NXCD, r = nwg % NXCD, xcd = wgid % NXCD, off = wgid / NXCD; wgid = (xcd < r ? xcd * (q + 1) : r * (q + 1) + (xcd - r) * q) + off; }
        const int nig = WGM * nN, gid = wgid / nig, fm = gid * WGM, gsz = (nM - fm) < WGM ? (nM - fm) : WGM;
        u.pm = fm + ((wgid % nig) % gsz); u.pn = (wgid % nig) / gsz; return true;
    }
    __device__ __forceinline__ void a_ready(const Unit&) const {}
    __device__ __forceinline__ void done(const Unit&) const {}
};


__device__ __forceinline__ unsigned cvt_pk_bf16(float lo, float hi) { unsigned r; asm volatile("v_cvt_pk_bf16_f32 %0, %1, %2" : "=v"(r) : "v"(lo), "v"(hi)); return r; }
__device__ __forceinline__ float bf_lo(unsigned w) { return __uint_as_float(w << 16); }
__device__ __forceinline__ float bf_hi(unsigned w) { return __uint_as_float(w & 0xffff0000u); }
__device__ __forceinline__ float sigmoid_f(float x) { return __builtin_amdgcn_rcpf(1.0f + __builtin_amdgcn_exp2f(-1.4426950408889634f * x)); }
__device__ __forceinline__ float silu_f(float x) { return x * sigmoid_f(x); }
__device__ __forceinline__ float sum_fq(float s) {
    { const auto r = __builtin_amdgcn_permlane16_swap(__float_as_uint(s), __float_as_uint(s), false, false); s = __uint_as_float(r[0]) + __uint_as_float(r[1]); }
    { const auto r = __builtin_amdgcn_permlane32_swap(__float_as_uint(s), __float_as_uint(s), false, false); s = __uint_as_float(r[0]) + __uint_as_float(r[1]); }
    return s;
}
__device__ __forceinline__ u32x4 pack8(const f32x4& a, const f32x4& b) { u32x4 w; w.x = cvt_pk_bf16(a[0], a[1]); w.y = cvt_pk_bf16(a[2], a[3]); w.z = cvt_pk_bf16(b[0], b[1]); w.w = cvt_pk_bf16(b[2], b[3]); return w; }

typedef __amdgpu_buffer_rsrc_t wt_rsrc;
__device__ __forceinline__ wt_rsrc wt_make(void* base, unsigned bytes) { return __builtin_amdgcn_make_buffer_rsrc(base, 0, bytes, 0x00020000); }
__device__ __forceinline__ void st_wt16(wt_rsrc rs, unsigned byte_off, const u32x4& v) { __builtin_amdgcn_raw_buffer_store_b128(v, rs, byte_off, 0, 16); }
__device__ __forceinline__ void st_wt4(unsigned* p, unsigned v) { __hip_atomic_store(p, v, __ATOMIC_RELAXED, __HIP_MEMORY_SCOPE_AGENT); }
__device__ __forceinline__ void st_wt2(unsigned short* p, unsigned v) { __hip_atomic_store(p, (unsigned short)v, __ATOMIC_RELAXED, __HIP_MEMORY_SCOPE_AGENT); }
struct TileOrder : StaticOrder {
    bool single; int spm, spn;
    __device__ __forceinline__ bool next(int i, Unit& u) const { if (single) { if (i != 0) return false; u.pm = spm; u.pn = spn; return true; } return StaticOrder::next(i, u); }
};
struct NoCopy { static constexpr bool ON = false; };
struct KvCopy {
    static constexpr bool ON = true;
    const float *c128, *c512, *c2048; float *o128, *o512, *o2048; float* dummy; int c0, nsteps; int ring_off;
    __device__ __forceinline__ void addr(int q, const float*& src, float*& dst) const {
        int c = c0 + q;
        if (c < 1920) { const int db = c / 60, r = c - db * 60; src = c128 + ((size_t)db * 128 + 8) * 1024 + (size_t)r * 2048; dst = o128 + (size_t)db * 128 * 1024 + (size_t)r * 2048; }
        else if (c < 1920 + 8064) { c -= 1920; const int db = c / 252, r = c - db * 252; src = c512 + ((size_t)db * 512 + 8) * 1024 + (size_t)r * 2048; dst = o512 + (size_t)db * 512 * 1024 + (size_t)r * 2048; }
        else { c -= 9984; const int db = c / 1020, r = c - db * 1020; src = c2048 + ((size_t)db * 2048 + 8) * 1024 + (size_t)r * 2048; dst = o2048 + (size_t)db * 2048 * 1024 + (size_t)r * 2048; }
    }
    __device__ __forceinline__ void dma(PG8_LAS unsigned char* lds, int q, int tid, int wid) const {
        const float* src; float* dst; addr(q < nsteps ? q : nsteps - 1, src, dst);
        __builtin_amdgcn_global_load_lds((const unsigned*)(src + tid * 4), (PG8_LAS unsigned*)(lds + ring_off + (q % 3) * 8192 + wid * 1024), 16, 0, 2);
    }
    __device__ __forceinline__ u32x4 rd(PG8_LAS unsigned char* lds, int q, int tid) const { return *(const PG8_LAS u32x4*)(lds + ring_off + ((q + 3) % 3) * 8192 + tid * 16); }
    __device__ __forceinline__ void st(const u32x4& v, int q, int tid) const {
        const float* src; float* dst = dummy;
        if (q >= 0 && q < nsteps) addr(q, src, dst);
        __builtin_nontemporal_store(v, (u32x4*)(dst + tid * 4));
    }
};
constexpr int MP_ = 16384;
struct EpiIn {
    static constexpr bool PERM = true, AFTER_DRAIN = false; static constexpr int MIDK = -1;
    bf16_t *XA, *SGA, *Q, *Kb, *Vb, *SGB, *GM;
    float* out;
    const float *b_merge, *g_q, *g_k;
    PG8_LAS float* scr;
    float qscale;
    size_t o_kv128p, o_kv512p, o_kv2048p, o_convp, o_kv128s, o_kv512s, o_kv2048s, o_convs;
    __device__ __forceinline__ void operator()(const f32x4 (&acc)[2][2][4][2], const Unit& u, int wr, int wc, int fr, int fq) const {
        const int pn = u.pn, pm = u.pm;
        const int rowl0 = wr * 64 + fr;
        const int cl0 = wc * 32 + 8 * fq;
        if (pn >= 8 && pn < 20) {
            const bool isk = pn >= 14;
            const float* gw = isk ? g_k : g_q;
            const f32x4 g0 = *(const f32x4*)(gw + cl0), g1 = *(const f32x4*)(gw + cl0 + 4);
            const float sc = isk ? 1.0f : qscale;
            const int colt = (pn - (isk ? 14 : 8)) * 256;
            bf16_t* dst = isk ? Kb : Q;
            const int grp = colt / 512;
#pragma unroll
            for (int ai = 0; ai < 2; ++ai) {
#pragma unroll
                for (int m = 0; m < 4; ++m)
#pragma unroll
                    for (int bj = 0; bj < 2; ++bj) {
                        const f32x4 a = acc[ai][bj][m][0], b = acc[ai][bj][m][1];
                        float s = (a[0] * a[0] + a[1] * a[1]) + (a[2] * a[2] + a[3] * a[3]) + (b[0] * b[0] + b[1] * b[1]) + (b[2] * b[2] + b[3] * b[3]);
                        s = sum_fq(s);
                        if (fq == 0) scr[((rowl0 + m * 16) * 2 + bj) * 4 + wc] = s;
                    }
                asm volatile("s_waitcnt lgkmcnt(0)" ::: "memory"); __builtin_amdgcn_s_barrier(); asm volatile("" ::: "memory");
#pragma unroll
                for (int m = 0; m < 4; ++m) {
                    const int rl = ai * 128 + rowl0 + m * 16; const int row = pm * 256 + rl;
                    float* kvrow = nullptr;
                    if (isk) {
                        if (row < MP_) { const int b = row >> 11, t = row & 2047;
                            if (grp == 0) { if (t >= 1920) kvrow = out + o_kv128p + ((size_t)(b * 128 + (t - 1920))) * 1024; }
                            else if (grp == 1) { if (t >= 1536) kvrow = out + o_kv512p + ((size_t)(b * 512 + (t - 1536))) * 1024; }
                            else kvrow = out + o_kv2048p + ((size_t)(b * 2048 + t)) * 1024;
                        } else { const int rs = row - MP_, db = rs >> 3, t = rs & 7;
                            if (grp == 0) kvrow = out + o_kv128s + ((size_t)(db * 128 + 120 + t)) * 1024;
                            else if (grp == 1) kvrow = out + o_kv512s + ((size_t)(db * 512 + 504 + t)) * 1024;
                            else kvrow = out + o_kv2048s + ((size_t)(db * 2048 + 2040 + t)) * 1024;
                        }
                    }
#pragma unroll
                    for (int bj = 0; bj < 2; ++bj) {
                        const f32x4 p = *(const PG8_LAS f32x4*)(scr + ((rowl0 + m * 16) * 2 + bj) * 4);
                        const float rs_ = __builtin_amdgcn_rsqf(((p[0] + p[1]) + (p[2] + p[3])) * (1.0f / 128.0f) + 1e-6f);
                        f32x4 a = acc[ai][bj][m][0] * rs_ * g0, b = acc[ai][bj][m][1] * rs_ * g1;
                        if (kvrow) { float* kp = kvrow + ((colt & 511) + bj * 128 + cl0); __builtin_nontemporal_store(a, (f32x4*)kp); __builtin_nontemporal_store(b, (f32x4*)(kp + 4)); }
                        a = a * sc; b = b * sc;
                        *(u32x4*)(dst + (size_t)row * 1536 + colt + bj * 128 + cl0) = pack8(a, b);
                    }
                }
                if (ai == 0) { asm volatile("s_waitcnt lgkmcnt(0)" ::: "memory"); __builtin_amdgcn_s_barrier(); asm volatile("" ::: "memory"); }
            }
            return;
        }
        int mode, ld, colt; bf16_t* dst;
        if (pn < 4)       { mode = 0; dst = XA;  ld = 1024; colt = pn * 256; }
        else if (pn < 8)  { mode = 4; dst = SGA; ld = 1024; colt = (pn - 4) * 256; }
        else if (pn < 26) { mode = 2; dst = Vb;  ld = 1536; colt = (pn - 20) * 256; }
        else if (pn < 28) { mode = 4; dst = SGB; ld = 512;  colt = (pn - 26) * 256; }
        else              { mode = 3; dst = GM;  ld = 2048; colt = (pn - 28) * 256; }
        f32x4 bm[2][2];
#pragma unroll
        for (int bj = 0; bj < 2; ++bj)
#pragma unroll
            for (int n = 0; n < 2; ++n) bm[bj][n] = (mode == 3) ? *(const f32x4*)(b_merge + bj * 1024 + colt / 2 + cl0 + 4 * n) : (f32x4){0.f, 0.f, 0.f, 0.f};
        const int grp = colt / 512;
#pragma unroll
        for (int ai = 0; ai < 2; ++ai)
#pragma unroll
            for (int m = 0; m < 4; ++m) {
                const int rl = ai * 128 + rowl0 + m * 16; const int row = pm * 256 + rl;
                float* frow = nullptr;
                if (mode == 2) {
                    if (row < MP_) { const int b = row >> 11, t = row & 2047;
                        if (grp == 0) { if (t >= 1920) frow = out + o_kv128p + ((size_t)(b * 128 + (t - 1920))) * 1024; }
                        else if (grp == 1) { if (t >= 1536) frow = out + o_kv512p + ((size_t)(b * 512 + (t - 1536))) * 1024; }
                        else frow = out + o_kv2048p + ((size_t)(b * 2048 + t)) * 1024;
                    } else { const int rs = row - MP_, db = rs >> 3, t = rs & 7;
                        if (grp == 0) frow = out + o_kv128s + ((size_t)(db * 128 + 120 + t)) * 1024;
                        else if (grp == 1) frow = out + o_kv512s + ((size_t)(db * 512 + 504 + t)) * 1024;
                        else frow = out + o_kv2048s + ((size_t)(db * 2048 + 2040 + t)) * 1024;
                    }
                    if (frow) frow += 512 + (colt & 511);
                } else if (mode == 0) {
                    if (row < MP_) { const int b = row >> 11, t = row & 2047; if (t >= 2045) frow = out + o_convp + ((size_t)(b * 3 + (t - 2045))) * 1024 + colt; }
                    else { const int rs = row - MP_, db = rs >> 3, t = rs & 7; if (t >= 5) frow = out + o_convs + ((size_t)(db * 3 + (t - 5))) * 1024 + colt; }
                }
#pragma unroll
                for (int bj = 0; bj < 2; ++bj) {
                    f32x4 a = acc[ai][bj][m][0], b = acc[ai][bj][m][1];
                    if (frow) { float* kp = frow + bj * 128 + cl0; __builtin_nontemporal_store(a, (f32x4*)kp); __builtin_nontemporal_store(b, (f32x4*)(kp + 4)); }
                    if (mode == 1) {
#pragma unroll
                        for (int e = 0; e < 4; ++e) { a[e] = silu_f(a[e]); b[e] = silu_f(b[e]); }
                    } else if (mode == 3) {
                        if (bj == 1) continue;
                        const f32x4 pa0 = a + bm[0][0], pa1 = b + bm[0][1], pb0 = acc[ai][1][m][0] + bm[1][0], pb1 = acc[ai][1][m][1] + bm[1][1];
                        f32x4 r0, r1, h0, h1;
#pragma unroll
                        for (int e = 0; e < 4; ++e) {
                            const float ea0 = __builtin_amdgcn_exp2f(-1.4426950408889634f * pa0[e]), eb0 = fminf(__builtin_amdgcn_exp2f(-1.4426950408889634f * pb0[e]), 1.1529215e18f);
                            const float ea1 = __builtin_amdgcn_exp2f(-1.4426950408889634f * pa1[e]), eb1 = fminf(__builtin_amdgcn_exp2f(-1.4426950408889634f * pb1[e]), 1.1529215e18f);
                            r0[e] = (1.0f + eb0) * __builtin_amdgcn_rcpf(1.0f + ea0); h0[e] = __builtin_amdgcn_rcpf(1.0f + eb0);
                            r1[e] = (1.0f + eb1) * __builtin_amdgcn_rcpf(1.0f + ea1); h1[e] = __builtin_amdgcn_rcpf(1.0f + eb1);
                        }
                        *(u32x4*)(dst + (size_t)row * 2048 + colt / 2 + cl0) = pack8(r0, r1);
                        *(u32x4*)(dst + (size_t)row * 2048 + 1024 + colt / 2 + cl0) = pack8(h0, h1);
                        continue;
                    }
                    *(u32x4*)(dst + (size_t)row * ld + colt + bj * 128 + cl0) = pack8(a, b);
                }
            }
    }
};

struct EpiG1 {
    static constexpr bool PERM = true, AFTER_DRAIN = false; static constexpr int MIDK = -1;
    const bf16_t* GM; float* T1;
    __device__ __forceinline__ void operator()(const f32x4 (&acc)[2][2][4][2], const Unit& u, int wr, int wc, int fr, int fq) const {
        const int row0 = u.pm * 256 + wr * 64 + fr, col0 = u.pn * 256 + wc * 32 + 8 * fq;
#pragma unroll
        for (int ai = 0; ai < 2; ++ai)
#pragma unroll
            for (int m = 0; m < 4; ++m) { const int row = row0 + ai * 128 + m * 16;
#pragma unroll
                for (int bj = 0; bj < 2; ++bj) { const int col = col0 + bj * 128;
                    const u32x4 g = *(const u32x4*)(GM + (size_t)row * 2048 + col);
                    f32x4 a = acc[ai][bj][m][0], b = acc[ai][bj][m][1];
                    a[0] *= bf_lo(g.x); a[1] *= bf_hi(g.x); a[2] *= bf_lo(g.y); a[3] *= bf_hi(g.y);
                    b[0] *= bf_lo(g.z); b[1] *= bf_hi(g.z); b[2] *= bf_lo(g.w); b[3] *= bf_hi(g.w);
                    float* p = T1 + (size_t)row * 1024 + col; *(f32x4*)p = a; *(f32x4*)(p + 4) = b; } }
    }
};
struct EpiG2 {
    static constexpr bool PERM = true, AFTER_DRAIN = false; static constexpr int MIDK = -1;
    const bf16_t* GM; const float* T1; bf16_t* MG;
    __device__ __forceinline__ void operator()(const f32x4 (&acc)[2][2][4][2], const Unit& u, int wr, int wc, int fr, int fq) const {
        const int row0 = u.pm * 256 + wr * 64 + fr, col0 = u.pn * 256 + wc * 32 + 8 * fq;
#pragma unroll
        for (int ai = 0; ai < 2; ++ai)
#pragma unroll
            for (int m = 0; m < 4; ++m) { const int row = row0 + ai * 128 + m * 16;
#pragma unroll
                for (int bj = 0; bj < 2; ++bj) { const int col = col0 + bj * 128;
                    const u32x4 g = *(const u32x4*)(GM + (size_t)row * 2048 + 1024 + col);
                    const float* p = T1 + (size_t)row * 1024 + col; f32x4 a = *(const f32x4*)p, b = *(const f32x4*)(p + 4);
                    const f32x4 x = acc[ai][bj][m][0], y = acc[ai][bj][m][1];
                    a[0] += x[0] * bf_lo(g.x); a[1] += x[1] * bf_hi(g.x); a[2] += x[2] * bf_lo(g.y); a[3] += x[3] * bf_hi(g.y);
                    b[0] += y[0] * bf_lo(g.z); b[1] += y[1] * bf_hi(g.z); b[2] += y[2] * bf_lo(g.w); b[3] += y[3] * bf_hi(g.w);
                    *(u32x4*)(MG + (size_t)row * 1024 + col) = pack8(a, b); } }
    }
};
struct EpiMerge {
    static constexpr bool PERM = true, AFTER_DRAIN = false; static constexpr int MIDK = 16;
    const bf16_t* GM; bf16_t* MG;
    __device__ __forceinline__ void mid(f32x4 (&acc)[2][2][4][2], const Unit& u, int, int, int, int) const {
        int t_ = threadIdx.x; asm volatile("" : "+v"(t_));
        const int wid_ = t_ >> 6, wr = wid_ >> 2, wc = wid_ & 3, fr = t_ & 15, fq = (t_ >> 4) & 3;
        const bf16_t* gp = GM + (size_t)(u.pm * 256 + wr * 64 + fr) * 2048 + u.pn * 256 + wc * 32 + 8 * fq;
#pragma unroll
        for (int ai = 0; ai < 2; ++ai) {
#pragma unroll
            for (int m = 0; m < 4; ++m)
#pragma unroll
                for (int bj = 0; bj < 2; ++bj) {
                    const u32x4 g1 = __builtin_nontemporal_load((const u32x4*)(gp + (size_t)(ai * 128 + m * 16) * 2048 + bj * 128));
                    f32x4 a = acc[ai][bj][m][0], b = acc[ai][bj][m][1];
                    a[0] *= bf_lo(g1.x); a[1] *= bf_hi(g1.x); a[2] *= bf_lo(g1.y); a[3] *= bf_hi(g1.y);
                    b[0] *= bf_lo(g1.z); b[1] *= bf_hi(g1.z); b[2] *= bf_lo(g1.w); b[3] *= bf_hi(g1.w);
                    acc[ai][bj][m][0] = a; acc[ai][bj][m][1] = b; }
            asm volatile("" ::: "memory");
        }
    }
    __device__ __forceinline__ void operator()(const f32x4 (&acc)[2][2][4][2], const Unit& u, int wr, int wc, int fr, int fq) const {
        const int row0 = u.pm * 256 + wr * 64 + fr, col0 = u.pn * 256 + wc * 32 + 8 * fq;
        const wt_rsrc rs = wt_make(MG, (unsigned)(16640u * 1024u * 2u));
#pragma unroll
        for (int ai = 0; ai < 2; ++ai)
#pragma unroll
            for (int m = 0; m < 4; ++m) { const int row = row0 + ai * 128 + m * 16;
#pragma unroll
                for (int bj = 0; bj < 2; ++bj) { const int col = col0 + bj * 128;
                    const u32x4 g2 = __builtin_nontemporal_load((const u32x4*)(GM + (size_t)row * 2048 + 1024 + col));
                    f32x4 a = acc[ai][bj][m][0], b = acc[ai][bj][m][1];
                    a[0] *= bf_lo(g2.x); a[1] *= bf_hi(g2.x); a[2] *= bf_lo(g2.y); a[3] *= bf_hi(g2.y);
                    b[0] *= bf_lo(g2.z); b[1] *= bf_hi(g2.z); b[2] *= bf_lo(g2.w); b[3] *= bf_hi(g2.w);
                    st_wt16(rs, (unsigned)(row * 1024 + col) * 2u, pack8(a, b)); } }
    }
};
struct EpiOut {
    static constexpr bool PERM = true, AFTER_DRAIN = false; static constexpr int MIDK = -1;
    const float *xp, *xs; float* y;
    __device__ __forceinline__ void operator()(const f32x4 (&acc)[2][2][4][2], const Unit& u, int wr, int wc, int fr, int fq) const {
        const int row0 = u.pm * 256 + wr * 64 + fr, col0 = u.pn * 256 + wc * 32 + 8 * fq;
        const float* xb = (u.pm < 64) ? xp : (xs - (size_t)MP_ * 1024);
#pragma unroll
        for (int ai = 0; ai < 2; ++ai)
#pragma unroll
            for (int m = 0; m < 4; ++m) { const int row = row0 + ai * 128 + m * 16;
#pragma unroll
                for (int bj = 0; bj < 2; ++bj) { const size_t off = (size_t)row * 1024 + col0 + bj * 128;
                    const f32x4 a = __builtin_nontemporal_load((const f32x4*)(xb + off)) + acc[ai][bj][m][0], b = __builtin_nontemporal_load((const f32x4*)(xb + off + 4)) + acc[ai][bj][m][1];
                    __builtin_nontemporal_store(a, (f32x4*)(y + off)); __builtin_nontemporal_store(b, (f32x4*)(y + off + 4)); } }
    }
};

template <class Epi, class Sched, bool ALIGN_EPI = false, bool SP2 = false, class CP = NoCopy>
__device__ __forceinline__ void gemm_phase(PG8_LAS unsigned char* lds, const Gemm g, const Sched& S, const Epi& E, const CP& cp = CP()) {
    int tid_ = threadIdx.x; asm volatile("" : "+v"(tid_));
    const int tid = tid_, wid = __builtin_amdgcn_readfirstlane(tid >> 6), lane = tid & 63, wr = wid >> 2, wc = wid & 3, fr = lane & 15, fq = lane >> 4;
    const int K = g.K, nt = K / BK;
    unsigned voffA[2], voffB[2];
#pragma unroll
    for (int i = 0; i < 2; ++i) { int R, C; stage_rc(tid * 16 + i * 8192, R, C); const int Rb = Epi::PERM ? ((R & ~31) + perm32(R & 31)) : R;
        voffA[i] = (unsigned)(R * K + C) * 2u; voffB[i] = (unsigned)(Rb * K + C) * 2u; }
    const size_t kstep = (size_t)(BK * 2);
    const size_t hstep = (size_t)HALF * K * 2;
    const size_t tstep = 2 * hstep;
    const unsigned ldsw = (unsigned)wid * 1024u;
    const int aoff = lds_byte(wr * 64 + fr, fq * 8), boff = lds_byte(wc * 32 + fr, fq * 8);
#define PG8_SA(b, h) (((b) * 2 + (h)) * HTB)
#define PG8_SB(b, h) ((4 + (b) * 2 + (h)) * HTB)
#define PG8_STAGE(bufoff, gbase, voff) do { _Pragma("unroll") for (int _i = 0; _i < 2; ++_i) \
        __builtin_amdgcn_global_load_lds((const unsigned*)((const char*)(gbase) + (voff)[_i]), (PG8_LAS unsigned*)(lds + (bufoff) + ldsw + _i * 8192), 16, 0, 0); } while (0)
#define PG8_LDA(dst, b, h) do { _Pragma("unroll") for (int m = 0; m < 4; ++m) _Pragma("unroll") for (int k = 0; k < 2; ++k) dst[m][k] = *(const PG8_LAS bf16x8*)(lds + PG8_SA(b, h) + aoff + m * 2048 + k * 1024); } while (0)
#define PG8_LDB(dst, b, h) do { _Pragma("unroll") for (int n = 0; n < 2; ++n) _Pragma("unroll") for (int k = 0; k < 2; ++k) dst[n][k] = *(const PG8_LAS bf16x8*)(lds + PG8_SB(b, h) + boff + n * 2048 + k * 1024); } while (0)
#define PG8_MMA(ai, bj, At, Bt) do { __builtin_amdgcn_s_setprio(1); _Pragma("unroll") for (int m = 0; m < 4; ++m) _Pragma("unroll") for (int n = 0; n < 2; ++n) _Pragma("unroll") for (int k = 0; k < 2; ++k) \
        acc[ai][bj][m][n] = __builtin_amdgcn_mfma_f32_16x16x32_bf16(Bt[n][k], At[m][k], acc[ai][bj][m][n], 0, 0, 0); __builtin_amdgcn_s_setprio(0); } while (0)
#define PG8_WAIT_V(n) asm volatile("s_waitcnt vmcnt(" #n ")" ::: "memory")
#define PG8_WAIT_L(n) asm volatile("s_waitcnt lgkmcnt(" #n ")" ::: "memory")
#define PG8_BAR __builtin_amdgcn_s_barrier()
#define PG8_SCHED __builtin_amdgcn_sched_barrier(0)
    Unit cur, nxt; int ui = 0;
    if (!S.next(0, cur)) return;
    f32x4 acc[2][2][4][2];
#pragma unroll
    for (int a = 0; a < 2; ++a)
#pragma unroll
        for (int b = 0; b < 2; ++b)
#pragma unroll
            for (int m = 0; m < 4; ++m)
#pragma unroll
                for (int n = 0; n < 2; ++n) acc[a][b][m][n] = (f32x4){0.f, 0.f, 0.f, 0.f};
    bf16x8 At[4][2], B0[2][2], B1[2][2];
    int cq = 0; u32x4 cpv = (u32x4){0u, 0u, 0u, 0u}; (void)cq; (void)cpv;
    const char* cA = (const char*)g.A + (size_t)cur.pm * tstep; const char* cB = (const char*)g.Bt + (size_t)cur.pn * tstep;
    S.a_ready(cur);
    if constexpr (SP2) {
        PG8_STAGE(PG8_SB(0, 0), cB, voffB); PG8_STAGE(PG8_SB(0, 1), cB + hstep, voffB); PG8_STAGE(PG8_SA(0, 0), cA, voffA); PG8_STAGE(PG8_SA(0, 1), cA + hstep, voffA);
        if (wr == 1) PG8_BAR;
        PG8_WAIT_V(2); PG8_BAR;
        PG8_STAGE(PG8_SB(1, 0), cB + kstep, voffB); PG8_STAGE(PG8_SA(1, 0), cA + kstep, voffA); PG8_STAGE(PG8_SB(1, 1), cB + hstep + kstep, voffB);
        PG8_WAIT_V(6); PG8_BAR;
        if constexpr (CP::ON) cp.st(cp.rd(lds, -1, tid), -1, tid);
    } else {
        PG8_STAGE(PG8_SB(0, 0), cB, voffB); PG8_STAGE(PG8_SA(0, 0), cA, voffA); PG8_STAGE(PG8_SB(0, 1), cB + hstep, voffB); PG8_STAGE(PG8_SA(0, 1), cA + hstep, voffA);
        if (wr == 1) PG8_BAR;
        PG8_WAIT_V(4); PG8_BAR;
        PG8_STAGE(PG8_SB(1, 0), cB + kstep, voffB); PG8_STAGE(PG8_SA(1, 0), cA + kstep, voffA); PG8_STAGE(PG8_SB(1, 1), cB + hstep + kstep, voffB);
        PG8_WAIT_V(6); PG8_BAR;
    }
    for (;;) {
        const bool has_next = S.next(ui + 1, nxt);
        const char* nA = has_next ? (const char*)g.A + (size_t)nxt.pm * tstep : cA; const char* nB = has_next ? (const char*)g.Bt + (size_t)nxt.pn * tstep : cB;
        for (int t = 0; t < nt; t += 2) {
            if constexpr (Epi::MIDK >= 0) { if (t == Epi::MIDK) E.mid(acc, cur, wr, wc, fr, fq); }
            const bool last = (t == nt - 2);
            const char* a1 = cA + (size_t)(t + 1) * kstep;
            const char* a2 = last ? nA : cA + (size_t)(t + 2) * kstep; const char* b2 = last ? nB : cB + (size_t)(t + 2) * kstep;
            const char* a3 = a2 + kstep; const char* b3 = b2 + kstep;
            if (last && has_next) S.a_ready(nxt);
            if constexpr (SP2) {
#define PG8_WAIT_VC() do { if constexpr (CP::ON) PG8_WAIT_V(12); else PG8_WAIT_V(8); } while (0)
#define PG8_CP_DMA() do { if constexpr (CP::ON) cp.dma(lds, cq, tid, wid); } while (0)
#define PG8_CP_RD() do { if constexpr (CP::ON) cpv = cp.rd(lds, cq - 2, tid); } while (0)
#define PG8_CP_ST() do { if constexpr (CP::ON) { cp.st(cpv, cq - 2, tid); ++cq; } } while (0)
            PG8_LDB(B0, 0, 0); PG8_LDB(B1, 0, 1); PG8_SCHED; PG8_LDA(At, 0, 0); PG8_CP_DMA(); PG8_STAGE(PG8_SA(1, 1), a1 + hstep, voffA);
            PG8_WAIT_VC(); PG8_CP_RD(); PG8_WAIT_L(0); PG8_BAR; PG8_CP_ST(); PG8_MMA(0, 0, At, B0); PG8_MMA(0, 1, At, B1); PG8_BAR; PG8_SCHED;
            PG8_LDA(At, 0, 1); PG8_CP_DMA(); PG8_STAGE(PG8_SB(0, 0), b2, voffB); PG8_STAGE(PG8_SB(0, 1), b2 + hstep, voffB); PG8_STAGE(PG8_SA(0, 0), a2, voffA);
            PG8_WAIT_VC(); PG8_CP_RD(); PG8_WAIT_L(0); PG8_BAR; PG8_CP_ST(); PG8_MMA(1, 0, At, B0); PG8_MMA(1, 1, At, B1); PG8_BAR; PG8_SCHED;
            PG8_LDB(B0, 1, 0); PG8_LDB(B1, 1, 1); PG8_SCHED; PG8_LDA(At, 1, 0); PG8_CP_DMA(); PG8_STAGE(PG8_SA(0, 1), a2 + hstep, voffA);
            PG8_WAIT_VC(); PG8_CP_RD(); PG8_WAIT_L(0); PG8_BAR; PG8_CP_ST(); PG8_MMA(0, 0, At, B0); PG8_MMA(0, 1, At, B1); PG8_BAR; PG8_SCHED;
            PG8_LDA(At, 1, 1); PG8_CP_DMA(); PG8_STAGE(PG8_SB(1, 0), b3, voffB); PG8_STAGE(PG8_SB(1, 1), b3 + hstep, voffB); PG8_STAGE(PG8_SA(1, 0), a3, voffA);
            PG8_WAIT_VC(); PG8_CP_RD(); PG8_WAIT_L(0); PG8_BAR; PG8_CP_ST(); PG8_MMA(1, 0, At, B0); PG8_MMA(1, 1, At, B1); PG8_BAR; PG8_SCHED;
            } else {
            PG8_LDB(B0, 0, 0); PG8_SCHED; PG8_LDA(At, 0, 0); PG8_STAGE(PG8_SA(1, 1), a1 + hstep, voffA);
            PG8_WAIT_L(8); PG8_BAR; PG8_WAIT_L(0); PG8_MMA(0, 0, At, B0); PG8_BAR; PG8_SCHED;
            PG8_LDB(B1, 0, 1); PG8_STAGE(PG8_SB(0, 0), b2, voffB);
            PG8_BAR; PG8_WAIT_L(0); PG8_MMA(0, 1, At, B1); PG8_BAR;
            PG8_LDA(At, 0, 1); PG8_STAGE(PG8_SA(0, 0), a2, voffA);
            PG8_BAR; PG8_WAIT_L(0); PG8_MMA(1, 0, At, B0); PG8_BAR; PG8_SCHED;
            PG8_STAGE(PG8_SB(0, 1), b2 + hstep, voffB);
            PG8_WAIT_V(6); PG8_BAR; PG8_MMA(1, 1, At, B1); PG8_BAR;
            PG8_LDB(B0, 1, 0); PG8_SCHED; PG8_LDA(At, 1, 0); PG8_STAGE(PG8_SA(0, 1), a2 + hstep, voffA);
            PG8_WAIT_L(8); PG8_BAR; PG8_WAIT_L(0); PG8_MMA(0, 0, At, B0); PG8_BAR; PG8_SCHED;
            PG8_LDB(B1, 1, 1); PG8_STAGE(PG8_SB(1, 0), b3, voffB);
            PG8_BAR; PG8_WAIT_L(0); PG8_MMA(0, 1, At, B1); PG8_BAR;
            PG8_LDA(At, 1, 1); PG8_STAGE(PG8_SA(1, 0), a3, voffA);
            PG8_BAR; PG8_WAIT_L(0); PG8_MMA(1, 0, At, B0); PG8_BAR; PG8_SCHED;
            PG8_STAGE(PG8_SB(1, 1), b3 + hstep, voffB);
            PG8_WAIT_V(6); PG8_BAR; PG8_MMA(1, 1, At, B1); PG8_BAR;
            }
        }
        if constexpr (ALIGN_EPI) { if (wr == 0) PG8_BAR; }
        if constexpr (!Epi::AFTER_DRAIN) { E(acc, cur, wr, wc, fr, fq); S.done(cur); }
        if (!has_next) break;
#pragma unroll
        for (int a = 0; a < 2; ++a)
#pragma unroll
            for (int b = 0; b < 2; ++b)
#pragma unroll
                for (int m = 0; m < 4; ++m)
#pragma unroll
                    for (int n = 0; n < 2; ++n) acc[a][b][m][n] = (f32x4){0.f, 0.f, 0.f, 0.f};
        cur = nxt; cA = nA; cB = nB; ++ui;
        if constexpr (ALIGN_EPI) { if (wr == 1) PG8_BAR; }
    }
    PG8_WAIT_V(0);
    if constexpr (!ALIGN_EPI) { if (wr == 0) PG8_BAR; }
    PG8_BAR;
    if constexpr (Epi::AFTER_DRAIN) { E.fused(acc, cur, wr, wc, fr, fq, lds, wid, lane); S.done(cur); }
#undef PG8_SA
#undef PG8_SB
#undef PG8_STAGE
#undef PG8_LDA
#undef PG8_LDB
#undef PG8_MMA
#undef PG8_WAIT_V
#undef PG8_WAIT_VC
#undef PG8_CP_DMA
#undef PG8_CP_RD
#undef PG8_CP_ST
#undef PG8_WAIT_L
#undef PG8_BAR
#undef PG8_SCHED
}
}
#define GAS __attribute__((address_space(1)))
#define LAS __attribute__((address_space(3)))
typedef unsigned short bf16;
typedef unsigned v4u __attribute__((ext_vector_type(4)));
typedef float f32x4 __attribute__((ext_vector_type(4)));
typedef short bf16x8 __attribute__((ext_vector_type(8)));
typedef GAS unsigned gu32;
typedef GAS unsigned long long gu64;
#define RLX_AGENT __ATOMIC_RELAXED, __HIP_MEMORY_SCOPE_AGENT
#define LDS_WAIT() asm volatile("s_waitcnt lgkmcnt(0)" ::: "memory")
#define VM_WAIT() asm volatile("s_waitcnt vmcnt(0)" ::: "memory")
__device__ __forceinline__ unsigned long long rt() { return __builtin_amdgcn_s_memrealtime(); }
__device__ __forceinline__ unsigned f2bf(float f) { unsigned u = __builtin_bit_cast(unsigned, f); return (u + 0x7fffu + ((u >> 16) & 1u)) >> 16; }
__device__ __forceinline__ unsigned pk2(float lo, float hi) { return f2bf(lo) | (f2bf(hi) << 16); }
#define XB_TMO      128
#define XB_XCNT(j)  (256  + 64 * (j))
#define XB_XSUB(j)  (1280 + 64 * (j))
#define XB_XGEN(j)  (2304 + 64 * (j))
#define XB_TOP      3328
#define XB_TOPGEN   3392
#define XCD_BAR_WORDS 3456
#define XB_SPIN_CAP (1u << 18)

__device__ __forceinline__ unsigned xb_ld(unsigned* p)              { return __hip_atomic_load(p, __ATOMIC_RELAXED, __HIP_MEMORY_SCOPE_AGENT); }
__device__ __forceinline__ unsigned xb_add(unsigned* p, unsigned v) { return __hip_atomic_fetch_add(p, v, __ATOMIC_RELAXED, __HIP_MEMORY_SCOPE_AGENT); }
__device__ __forceinline__ unsigned xb_xcc_id() { return (unsigned)__builtin_amdgcn_s_getreg((3 << 11) | 20) & 0xFu; }
#define XB_SPIN(cond, bar) do { unsigned _sp = 0; while (cond) { __builtin_amdgcn_s_sleep(1); \
    if ((++_sp & 255u) == 0u) { if (xb_ld(&(bar)[XB_TMO])) break; if (_sp > XB_SPIN_CAP) { atomicAdd(&(bar)[XB_TMO], 1u); break; } } } } while (0)

struct XcdBarrier {
    unsigned* bar; unsigned x;
    volatile LAS unsigned* st;
};

__device__ __forceinline__ XcdBarrier xcd_barrier_post(unsigned* bar, volatile LAS unsigned* st) {
    XcdBarrier b; b.bar = bar; b.x = xb_xcc_id(); b.st = st;
    if (threadIdx.x == 0) (void)xb_add(&bar[XB_XCNT(b.x)], 1u);
    return b;
}
__device__ __forceinline__ void xcd_barrier_complete(unsigned* bar, unsigned x, unsigned& nloc, unsigned& nx) {
    const unsigned G = gridDim.x * gridDim.y * gridDim.z;
    unsigned sum, cnt, mine, sp = 0u;
    for (;;) {
        sum = 0u; cnt = 0u; mine = 0u;
#pragma unroll
        for (unsigned j = 0; j < 16; ++j) { const unsigned c = xb_ld(&bar[XB_XCNT(j)]); sum += c; cnt += (c > 0u) ? 1u : 0u; mine = (j == x) ? c : mine; }
        if (sum == G) break;
        __builtin_amdgcn_s_sleep(1);
        if ((++sp & 255u) == 0u) { if (xb_ld(&bar[XB_TMO])) break; if (sp > XB_SPIN_CAP) { atomicAdd(&bar[XB_TMO], 1u); break; } }
    }
    nloc = mine > 0u ? mine : 1u; nx = cnt > 0u ? cnt : 1u;
}

__device__ __forceinline__ void xcd_barrier(const XcdBarrier& b) {
    asm volatile("s_waitcnt vmcnt(0)" ::: "memory");
    __syncthreads();
    if (threadIdx.x == 0) {
        unsigned* bar = b.bar;
        __builtin_amdgcn_s_waitcnt(0);
        unsigned nloc = b.st[0], nx = b.st[1];
        if (nloc == 0u) { xcd_barrier_complete(bar, b.x, nloc, nx); b.st[0] = nloc; b.st[1] = nx; }
        const unsigned old = xb_add(&bar[XB_XSUB(b.x)], 1u);
        const unsigned gen = old / nloc;
        if (old + 1u == (gen + 1u) * nloc) {
            __builtin_amdgcn_fence(__ATOMIC_RELEASE, "agent");
            asm volatile("s_waitcnt vmcnt(0)" ::: "memory");
            const unsigned og = xb_add(&bar[XB_TOP], 1u);
            const unsigned tg = og / nx;
            if (og + 1u == (tg + 1u) * nx) xb_add(&bar[XB_TOPGEN], 1u);
            else XB_SPIN(xb_ld(&bar[XB_TOPGEN]) == tg, bar);
            __builtin_amdgcn_fence(__ATOMIC_ACQUIRE, "agent");
            xb_add(&bar[XB_XGEN(b.x)], 1u);
            asm volatile("s_waitcnt vmcnt(0)" ::: "memory");
        } else {
            XB_SPIN(xb_ld(&bar[XB_XGEN(b.x)]) == gen, bar);
            __builtin_amdgcn_fence(__ATOMIC_ACQUIRE, "agent");
            asm volatile("s_waitcnt vmcnt(0)" ::: "memory");
        }
    }
    __syncthreads();
}

constexpr int NWAVES = 8;
constexpr int MP = 16384, MS = 256, MT = MP + MS;
constexpr int DMOD = 1024, DIN = 9216, DQKV = 1536, DAO = 512, NHEAD = 12, KCAT = 1536;
constexpr float LOG2E = 1.4426950408889634f, LN2 = 0.6931471805599453f;
constexpr float QSCALE = 0.08838834764831845f * LOG2E;
constexpr int TABW = 192;
constexpr size_t O_YP = 0, O_YS = O_YP + (size_t)MP * 1024, O_KV128P = O_YS + (size_t)MS * 1024, O_KV512P = O_KV128P + (size_t)8 * 128 * 1024,
                 O_KV2048P = O_KV512P + (size_t)8 * 512 * 1024, O_CONVP = O_KV2048P + (size_t)8 * 2048 * 1024, O_HP = O_CONVP + 8 * 3 * 1024,
                 O_KV128S = O_HP + 8 * 1024, O_KV512S = O_KV128S + (size_t)32 * 128 * 1024, O_KV2048S = O_KV512S + (size_t)32 * 512 * 1024,
                 O_CONVS = O_KV2048S + (size_t)32 * 2048 * 1024, O_HS = O_CONVS + 32 * 3 * 1024, O_END = O_HS + 32 * 1024;
constexpr size_t MiB = 1u << 20;
constexpr size_t WS_CTL = 0, CTL_ZERO_BYTES = 64 * 1024;
constexpr size_t WS_BT = 1 * MiB, WS_WIN = 2 * MiB, WS_WLRU = 20 * MiB, WS_WATT = 22 * MiB, WS_WOUT = 23 * MiB, WS_WA = 25 * MiB, WS_WX = 25 * MiB + 512 * 1024,
                 WS_PEND = 26 * MiB, WS_HEND = 27 * MiB, WS_LSE = 28 * MiB,
                 WS_XN = 32 * MiB, WS_XA = 65 * MiB, WS_SGA = 98 * MiB, WS_Q = 131 * MiB, WS_K = 180 * MiB, WS_V = 229 * MiB, WS_SGB = 278 * MiB, WS_GM = 295 * MiB,
                 WS_O = 360 * MiB, WS_HL = 409 * MiB, WS_PP = 442 * MiB, WS_A1 = 475 * MiB, WS_A2 = 508 * MiB, WS_T1 = 525 * MiB, WS_MG = 590 * MiB, WS_PART = 623 * MiB, WS_DUMMY = 636 * MiB, WS_WCAT = 639 * MiB, WS_ACAT = 409 * MiB  , WS_END = 643 * MiB;
constexpr int CW_BAR = 1024, CW_Q2 = 512, CW_MRG = 896, CW_LFLAG = 8192, CW_Q3 = 640;
constexpr int CW_CHAIN = 5120, CH_A2 = 0, CH_M = 64 * 16, CH_5 = 72 * 16, CH_S = 136 * 16, CH_S1 = 144 * 16, CH_P2 = 145 * 16, CH_P3 = 146 * 16;
constexpr int PSLOTS = 21, PSTRIDE = 132;
static_assert((CW_BAR + XCD_BAR_WORDS) * 4 <= (int)CTL_ZERO_BYTES, "ctl");
constexpr int RING_OFF = 0, RING_BYTES = 131072, CPR_OFF = 131072  , EPI_OFF = CPR_OFF + 24576  ,
              SCR_OFF = CPR_OFF, TAB_OFF = EPI_OFF + 4096, MISC_OFF = TAB_OFF + 1024, LDS_BYTES = 163840;
static_assert(MISC_OFF + 128 <= LDS_BYTES, "LDS map");

typedef unsigned u32x2 __attribute__((ext_vector_type(2)));
typedef short v4i16_t __attribute__((ext_vector_type(4)));
typedef float f32x2 __attribute__((ext_vector_type(2)));

struct Args {
    const float* in[23]; float* out; unsigned char* ws; int ph_lo, ph_hi, qslot, sub;
};
struct Frame {
    LAS unsigned char* lds; int tid, lane, wave, vcu, G;
};
__device__ __forceinline__ float wave_sum(float v) {
#pragma unroll
    for (int o = 1; o < 64; o <<= 1) v += __shfl_xor(v, o);
    return v;
}
__device__ __forceinline__ unsigned cvtpk(float lo, float hi) { return pg8::cvt_pk_bf16(lo, hi); }
__device__ __forceinline__ float bflo(unsigned w) { return __uint_as_float(w << 16); }
__device__ __forceinline__ float bfhi(unsigned w) { return __uint_as_float(w & 0xffff0000u); }
__device__ __forceinline__ float silu_lo(unsigned w) { return pg8::silu_f(bflo(w)); }
__device__ __forceinline__ float silu_hi(unsigned w) { return pg8::silu_f(bfhi(w)); }
__device__ __forceinline__ unsigned off_b(unsigned row, unsigned ch) { return 256u * row + 16u * (ch ^ (((row & 3u) << 2) | ((row >> 2) & 3u))); }

struct BgCopy { v4u r[16]; };
__device__ __forceinline__ void bg_addr(const Args& A, int c, const float*& src, float*& dst) {
    if (c < 1920) { const int db = c / 60, r = c - db * 60; src = A.in[2] + ((size_t)db * 128 + 8) * 1024 + (size_t)r * 2048; dst = A.out + O_KV128S + (size_t)db * 128 * 1024 + (size_t)r * 2048; }
    else if (c < 1920 + 8064) { c -= 1920; const int db = c / 252, r = c - db * 252; src = A.in[3] + ((size_t)db * 512 + 8) * 1024 + (size_t)r * 2048; dst = A.out + O_KV512S + (size_t)db * 512 * 1024 + (size_t)r * 2048; }
    else { c -= 9984; const int db = c / 1020, r = c - db * 1020; src = A.in[4] + ((size_t)db * 2048 + 8) * 1024 + (size_t)r * 2048; dst = A.out + O_KV2048S + (size_t)db * 2048 * 1024 + (size_t)r * 2048; }
}
__device__ __forceinline__ void bg_load(const Args& A, int cu, int tid, BgCopy& B) {
#pragma unroll
    for (int i = 0; i < 16; ++i) { const float* src; float* dst; bg_addr(A, 16 * cu + i, src, dst); B.r[i] = __builtin_nontemporal_load((const v4u*)src + tid); }
}
__device__ __forceinline__ void bg_store(const Args& A, int cu, int tid, const BgCopy& B) {
#pragma unroll
    for (int i = 0; i < 16; ++i) { const float* src; float* dst; bg_addr(A, 16 * cu + i, src, dst); __builtin_nontemporal_store(B.r[i], (v4u*)dst + tid); }
}
constexpr int BG_UNITS = 2664;
struct BgHalf { v4u r[8]; };
__device__ __forceinline__ void bg2h_load(const Args& A, int u, int hf, int tid, BgHalf& B) {
    const int db = u >> 5, rg0 = 4 * (u & 31) + 2 * hf;
#pragma unroll
    for (int i = 0; i < 2; ++i) { const v4u* src = (const v4u*)(A.in[4] + ((size_t)db * 2048 + 16 * (rg0 + i) + 8) * 1024);
#pragma unroll
        for (int j = 0; j < 4; ++j) B.r[4 * i + j] = __builtin_nontemporal_load(src + tid + 512 * j); }
}
__device__ __forceinline__ void bg2h_store(const Args& A, int u, int hf, int tid, const BgHalf& B) {
    const int db = u >> 5, rg0 = 4 * (u & 31) + 2 * hf;
#pragma unroll
    for (int i = 0; i < 2; ++i) { v4u* dst = (v4u*)(A.out + O_KV2048S + ((size_t)db * 2048 + 16 * (rg0 + i)) * 1024);
#pragma unroll
        for (int j = 0; j < 4; ++j) __builtin_nontemporal_store(B.r[4 * i + j], dst + tid + 512 * j); }
}
__device__ __forceinline__ void bg2_load(const Args& A, int u, int tid, BgCopy& B) {
    const int db = u >> 5, rg0 = 4 * (u & 31);
#pragma unroll
    for (int i = 0; i < 4; ++i) { const v4u* src = (const v4u*)(A.in[4] + ((size_t)db * 2048 + 16 * (rg0 + i) + 8) * 1024);
#pragma unroll
        for (int j = 0; j < 4; ++j) B.r[4 * i + j] = __builtin_nontemporal_load(src + tid + 512 * j); }
}
__device__ __forceinline__ void bg2_store(const Args& A, int u, int tid, const BgCopy& B) {
    const int db = u >> 5, rg0 = 4 * (u & 31);
#pragma unroll
    for (int i = 0; i < 4; ++i) { v4u* dst = (v4u*)(A.out + O_KV2048S + ((size_t)db * 2048 + 16 * (rg0 + i)) * 1024);
#pragma unroll
        for (int j = 0; j < 4; ++j) __builtin_nontemporal_store(B.r[4 * i + j], dst + tid + 512 * j); }
}

__device__ __forceinline__ void p0_transpose_item(const float* W, int K, int N, bf16* WT, LAS float* scr, int item, int lane, int ldo = 0, int koff = 0, bool gmil = false) {
    if (ldo == 0) ldo = K;
    const int nblk = N / 32, kb = item / nblk, nb = item % nblk, k0 = 64 * kb, n0 = 32 * nb;
    int nd0 = n0;
    if (gmil && n0 >= 7168) { const int cc = n0 - 7168, sel = cc >> 10, chn = cc & 1023; nd0 = 7168 + 256 * (chn >> 7) + 128 * sel + (chn & 127); }
#pragma unroll 8
    for (int i = 0; i < 32; ++i) { const int kk = 2 * i + (lane >> 5); scr[kk * 33 + (lane & 31)] = __builtin_nontemporal_load(W + (size_t)(k0 + kk) * N + n0 + (lane & 31)); }
    LDS_WAIT(); asm volatile("" ::: "memory");
    const int c = lane & 7;
#pragma unroll
    for (int j = 0; j < 4; ++j) { const int n = (lane >> 3) + 8 * j; const LAS float* s = scr + (8 * c) * 33 + n;
        v4u o; o.x = pk2(s[0 * 33], s[1 * 33]); o.y = pk2(s[2 * 33], s[3 * 33]); o.z = pk2(s[4 * 33], s[5 * 33]); o.w = pk2(s[6 * 33], s[7 * 33]);
        *(GAS v4u*)(WT + (size_t)(nd0 + n) * ldo + koff + k0 + 8 * c) = o; }
    LDS_WAIT(); asm volatile("" ::: "memory");
}
__device__ __forceinline__ int t5_bucket(int dist) {
    if (dist < 16) return dist;
    const int large = 16 + (int)(log((double)dist / 16.0) / log(128.0) * 16.0);
    return large < 31 ? large : 31;
}
template <int L>
__device__ __forceinline__ void copy_region(const float* src, float* dst, unsigned gt, unsigned nt) {
    constexpr unsigned per = (unsigned)(L - 8) * 256u, total = 32u * per;
    for (unsigned i = gt; i < total; i += 4 * nt) {
        f32x4 v[4];
#pragma unroll
        for (int k = 0; k < 4; ++k) { const unsigned j = i + k * nt; if (j < total) { const unsigned db = j / per, rem = j - db * per; v[k] = __builtin_nontemporal_load((const f32x4*)(src + ((size_t)db * L + 8) * 1024) + rem); } }
#pragma unroll
        for (int k = 0; k < 4; ++k) { const unsigned j = i + k * nt; if (j < total) { const unsigned db = j / per, rem = j - db * per; __builtin_nontemporal_store(v[k], (f32x4*)(dst + (size_t)db * L * 1024) + rem); } }
    }
}
__device__ __forceinline__ void p0_prologue(const Frame& F, const Args& A) {
    unsigned char* ws = A.ws;
    LAS float* scr = (LAS float*)(F.lds + RING_OFF + F.wave * 16384);
    const int gw = F.vcu * NWAVES + F.wave, NGW = F.G * NWAVES;
    constexpr int I_IN = (1024 / 64) * (DIN / 32), I_LRU = 16 * 32, I_ATT = (512 / 64) * 32, I_OUT = 16 * 32, I_G = 8 * (2 * 4);
    constexpr int NITEMS = I_IN + I_LRU + I_ATT + I_OUT + 2 * I_G;
    for (int it = gw; it < NITEMS; it += NGW) {
        int r = it;
        if (r < I_IN) { p0_transpose_item(A.in[8], 1024, DIN, (bf16*)(ws + WS_WIN), scr, r, F.lane, 0, 0, true); continue; } r -= I_IN;
        if (r < I_LRU) { p0_transpose_item(A.in[20], 1024, 1024, (bf16*)(ws + WS_WCAT), scr, r, F.lane, KCAT, 0); continue; } r -= I_LRU;
        if (r < I_ATT) { p0_transpose_item(A.in[21], 512, 1024, (bf16*)(ws + WS_WCAT), scr, r, F.lane, KCAT, 1024); continue; } r -= I_ATT;
        if (r < I_OUT) { p0_transpose_item(A.in[22], 1024, 1024, (bf16*)(ws + WS_WOUT), scr, r, F.lane); continue; } r -= I_OUT;
        if (r < I_G) { const int n = r >> 3; p0_transpose_item(A.in[12] + n * 16384, 128, 128, (bf16*)(ws + WS_WA) + n * 16384, scr, r & 7, F.lane); continue; } r -= I_G;
        { const int n = r >> 3; p0_transpose_item(A.in[14] + n * 16384, 128, 128, (bf16*)(ws + WS_WX) + n * 16384, scr, r & 7, F.lane); }
    }
    {
        const float* gn = A.in[7]; bf16* XN = (bf16*)(ws + WS_XN);
        f32x4 gv[4];
#pragma unroll
        for (int j = 0; j < 4; ++j) gv[j] = ((const f32x4*)gn)[F.lane + 64 * j];
        for (int m = gw; m < MT; m += NGW) {
            const float* xrow = (m < MP) ? A.in[0] + (size_t)m * 1024 : A.in[1] + (size_t)(m - MP) * 1024;
            const f32x4* xr = (const f32x4*)xrow + F.lane;
            f32x4 v[4]; float s = 0.f;
#pragma unroll
            for (int j = 0; j < 4; ++j) { v[j] = __builtin_nontemporal_load(xr + 64 * j); s += (v[j].x * v[j].x + v[j].y * v[j].y) + (v[j].z * v[j].z + v[j].w * v[j].w); }
            const float rs = 1.f / sqrtf(wave_sum(s) * (1.f / 1024.f) + 1e-6f);
            unsigned long long* o8 = (unsigned long long*)(XN + (size_t)m * 1024) + F.lane;
#pragma unroll
            for (int j = 0; j < 4; ++j) { const f32x4 y = v[j] * rs * gv[j]; o8[64 * j] = (unsigned long long)cvtpk(y.x, y.y) | ((unsigned long long)cvtpk(y.z, y.w) << 32); }
        }
    }
    {
        const int gt = F.vcu * 512 + F.tid;
        if (gt < NHEAD * TABW) {
            const int h = gt / TABW, idx = gt % TABW, dist = idx - 31, g = h >> 2, dil = 1 << (2 * g);
            float v = -INFINITY;
            if (dist >= 0 && dist <= 128) v = A.in[19][t5_bucket(dist * dil) * NHEAD + h] * LOG2E;
            ((float*)(ws + WS_BT))[gt] = v;
        }
    }
}

constexpr int AT_K = 0, AT_V = 65536;
__device__ __forceinline__ void attn_prompt_unit(const Frame& F, const Args& A, int u, int cu) {
    unsigned char* ws = A.ws;
    const bf16* Qb = (const bf16*)(ws + WS_Q); const bf16* Kb = (const bf16*)(ws + WS_K); const bf16* Vb = (const bf16*)(ws + WS_V);
    bf16* Ob = (bf16*)(ws + WS_O); float* LSE = (float*)(ws + WS_LSE);
    const int b = u / 192, rem = u % 192, h = rem >> 4, x = rem & 15, g = h >> 2, dsh = 2 * g, dil = 1 << dsh, r = x & (dil - 1), n = x >> dsh;
    int tid_o = F.tid; asm volatile("" : "+v"(tid_o));
    const int lane = tid_o & 63, wave = F.wave, l15 = lane & 15, g4 = lane >> 4;
    LAS float* TAB = (LAS float*)(F.lds + TAB_OFF);
    if (tid_o < TABW) TAB[tid_o] = ((const float*)(ws + WS_BT))[h * TABW + tid_o];
    const int klo = (n == 0) ? 128 : 0;
    BgCopy bgc; if (cu >= 0) bg_load(A, cu, tid_o, bgc);
#pragma unroll
    for (int i = 0; i < 8; ++i) {
        const int inst = wave * 8 + i, row0 = 4 * inst;
        if (row0 >= klo) {
            const int row = row0 + g4, ch = l15 ^ (((row & 3) << 2) | ((row >> 2) & 3));
            const int t = (((n - 1) * 128 + row) << dsh) + r;
            const size_t eoff = ((size_t)(b * 2048 + t) * DQKV + h * 128) + ch * 8;
            __builtin_amdgcn_global_load_lds((const unsigned*)(Kb + eoff), (LAS unsigned*)(F.lds + AT_K + inst * 1024), 16, 0, 0);
            __builtin_amdgcn_global_load_lds((const unsigned*)(Vb + eoff), (LAS unsigned*)(F.lds + AT_V + inst * 1024), 16, 0, 0);
        }
    }
    const int qi = 16 * wave + l15, tq = ((n * 128 + qi) << dsh) + r;
    const size_t qrow = (size_t)(b * 2048 + tq);
    bf16x8 qf[4];
#pragma unroll
    for (int s = 0; s < 4; ++s) qf[s] = *(const bf16x8*)(Qb + qrow * DQKV + h * 128 + 32 * s + 8 * g4);
    VM_WAIT(); __syncthreads();
    if (cu >= 0) bg_store(A, cu, tid_o, bgc);
    const int kb0 = 32 * (wave >> 1);
    f32x4 sc[5][2];
#pragma unroll
    for (int ss = 0; ss < 5; ++ss) {
        const int kb = kb0 + 32 * ss;
        if (kb < klo) { sc[ss][0] = (f32x4){-INFINITY, -INFINITY, -INFINITY, -INFINITY}; sc[ss][1] = sc[ss][0]; continue; }
#pragma unroll
        for (int t = 0; t < 2; ++t) {
            const unsigned key = kb + 8 * (l15 >> 2) + 4 * t + (l15 & 3);
            f32x4 acc = (f32x4){0.f, 0.f, 0.f, 0.f};
#pragma unroll
            for (int s = 0; s < 4; ++s) { const bf16x8 a = *(const LAS bf16x8*)(F.lds + AT_K + off_b(key, 4 * s + g4)); acc = __builtin_amdgcn_mfma_f32_16x16x32_bf16(a, qf[s], acc, 0, 0, 0); }
            const int d0 = qi + 128 - (kb + 8 * g4 + 4 * t) + 31;
#pragma unroll
            for (int e = 0; e < 4; ++e) acc[e] += TAB[d0 - e];
            sc[ss][t] = acc;
        }
    }
    float mx = -INFINITY;
#pragma unroll
    for (int ss = 0; ss < 5; ++ss)
#pragma unroll
        for (int t = 0; t < 2; ++t)
#pragma unroll
            for (int e = 0; e < 4; ++e) mx = fmaxf(mx, sc[ss][t][e]);
    mx = fmaxf(mx, __shfl_xor(mx, 16)); mx = fmaxf(mx, __shfl_xor(mx, 32));
    float sum = 0.f; bf16x8 pf[5];
#pragma unroll
    for (int ss = 0; ss < 5; ++ss) {
        float p[8];
#pragma unroll
        for (int t = 0; t < 2; ++t)
#pragma unroll
            for (int e = 0; e < 4; ++e) { p[4 * t + e] = __builtin_amdgcn_exp2f(sc[ss][t][e] - mx); sum += p[4 * t + e]; }
        v4u w; w.x = cvtpk(p[0], p[1]); w.y = cvtpk(p[2], p[3]); w.z = cvtpk(p[4], p[5]); w.w = cvtpk(p[6], p[7]);
        pf[ss] = __builtin_bit_cast(bf16x8, w);
    }
    sum += __shfl_xor(sum, 16); sum += __shfl_xor(sum, 32);
    const float inv = 1.0f / sum;
    const unsigned q4 = l15 >> 2, p4 = lane & 3;
#pragma unroll
    for (int c = 0; c < 8; ++c) {
        f32x4 acc = (f32x4){0.f, 0.f, 0.f, 0.f};
#pragma unroll
        for (int ss = 0; ss < 5; ++ss) {
            const int kb = kb0 + 32 * ss;
            if (kb < klo) continue;
            const unsigned a0 = AT_V + off_b(kb + 8 * g4 + q4, 2 * c + (p4 >> 1)) + 8 * (p4 & 1);
            const unsigned a1 = AT_V + off_b(kb + 8 * g4 + 4 + q4, 2 * c + (p4 >> 1)) + 8 * (p4 & 1);
            const v4i16_t lo = __builtin_amdgcn_ds_read_tr16_b64_v4i16((LAS v4i16_t*)(F.lds + a0));
            const v4i16_t hi = __builtin_amdgcn_ds_read_tr16_b64_v4i16((LAS v4i16_t*)(F.lds + a1));
            const bf16x8 vf = (bf16x8){lo[0], lo[1], lo[2], lo[3], hi[0], hi[1], hi[2], hi[3]};
            acc = __builtin_amdgcn_mfma_f32_16x16x32_bf16(vf, pf[ss], acc, 0, 0, 0);
        }
        acc = acc * inv;
        u32x2 w; w.x = cvtpk(acc[0], acc[1]); w.y = cvtpk(acc[2], acc[3]);
        __hip_atomic_store((unsigned long long*)(Ob + qrow * DQKV + h * 128 + 16 * c + 4 * g4), ((unsigned long long)w.y << 32) | w.x, __ATOMIC_RELAXED, __HIP_MEMORY_SCOPE_AGENT);
    }
    if (g4 == 0) pg8::st_wt4((unsigned*)(LSE + qrow * NHEAD + h), __float_as_uint((mx + __builtin_amdgcn_logf(sum)) * LN2));
    __syncthreads();
}

struct AUnit { int b, h, dsh, r, n, klo; };
__device__ __forceinline__ AUnit attn_decode(int u) { AUnit d; d.b = u / 192; const int rem = u % 192; d.h = rem >> 4; const int x = rem & 15, g = d.h >> 2; d.dsh = 2 * g; const int dil = 1 << d.dsh; d.r = x & (dil - 1); d.n = x >> d.dsh; d.klo = (d.n == 0) ? 128 : 0; return d; }
__device__ __forceinline__ void attn_dma_tile(const Frame& F, const bf16* base, const AUnit& d, int lds_off, int wave, int l15, int g4) {
#pragma unroll
    for (int i = 0; i < 8; ++i) {
        const int inst = wave * 8 + i, row0 = 4 * inst;
        if (row0 >= d.klo) {
            const int row = row0 + g4, ch = l15 ^ (((row & 3) << 2) | ((row >> 2) & 3));
            const int t = (((d.n - 1) * 128 + row) << d.dsh) + d.r;
            const size_t eoff = ((size_t)(d.b * 2048 + t) * DQKV + d.h * 128) + ch * 8;
            __builtin_amdgcn_global_load_lds((const unsigned*)(base + eoff), (LAS unsigned*)(F.lds + lds_off + inst * 1024), 16, 0, 0);
        }
    }
}
__device__ __forceinline__ void attn_prompt_wg(const Frame& F, const Args& A, int u0, int ustride) {
    unsigned char* ws = A.ws;
    const bf16* Qb = (const bf16*)(ws + WS_Q); const bf16* Kb = (const bf16*)(ws + WS_K); const bf16* Vb = (const bf16*)(ws + WS_V);
    bf16* Ob = (bf16*)(ws + WS_O); float* LSE = (float*)(ws + WS_LSE); const float* BT = (const float*)(ws + WS_BT);
    if (u0 >= 1536) return;
    int tid_o = F.tid; asm volatile("" : "+v"(tid_o));
    const int lane = tid_o & 63, wave = F.wave, l15 = lane & 15, g4 = lane >> 4;
    LAS float* TAB2 = (LAS float*)(F.lds + SCR_OFF + 8192);
    int u = u0, pb = 0;
    AUnit d = attn_decode(u);
    bf16x8 qf[4];
    {
        attn_dma_tile(F, Kb, d, AT_K, wave, l15, g4);
        const int qi = 16 * wave + l15, tq = ((d.n * 128 + qi) << d.dsh) + d.r; const size_t qrow = (size_t)(d.b * 2048 + tq);
#pragma unroll
        for (int s2 = 0; s2 < 4; ++s2) qf[s2] = *(const bf16x8*)(Qb + qrow * DQKV + d.h * 128 + 32 * s2 + 8 * g4);
        if (tid_o < TABW) TAB2[tid_o] = BT[d.h * TABW + tid_o];
        VM_WAIT(); __syncthreads();
    }
#pragma unroll 1
    for (;;) {
        const LAS float* TAB = TAB2 + pb * TABW;
        const int klo = d.klo;
        const int qi = 16 * wave + l15, tq = ((d.n * 128 + qi) << d.dsh) + d.r; const size_t qrow = (size_t)(d.b * 2048 + tq);
        attn_dma_tile(F, Vb, d, AT_V, wave, l15, g4);
        const int kb0 = 32 * (wave >> 1);
        f32x4 sc[5][2];
#pragma unroll
        for (int ss = 0; ss < 5; ++ss) {
            const int kb = kb0 + 32 * ss;
            if (kb < klo) { sc[ss][0] = (f32x4){-INFINITY, -INFINITY, -INFINITY, -INFINITY}; sc[ss][1] = sc[ss][0]; continue; }
#pragma unroll
            for (int t = 0; t < 2; ++t) {
                const unsigned key = kb + 8 * (l15 >> 2) + 4 * t + (l15 & 3);
                f32x4 acc = (f32x4){0.f, 0.f, 0.f, 0.f};
#pragma unroll
                for (int s2 = 0; s2 < 4; ++s2) { const bf16x8 a = *(const LAS bf16x8*)(F.lds + AT_K + off_b(key, 4 * s2 + g4)); acc = __builtin_amdgcn_mfma_f32_16x16x32_bf16(a, qf[s2], acc, 0, 0, 0); }
                const int d0 = qi + 128 - (kb + 8 * g4 + 4 * t) + 31;
#pragma unroll
                for (int e = 0; e < 4; ++e) acc[e] += TAB[d0 - e];
                sc[ss][t] = acc;
            }
        }
        float mx = -INFINITY;
#pragma unroll
        for (int ss = 0; ss < 5; ++ss)
#pragma unroll
            for (int t = 0; t < 2; ++t)
#pragma unroll
                for (int e = 0; e < 4; ++e) mx = fmaxf(mx, sc[ss][t][e]);
        mx = fmaxf(mx, __shfl_xor(mx, 16)); mx = fmaxf(mx, __shfl_xor(mx, 32));
        float sum = 0.f; bf16x8 pf[5];
#pragma unroll
        for (int ss = 0; ss < 5; ++ss) {
            float pv[8];
#pragma unroll
            for (int t = 0; t < 2; ++t)
#pragma unroll
                for (int e = 0; e < 4; ++e) { pv[4 * t + e] = __builtin_amdgcn_exp2f(sc[ss][t][e] - mx); sum += pv[4 * t + e]; }
            v4u w; w.x = cvtpk(pv[0], pv[1]); w.y = cvtpk(pv[2], pv[3]); w.z = cvtpk(pv[4], pv[5]); w.w = cvtpk(pv[6], pv[7]);
            pf[ss] = __builtin_bit_cast(bf16x8, w);
        }
        sum += __shfl_xor(sum, 16); sum += __shfl_xor(sum, 32);
        const float inv = 1.0f / sum;
        VM_WAIT(); __syncthreads();
        const int un = u + ustride; const bool has_next = un < 1536;
        AUnit dn = d; bf16x8 qn[4]; float tabn = 0.f;
        if (has_next) {
            dn = attn_decode(un);
            attn_dma_tile(F, Kb, dn, AT_K, wave, l15, g4);
            const int tqn = ((dn.n * 128 + qi) << dn.dsh) + dn.r; const size_t qrn = (size_t)(dn.b * 2048 + tqn);
#pragma unroll
            for (int s2 = 0; s2 < 4; ++s2) qn[s2] = *(const bf16x8*)(Qb + qrn * DQKV + dn.h * 128 + 32 * s2 + 8 * g4);
            if (tid_o < TABW) tabn = BT[dn.h * TABW + tid_o];
        }
        const unsigned q4 = l15 >> 2, p4 = lane & 3;
#pragma unroll
        for (int c = 0; c < 8; ++c) {
            f32x4 acc = (f32x4){0.f, 0.f, 0.f, 0.f};
#pragma unroll
            for (int ss = 0; ss < 5; ++ss) {
                const int kb = kb0 + 32 * ss;
                if (kb < klo) continue;
                const unsigned a0 = AT_V + off_b(kb + 8 * g4 + q4, 2 * c + (p4 >> 1)) + 8 * (p4 & 1);
                const unsigned a1 = AT_V + off_b(kb + 8 * g4 + 4 + q4, 2 * c + (p4 >> 1)) + 8 * (p4 & 1);
                const v4i16_t lo = __builtin_amdgcn_ds_read_tr16_b64_v4i16((LAS v4i16_t*)(F.lds + a0));
                const v4i16_t hi = __builtin_amdgcn_ds_read_tr16_b64_v4i16((LAS v4i16_t*)(F.lds + a1));
                const bf16x8 vf = (bf16x8){lo[0], lo[1], lo[2], lo[3], hi[0], hi[1], hi[2], hi[3]};
                acc = __builtin_amdgcn_mfma_f32_16x16x32_bf16(vf, pf[ss], acc, 0, 0, 0);
            }
            acc = acc * inv;
            u32x2 w; w.x = cvtpk(acc[0], acc[1]); w.y = cvtpk(acc[2], acc[3]);
            __hip_atomic_store((unsigned long long*)(Ob + qrow * DQKV + d.h * 128 + 16 * c + 4 * g4), ((unsigned long long)w.y << 32) | w.x, __ATOMIC_RELAXED, __HIP_MEMORY_SCOPE_AGENT);
        }
        if (g4 == 0) pg8::st_wt4((unsigned*)(LSE + qrow * NHEAD + d.h), __float_as_uint((mx + __builtin_amdgcn_logf(sum)) * LN2));
        asm volatile("" ::: "memory");
        if (has_next && tid_o < TABW) TAB2[(pb ^ 1) * TABW + tid_o] = tabn;
        VM_WAIT(); __syncthreads();
        if (!has_next) break;
        u = un; d = dn; pb ^= 1;
#pragma unroll
        for (int s2 = 0; s2 < 4; ++s2) qf[s2] = qn[s2];
    }
}

constexpr int LR_XCF = 0, LR_XCB = 65536, LR_PPL = 98304;
__device__ __forceinline__ void lru_item(const Frame& F, const Args& A, int it, int cu) {
    unsigned char* ws = A.ws;
    const bf16* XA = (const bf16*)(ws + WS_XA);
    const bool prompt = it < 1024;
    const int n = it & 7; int b = 0, c = 0, cs = 0;
    if (prompt) { c = it >> 6; b = (it >> 3) & 7; } else cs = (it - 1024) >> 3;
    const int m0 = prompt ? b * 2048 + c * 128 : MP + cs * 128, cidx = prompt ? b * 16 + c : 128 + cs;
    int tid = F.tid; asm volatile("" : "+v"(tid));
    const int lane = tid & 63, wave = F.wave, l15 = lane & 15, g4 = lane >> 4;
    LAS float* XCF = (LAS float*)(F.lds + LR_XCF);
    LAS bf16* PPL = (LAS bf16*)(F.lds + LR_PPL);
    BgCopy bgc; if (cu >= 0) bg_load(A, 2 * cu, tid, bgc);
    {
        const int tg = tid >> 4, c8 = tid & 15, ch0 = n * 128 + 8 * c8;
        float xin[7][8];
#pragma unroll
        for (int j = 0; j < 7; ++j) {
            const int trel = 4 * tg - 3 + j;
            const bool from_xa = prompt ? (c * 128 + trel >= 0) : (((tg & 1) != 0) || j >= 3);
            if (from_xa) { const v4u w = *(const v4u*)(XA + (size_t)(m0 + trel) * 1024 + ch0);
                xin[j][0] = bflo(w.x); xin[j][1] = bfhi(w.x); xin[j][2] = bflo(w.y); xin[j][3] = bfhi(w.y); xin[j][4] = bflo(w.z); xin[j][5] = bfhi(w.z); xin[j][6] = bflo(w.w); xin[j][7] = bfhi(w.w); }
            else if (!prompt) { const int db = (cs * 128 + 4 * tg) >> 3; const float* sp = A.in[5] + ((size_t)db * 3 + j) * 1024 + ch0; const f32x4 a = *(const f32x4*)sp, bq = *(const f32x4*)(sp + 4);
                xin[j][0] = a[0]; xin[j][1] = a[1]; xin[j][2] = a[2]; xin[j][3] = a[3]; xin[j][4] = bq[0]; xin[j][5] = bq[1]; xin[j][6] = bq[2]; xin[j][7] = bq[3]; }
            else {
#pragma unroll
                for (int e = 0; e < 8; ++e) xin[j][e] = 0.f; }
        }
        float cw[4][8], cb[8];
#pragma unroll
        for (int jj = 0; jj < 4; ++jj) { const f32x4 a = *(const f32x4*)(A.in[10] + jj * 1024 + ch0), bq = *(const f32x4*)(A.in[10] + jj * 1024 + ch0 + 4);
            cw[jj][0] = a[0]; cw[jj][1] = a[1]; cw[jj][2] = a[2]; cw[jj][3] = a[3]; cw[jj][4] = bq[0]; cw[jj][5] = bq[1]; cw[jj][6] = bq[2]; cw[jj][7] = bq[3]; }
        { const f32x4 a = *(const f32x4*)(A.in[11] + ch0), bq = *(const f32x4*)(A.in[11] + ch0 + 4); cb[0] = a[0]; cb[1] = a[1]; cb[2] = a[2]; cb[3] = a[3]; cb[4] = bq[0]; cb[5] = bq[1]; cb[6] = bq[2]; cb[7] = bq[3]; }
#pragma unroll
        for (int i = 0; i < 4; ++i) {
            float y[8];
#pragma unroll
            for (int e = 0; e < 8; ++e) y[e] = cb[e] + ((cw[0][e] * xin[i][e] + cw[1][e] * xin[i + 1][e]) + (cw[2][e] * xin[i + 2][e] + cw[3][e] * xin[i + 3][e]));
            const int tok = 4 * tg + i;
            *(LAS f32x4*)(XCF + tok * 128 + 8 * c8) = (f32x4){y[0], y[1], y[2], y[3]};
            *(LAS f32x4*)(XCF + tok * 128 + 8 * c8 + 4) = (f32x4){y[4], y[5], y[6], y[7]};
            v4u w; w.x = cvtpk(y[0], y[1]); w.y = cvtpk(y[2], y[3]); w.z = cvtpk(y[4], y[5]); w.w = cvtpk(y[6], y[7]);
            *(LAS v4u*)(F.lds + LR_XCB + off_b(tok, c8)) = w;
        }
    }
    const int chl = 16 * wave + l15, ch = n * 128 + chl;
    bf16x8 wa[4], wx[4];
    {
        const bf16* WA = (const bf16*)(ws + WS_WA) + n * 16384 + chl * 128 + 8 * g4; const bf16* WX = (const bf16*)(ws + WS_WX) + n * 16384 + chl * 128 + 8 * g4;
#pragma unroll
        for (int s = 0; s < 4; ++s) { wa[s] = *(const bf16x8*)(WA + 32 * s); wx[s] = *(const bf16x8*)(WX + 32 * s); }
    }
    const float ba = A.in[13][ch], bx = A.in[15][ch];
    const float lam = A.in[16][ch];
    const float sp8 = -8.0f * log1pf(expf(-lam));
    __syncthreads();
    if (cu >= 0) { bg_store(A, 2 * cu, tid, bgc); bg_load(A, 2 * cu + 1, tid, bgc); }
    float Hin = 0.f, Pin = 1.f;
#pragma unroll 1
    for (int tb = 0; tb < 8; ++tb) {
        if (tb == 4 && cu >= 0) bg_store(A, 2 * cu + 1, tid, bgc);
        f32x4 ga = (f32x4){0.f, 0.f, 0.f, 0.f}, gx = ga;
#pragma unroll
        for (int s = 0; s < 4; ++s) {
            const bf16x8 a = *(const LAS bf16x8*)(F.lds + LR_XCB + off_b(16 * tb + l15, 4 * s + g4));
            ga = __builtin_amdgcn_mfma_f32_16x16x32_bf16(a, wa[s], ga, 0, 0, 0);
            gx = __builtin_amdgcn_mfma_f32_16x16x32_bf16(a, wx[s], gx, 0, 0, 0);
        }
        float av[4], uv[4];
#pragma unroll
        for (int e = 0; e < 4; ++e) {
            const int tok = 16 * tb + 4 * g4 + e;
            const float rr = pg8::sigmoid_f(ga[e] + ba), ii = pg8::sigmoid_f(gx[e] + bx);
            const float la = sp8 * rr;
            float a = __builtin_amdgcn_exp2f(la * LOG2E);
            const float x2 = 2.0f * la;
            const float tay = -x2 * (1.0f + x2 * (0.5f + x2 * (0.16666667f + x2 * (0.041666668f + x2 * (0.0083333338f + x2 * 0.0013888889f)))));
            const float om = (x2 > -0.25f) ? tay : (1.0f - __builtin_amdgcn_exp2f(x2 * LOG2E));
            const float mult = __builtin_amdgcn_sqrtf(om);
            float uu = mult * (ii * XCF[tok * 128 + chl]);
            if (!prompt && e == 0 && (g4 & 1) == 0) { const int db = (cs * 128 + tok) >> 3; uu = a * A.in[6][(size_t)db * 1024 + ch] + uu; a = 0.f; }
            av[e] = a; uv[e] = uu;
        }
        float Ac[4], Uc[4];
        Ac[0] = av[0]; Uc[0] = uv[0];
#pragma unroll
        for (int e = 1; e < 4; ++e) { Ac[e] = av[e] * Ac[e - 1]; Uc[e] = av[e] * Uc[e - 1] + uv[e]; }
        float hst = Hin, pst = Pin, hrun = Hin, prun = Pin;
#pragma unroll
        for (int gg = 0; gg < 4; ++gg) {
            const float ar = __shfl(Ac[3], l15 + 16 * gg), ur = __shfl(Uc[3], l15 + 16 * gg);
            if (g4 == gg) { hst = hrun; pst = prun; }
            hrun = ar * hrun + ur; prun = ar * prun;
        }
        Hin = hrun; Pin = prun;
#pragma unroll
        for (int e = 0; e < 4; ++e) {
            const int tok = 16 * tb + 4 * g4 + e;
            const float hh = Ac[e] * hst + Uc[e], pp = Ac[e] * pst;
            if (prompt) {
                XCF[tok * 128 + chl] = hh;
                PPL[tok * 128 + chl] = (bf16)(cvtpk(pp, 0.f) & 0xffffu);
            } else {
                const size_t o1 = (size_t)(m0 + tok) * 1024 + ch;
                const float sg = pg8::silu_f(__uint_as_float((unsigned)((const bf16*)(ws + WS_SGA))[o1] << 16));
                pg8::st_wt2((unsigned short*)(ws + WS_ACAT) + (size_t)(m0 + tok) * KCAT + ch, cvtpk(hh * sg, 0.f) & 0xffffu);
                if (e == 3 && (g4 & 1) == 1) { const int db = (cs * 128 + tok) >> 3; A.out[O_HS + (size_t)db * 1024 + ch] = hh; }
            }
        }
    }
    if (!prompt) { __syncthreads(); return; }
    typedef float f32x2_ __attribute__((ext_vector_type(2)));
    f32x2_* AGG = (f32x2_*)(ws + WS_PEND);
    unsigned* FLG = (unsigned*)(ws + WS_CTL) + CW_LFLAG;
    if (g4 == 0) __hip_atomic_store((unsigned long long*)(AGG + cidx * 1024 + ch), ((unsigned long long)__float_as_uint(Hin) << 32) | __float_as_uint(Pin), RLX_AGENT);
    const int tg = tid >> 4, c8 = tid & 15;
    v4u sg4[4];
#pragma unroll
    for (int i = 0; i < 4; ++i) sg4[i] = *(const v4u*)((const bf16*)(ws + WS_SGA) + (size_t)(m0 + 4 * tg + i) * 1024 + n * 128 + 8 * c8);
    VM_WAIT(); __syncthreads();
    if (tid == 0) __hip_atomic_store(FLG + it, 1u, RLX_AGENT);
    float Hc = 0.f;
    if (c > 0) {
        if (wave == 0) {
            unsigned* barw = (unsigned*)(ws + WS_CTL) + CW_BAR; unsigned sp = 0;
            const int cc = lane < c ? lane : 0;
            for (;;) {
                const bool ok = (lane >= c) || (xb_ld(FLG + (cc * 64 + b * 8 + n)) != 0u);
                if (__all(ok)) break;
                __builtin_amdgcn_s_sleep(1);
                if ((++sp & 1023u) == 0u) { if (xb_ld(&barw[XB_TMO])) break; if (sp > (1u << 22)) { atomicAdd(&barw[XB_TMO], 1u); break; } }
            }
        }
        __syncthreads();
        f32x2_ ag[4];
#pragma unroll
        for (int k = 0; k < 4; ++k) { const int cc = g4 + 4 * k; ag[k] = (f32x2_){1.f, 0.f};
            if (cc < c) { const unsigned long long w = __hip_atomic_load((unsigned long long*)(AGG + (b * 16 + cc) * 1024 + ch), RLX_AGENT); ag[k] = (f32x2_){__uint_as_float((unsigned)w), __uint_as_float((unsigned)(w >> 32))}; } }
#pragma unroll
        for (int cc = 0; cc < 15; ++cc) {
            const float pc = __shfl(ag[cc >> 2][0], l15 + 16 * (cc & 3)), hc = __shfl(ag[cc >> 2][1], l15 + 16 * (cc & 3));
            if (cc < c) Hc = pc * Hc + hc;
        }
    }
    if (c == 15 && g4 == 0) A.out[O_HP + (size_t)b * 1024 + ch] = Pin * Hc + Hin;
    LAS float* HCL = (LAS float*)(F.lds + SCR_OFF);
    if (g4 == 0) HCL[chl] = Hc;
    __syncthreads();
    {
        const f32x4 h0 = *(const LAS f32x4*)(HCL + 8 * c8), h1 = *(const LAS f32x4*)(HCL + 8 * c8 + 4);
#pragma unroll
        for (int i = 0; i < 4; ++i) {
            const int tok = 4 * tg + i;
            const f32x4 l0 = *(const LAS f32x4*)(XCF + tok * 128 + 8 * c8), l1 = *(const LAS f32x4*)(XCF + tok * 128 + 8 * c8 + 4);
            const v4u pw = *(const LAS v4u*)(PPL + tok * 128 + 8 * c8); const v4u sw = sg4[i];
            v4u w;
            w.x = cvtpk((l0[0] + bflo(pw.x) * h0[0]) * silu_lo(sw.x), (l0[1] + bfhi(pw.x) * h0[1]) * silu_hi(sw.x));
            w.y = cvtpk((l0[2] + bflo(pw.y) * h0[2]) * silu_lo(sw.y), (l0[3] + bfhi(pw.y) * h0[3]) * silu_hi(sw.y));
            w.z = cvtpk((l1[0] + bflo(pw.z) * h1[0]) * silu_lo(sw.z), (l1[1] + bfhi(pw.z) * h1[1]) * silu_hi(sw.z));
            w.w = cvtpk((l1[2] + bflo(pw.w) * h1[2]) * silu_lo(sw.w), (l1[3] + bfhi(pw.w) * h1[3]) * silu_hi(sw.w));
            pg8::st_wt16(pg8::wt_make(ws + WS_ACAT, (unsigned)((size_t)MT * KCAT * 2)), (unsigned)((m0 + tok) * KCAT + n * 128 + 8 * c8) * 2u, w);
        }
    }
    __syncthreads();
}

__device__ __forceinline__ void lru_prompt_wg(const Frame& F, const Args& A, int w) {
    unsigned char* ws = A.ws;
    const bf16* XA = (const bf16*)(ws + WS_XA);
    const int n = w & 7, b = (w >> 3) & 7, c0 = w >> 6;
    int tid0 = F.tid; asm volatile("" : "+v"(tid0)); const int tid = tid0;
    const int lane = tid & 63, wave = F.wave, l15 = lane & 15, g4 = lane >> 4;
    const int tg = tid >> 4, c8 = tid & 15, ch0 = n * 128 + 8 * c8;
    LAS float* XCF = (LAS float*)(F.lds + LR_XCF);
    LAS bf16* PPL = (LAS bf16*)(F.lds + LR_PPL);
    LAS float* HCL = (LAS float*)(F.lds + SCR_OFF);
    typedef float f32x2_ __attribute__((ext_vector_type(2)));
    f32x2_* AGG = (f32x2_*)(ws + WS_PEND);
    unsigned* FLG = (unsigned*)(ws + WS_CTL) + CW_LFLAG;
    LAS float* CWL = (LAS float*)(F.lds + SCR_OFF + 1024);
    for (int i = tid; i < 640; i += 512) CWL[i] = (i < 512) ? A.in[10][(i >> 7) * 1024 + n * 128 + (i & 127)] : A.in[11][n * 128 + (i - 512)];
    __syncthreads();
    const int chl = 16 * wave + l15, ch = n * 128 + chl;
    bf16x8 wa[4], wx[4];
    {
        const bf16* WA = (const bf16*)(ws + WS_WA) + n * 16384 + chl * 128 + 8 * g4; const bf16* WX = (const bf16*)(ws + WS_WX) + n * 16384 + chl * 128 + 8 * g4;
#pragma unroll
        for (int s2 = 0; s2 < 4; ++s2) { wa[s2] = *(const bf16x8*)(WA + 32 * s2); wx[s2] = *(const bf16x8*)(WX + 32 * s2); }
    }
    const float ba = A.in[13][ch], bx = A.in[15][ch];
    const float sp8 = -8.0f * log1pf(expf(-A.in[16][ch]));
    v4u xr[7];
    {
        const int m0 = b * 2048 + c0 * 128;
#pragma unroll
        for (int j = 0; j < 7; ++j) { const int trel = 4 * tg - 3 + j; const bool ok = (c0 * 128 + trel >= 0); xr[j] = *(const v4u*)(XA + (size_t)(m0 + (ok ? trel : 0)) * 1024 + ch0); if (!ok) xr[j] = (v4u){0u, 0u, 0u, 0u}; }
    }
#pragma unroll 1
    for (int k = 0; k < 4; ++k) {
        const int c = c0 + 4 * k, it = c * 64 + b * 8 + n, m0 = b * 2048 + c * 128, cidx = b * 16 + c;
        int tid = tid0; asm volatile("" : "+v"(tid));
        const int lane = tid & 63, l15 = lane & 15, g4 = lane >> 4, tg = tid >> 4, c8 = tid & 15, ch0 = n * 128 + 8 * c8, chl = 16 * wave + l15, ch = n * 128 + chl;
        {
            float cw[4][8], cb[8];
#pragma unroll
            for (int jj = 0; jj < 5; ++jj) { const f32x4 a = *(const LAS f32x4*)(CWL + jj * 128 + 8 * c8), bq = *(const LAS f32x4*)(CWL + jj * 128 + 8 * c8 + 4);
                float* d = (jj < 4) ? cw[jj < 4 ? jj : 0] : cb;
                d[0] = a[0]; d[1] = a[1]; d[2] = a[2]; d[3] = a[3]; d[4] = bq[0]; d[5] = bq[1]; d[6] = bq[2]; d[7] = bq[3]; }
            float xin[7][8];
#pragma unroll
            for (int j = 0; j < 7; ++j) { const v4u wv = xr[j];
                xin[j][0] = bflo(wv.x); xin[j][1] = bfhi(wv.x); xin[j][2] = bflo(wv.y); xin[j][3] = bfhi(wv.y); xin[j][4] = bflo(wv.z); xin[j][5] = bfhi(wv.z); xin[j][6] = bflo(wv.w); xin[j][7] = bfhi(wv.w); }
#pragma unroll
            for (int i = 0; i < 4; ++i) {
                float y[8];
#pragma unroll
                for (int e = 0; e < 8; ++e) y[e] = cb[e] + ((cw[0][e] * xin[i][e] + cw[1][e] * xin[i + 1][e]) + (cw[2][e] * xin[i + 2][e] + cw[3][e] * xin[i + 3][e]));
                const int tok = 4 * tg + i;
                *(LAS f32x4*)(XCF + tok * 128 + 8 * c8) = (f32x4){y[0], y[1], y[2], y[3]};
                *(LAS f32x4*)(XCF + tok * 128 + 8 * c8 + 4) = (f32x4){y[4], y[5], y[6], y[7]};
                v4u wv; wv.x = cvtpk(y[0], y[1]); wv.y = cvtpk(y[2], y[3]); wv.z = cvtpk(y[4], y[5]); wv.w = cvtpk(y[6], y[7]);
                *(LAS v4u*)(F.lds + LR_XCB + off_b(tok, c8)) = wv;
            }
        }
        v4u sg4[4];
        __syncthreads();
        BgHalf bgc; bg2h_load(A, it, 0, tid, bgc);
        float Hin = 0.f, Pin = 1.f;
#pragma unroll 4
        for (int tb = 0; tb < 8; ++tb) {
            if (tb == 2) { bg2h_store(A, it, 0, tid, bgc); bg2h_load(A, it, 1, tid, bgc); }
            if (tb == 5) {
                bg2h_store(A, it, 1, tid, bgc);
                if (k < 3) {
                    const int m1 = m0 + 512;
#pragma unroll
                    for (int j = 0; j < 7; ++j) xr[j] = *(const v4u*)(XA + (size_t)(m1 + 4 * tg - 3 + j) * 1024 + ch0);
                }
#pragma unroll
                for (int i = 0; i < 4; ++i) sg4[i] = __builtin_nontemporal_load((const v4u*)((const bf16*)(ws + WS_SGA) + (size_t)(m0 + 4 * tg + i) * 1024 + n * 128 + 8 * c8));
            }
            f32x4 ga = (f32x4){0.f, 0.f, 0.f, 0.f}, gx = ga;
#pragma unroll
            for (int s2 = 0; s2 < 4; ++s2) {
                const bf16x8 a = *(const LAS bf16x8*)(F.lds + LR_XCB + off_b(16 * tb + l15, 4 * s2 + g4));
                ga = __builtin_amdgcn_mfma_f32_16x16x32_bf16(a, wa[s2], ga, 0, 0, 0);
                gx = __builtin_amdgcn_mfma_f32_16x16x32_bf16(a, wx[s2], gx, 0, 0, 0);
            }
            float Ac[4], Uc[4];
#pragma unroll
            for (int e = 0; e < 4; ++e) {
                const int tok = 16 * tb + 4 * g4 + e;
                const float rr = pg8::sigmoid_f(ga[e] + ba), ii = pg8::sigmoid_f(gx[e] + bx);
                const float la = sp8 * rr;
                const float a = __builtin_amdgcn_exp2f(la * LOG2E);
                const float x2 = 2.0f * la;
                const float tay = -x2 * (1.0f + x2 * (0.5f + x2 * (0.16666667f + x2 * (0.041666668f + x2 * (0.0083333338f + x2 * 0.0013888889f)))));
                const float om = (x2 > -0.25f) ? tay : (1.0f - __builtin_amdgcn_exp2f(x2 * LOG2E));
                const float uu = __builtin_amdgcn_sqrtf(om) * (ii * XCF[tok * 128 + chl]);
                if (e == 0) { Ac[0] = a; Uc[0] = uu; } else { Ac[e] = a * Ac[e - 1]; Uc[e] = a * Uc[e - 1] + uu; }
            }
            float hst = Hin, pst = Pin, hrun = Hin, prun = Pin;
#pragma unroll
            for (int gg = 0; gg < 4; ++gg) {
                const float ar = __shfl(Ac[3], l15 + 16 * gg), ur = __shfl(Uc[3], l15 + 16 * gg);
                if (g4 == gg) { hst = hrun; pst = prun; }
                hrun = ar * hrun + ur; prun = ar * prun;
            }
            Hin = hrun; Pin = prun;
#pragma unroll
            for (int e = 0; e < 4; ++e) {
                const int tok = 16 * tb + 4 * g4 + e;
                XCF[tok * 128 + chl] = Ac[e] * hst + Uc[e];
                PPL[tok * 128 + chl] = (bf16)(cvtpk(Ac[e] * pst, 0.f) & 0xffffu);
            }
        }
        if (g4 == 0) __hip_atomic_store((unsigned long long*)(AGG + cidx * 1024 + ch), ((unsigned long long)__float_as_uint(Hin) << 32) | __float_as_uint(Pin), RLX_AGENT);
        VM_WAIT(); __syncthreads();
        if (tid == 0) __hip_atomic_store(FLG + it, 1u, RLX_AGENT);
        float Hc = 0.f;
        if (c > 0) {
            if (wave == 0) {
                unsigned* barw = (unsigned*)(ws + WS_CTL) + CW_BAR; unsigned sp = 0;
                const int cc = lane < c ? lane : 0;
                for (;;) {
                    const bool ok = (lane >= c) || (xb_ld(FLG + (cc * 64 + b * 8 + n)) != 0u);
                    if (__all(ok)) break;
                    __builtin_amdgcn_s_sleep(1);
                    if ((++sp & 1023u) == 0u) { if (xb_ld(&barw[XB_TMO])) break; if (sp > (1u << 22)) { atomicAdd(&barw[XB_TMO], 1u); break; } }
                }
            }
            __syncthreads();
            f32x2_ ag[4];
#pragma unroll
            for (int q = 0; q < 4; ++q) { const int cc = g4 + 4 * q; ag[q] = (f32x2_){1.f, 0.f};
                if (cc < c) { const unsigned long long wv = __hip_atomic_load((unsigned long long*)(AGG + (b * 16 + cc) * 1024 + ch), RLX_AGENT); ag[q] = (f32x2_){__uint_as_float((unsigned)wv), __uint_as_float((unsigned)(wv >> 32))}; } }
#pragma unroll
            for (int cc = 0; cc < 15; ++cc) {
                const float pc = __shfl(ag[cc >> 2][0], l15 + 16 * (cc & 3)), hc = __shfl(ag[cc >> 2][1], l15 + 16 * (cc & 3));
                if (cc < c) Hc = pc * Hc + hc;
            }
        }
        if (c == 15 && g4 == 0) A.out[O_HP + (size_t)b * 1024 + ch] = Pin * Hc + Hin;
        if (g4 == 0) HCL[chl] = Hc;
        __syncthreads();
        {
            const f32x4 h0 = *(const LAS f32x4*)(HCL + 8 * c8), h1 = *(const LAS f32x4*)(HCL + 8 * c8 + 4);
#pragma unroll
            for (int i = 0; i < 4; ++i) {
                const int tok = 4 * tg + i;
                const f32x4 l0 = *(const LAS f32x4*)(XCF + tok * 128 + 8 * c8), l1 = *(const LAS f32x4*)(XCF + tok * 128 + 8 * c8 + 4);
                const v4u pw = *(const LAS v4u*)(PPL + tok * 128 + 8 * c8); const v4u sw = sg4[i];
                v4u wv;
                wv.x = cvtpk((l0[0] + bflo(pw.x) * h0[0]) * silu_lo(sw.x), (l0[1] + bfhi(pw.x) * h0[1]) * silu_hi(sw.x));
                wv.y = cvtpk((l0[2] + bflo(pw.y) * h0[2]) * silu_lo(sw.y), (l0[3] + bfhi(pw.y) * h0[3]) * silu_hi(sw.y));
                wv.z = cvtpk((l1[0] + bflo(pw.z) * h1[0]) * silu_lo(sw.z), (l1[1] + bfhi(pw.z) * h1[1]) * silu_hi(sw.z));
                wv.w = cvtpk((l1[2] + bflo(pw.w) * h1[2]) * silu_lo(sw.w), (l1[3] + bfhi(pw.w) * h1[3]) * silu_hi(sw.w));
                pg8::st_wt16(pg8::wt_make(ws + WS_ACAT, (unsigned)((size_t)MT * KCAT * 2)), (unsigned)((m0 + tok) * KCAT + n * 128 + 8 * c8) * 2u, wv);
            }
        }
        __syncthreads();
    }
}

__device__ __forceinline__ float dpp_row_sum(float s) {
    s += __builtin_bit_cast(float, __builtin_amdgcn_update_dpp(0, __builtin_bit_cast(int, s), 0xB1, 0xF, 0xF, false));
    s += __builtin_bit_cast(float, __builtin_amdgcn_update_dpp(0, __builtin_bit_cast(int, s), 0x4E, 0xF, 0xF, false));
    s += __builtin_bit_cast(float, __builtin_amdgcn_update_dpp(0, __builtin_bit_cast(int, s), 0x141, 0xF, 0xF, false));
    s += __builtin_bit_cast(float, __builtin_amdgcn_update_dpp(0, __builtin_bit_cast(int, s), 0x140, 0xF, 0xF, false));
    return s;
}
template <int G, int RB, int COPY>
__device__ __forceinline__ void stream_load(f32x4 (&kv)[RB][4], const float* cache, const float* okv, int bi, int wave, int p, int lane, bool lastp) {
    constexpr int L = 128 << (2 * G);
    const int fo = (lane >> 4) * 32 + (lane & 15);
#pragma unroll
    for (int i = 0; i < RB; ++i) {
        const int slot = RB * bi + i;
        if (COPY == 0 && G == 2 && slot >= 8 && slot < 16) continue;
        if (slot < 16) {
            const int idx = (G == 0) ? wave + 8 * slot : (G == 1 ? 128 * p + (wave & 3) + 4 * (2 * slot + (wave >> 2)) : (COPY == 2 ? 128 * (p + (slot >> 3)) + wave + 16 * (slot & 7) : 128 * p + wave + 16 * (slot & 7) + (slot & 8)));
            const f32x4* rp = (const f32x4*)(cache + (size_t)idx * 1024) + fo;
            kv[i][0] = __builtin_nontemporal_load(rp); kv[i][1] = __builtin_nontemporal_load(rp + 16); kv[i][2] = __builtin_nontemporal_load(rp + 128); kv[i][3] = __builtin_nontemporal_load(rp + 144);
        } else if (slot == 16 && lastp) {
            const f32x4* rp = (const f32x4*)(okv + (size_t)(L + wave - 8) * 1024) + fo;
            kv[i][0] = rp[0]; kv[i][1] = rp[16]; kv[i][2] = rp[128]; kv[i][3] = rp[144];
        }
    }
}
template <int G, int RB, int NT, int COPY>
__device__ __forceinline__ void stream_proc(const f32x4 (&kv)[RB][4], float* okv, int bi, int wave, int p, int lane, bool lastp,
                                            const v4u (&qp)[NT], float (&m)[NT], float (&l)[NT], float (&o)[NT][8], const LAS float* bt) {
    constexpr int DSH = 2 * G, DIL = 1 << DSH, L = 128 * DIL;
    const int fo = (lane >> 4) * 32 + (lane & 15);
#pragma unroll
    for (int i = 0; i < RB; ++i) {
        const int slot = RB * bi + i;
        if (slot > 16 || (slot == 16 && !lastp)) continue;
        const int idx = (slot < 16) ? ((G == 0) ? wave + 8 * slot : (G == 1 ? 128 * p + (wave & 3) + 4 * (2 * slot + (wave >> 2)) : (COPY == 2 ? 128 * (p + (slot >> 3)) + wave + 16 * (slot & 7) : 128 * p + wave + 16 * (slot & 7) + (slot & 8)))) : L + wave;
        if (COPY && slot < 16 && idx >= 8) { f32x4* wp = (f32x4*)(okv + (size_t)(idx - 8) * 1024) + fo;
            __builtin_nontemporal_store(kv[i][0], wp); __builtin_nontemporal_store(kv[i][1], wp + 16); __builtin_nontemporal_store(kv[i][2], wp + 128); __builtin_nontemporal_store(kv[i][3], wp + 144); }
        if (G == 2 && COPY != 2 && slot >= 8 && slot < 16) continue;
#pragma unroll
        for (int ts = 0; ts < NT; ++ts) {
            const int t = (G == 0) ? ts : (G == 1 ? (wave & 3) + 4 * ts : wave);
            const int jn = L + t - idx;
            if (jn >= 0 && jn <= 128 * DIL) {
                const v4u w = qp[ts];
                float s = (bflo(w.x) * kv[i][0][0] + bfhi(w.x) * kv[i][0][1]) + (bflo(w.y) * kv[i][0][2] + bfhi(w.y) * kv[i][0][3])
                        + (bflo(w.z) * kv[i][1][0] + bfhi(w.z) * kv[i][1][1]) + (bflo(w.w) * kv[i][1][2] + bfhi(w.w) * kv[i][1][3]);
                s = dpp_row_sum(s) + bt[jn >> DSH];
                const float mn = fmaxf(m[ts], s), corr = __builtin_amdgcn_exp2f(m[ts] - mn), pw = __builtin_amdgcn_exp2f(s - mn);
                l[ts] = l[ts] * corr + pw; m[ts] = mn;
#pragma unroll
                for (int e = 0; e < 4; ++e) { o[ts][e] = o[ts][e] * corr + pw * kv[i][2][e]; o[ts][4 + e] = o[ts][4 + e] * corr + pw * kv[i][3][e]; }
            }
        }
    }
}
template <int G, int COPY>
__device__ __forceinline__ void stream_item(const Frame& F, const Args& A, int db, int p) {
    constexpr int DSH = 2 * G, DIL = 1 << DSH, L = 128 * DIL, NT = (G == 0) ? 8 : (G == 1 ? 2 : 1), NC = (G == 0) ? 8 : (G == 1 ? 2 : 1), NPART = L / 128;
    constexpr int RB = (G == 0) ? 2 : 4, NB = (17 + RB - 1) / RB;
    unsigned char* ws = A.ws;
    int tid = F.tid; asm volatile("" : "+v"(tid));
    const int lane = tid & 63, wave = F.wave, hh = lane >> 4, c4 = 4 * (lane & 15);
    const float* cache = A.in[2 + G] + (size_t)db * L * 1024;
    float* okv = A.out + (G == 0 ? O_KV128S : (G == 1 ? O_KV512S : O_KV2048S)) + (size_t)db * L * 1024;
    LAS float* TABS = (LAS float*)(F.lds + SCR_OFF + 4096);
    for (int i = tid; i < 4 * 129; i += 512) { const int h_ = i / 129, j_ = i - 129 * h_; TABS[h_ * 132 + j_] = ((const float*)(ws + WS_BT))[(G * 4 + h_) * TABW + 31 + j_]; }
    __syncthreads();
    const LAS float* bt = TABS + hh * 132;
    v4u qp[NT]; float m[NT], l[NT], o[NT][8];
#pragma unroll
    for (int ts = 0; ts < NT; ++ts) {
        const int t = (G == 0) ? ts : (G == 1 ? (wave & 3) + 4 * ts : wave);
        const bf16* qr = (const bf16*)(ws + WS_Q) + (size_t)(MP + db * 8 + t) * DQKV + (G * 4 + hh) * 128 + c4;
        const u32x2 q0 = *(const u32x2*)qr, q1 = *(const u32x2*)(qr + 64);
        qp[ts] = (v4u){q0.x, q0.y, q1.x, q1.y};
        m[ts] = -INFINITY; l[ts] = 0.f;
#pragma unroll
        for (int e = 0; e < 8; ++e) o[ts][e] = 0.f;
    }
    const bool lastp = (G == 2 && COPY == 2) ? (p + 1 == NPART - 1) : (p == NPART - 1);
    f32x4 kvA[RB][4], kvB[RB][4];
    stream_load<G, RB, COPY>(kvA, cache, okv, 0, wave, p, lane, lastp);
#pragma unroll 1
    for (int bi = 0; bi < NB; bi += 2) {
        if (bi + 1 < NB) stream_load<G, RB, COPY>(kvB, cache, okv, bi + 1, wave, p, lane, lastp);
        stream_proc<G, RB, NT, COPY>(kvA, okv, bi, wave, p, lane, lastp, qp, m, l, o, bt);
        if (bi + 2 < NB) stream_load<G, RB, COPY>(kvA, cache, okv, bi + 2, wave, p, lane, lastp);
        if (bi + 1 < NB) stream_proc<G, RB, NT, COPY>(kvB, okv, bi + 1, wave, p, lane, lastp, qp, m, l, o, bt);
    }
    LAS float* LO = (LAS float*)(F.lds);
    LAS float* LM = (LAS float*)(F.lds + SCR_OFF);
    LAS float* LL = LM + 8 * NC * 4;
#pragma unroll
    for (int ts = 0; ts < NT; ++ts) {
        const int t = (G == 0) ? ts : (G == 1 ? (wave & 3) + 4 * ts : wave), c = (G == 0) ? wave : (G == 1 ? (wave >> 2) : 0);
        *(LAS f32x4*)(LO + (t * NC + c) * 512 + hh * 128 + c4) = (f32x4){o[ts][0], o[ts][1], o[ts][2], o[ts][3]};
        *(LAS f32x4*)(LO + (t * NC + c) * 512 + hh * 128 + 64 + c4) = (f32x4){o[ts][4], o[ts][5], o[ts][6], o[ts][7]};
        if ((lane & 15) == 0) { LM[(t * NC + c) * 4 + hh] = m[ts]; LL[(t * NC + c) * 4 + hh] = l[ts]; }
    }
    __syncthreads();
    {
        const int h2 = tid >> 7, d = tid & 127, slot = (G == 0) ? 0 : (G == 1 ? 1 + p : 5 + p);
        float* PART = (float*)(ws + WS_PART);
#pragma unroll 1
        for (int t = 0; t < 8; ++t) {
            float M = -INFINITY;
#pragma unroll
            for (int c = 0; c < NC; ++c) M = fmaxf(M, LM[(t * NC + c) * 4 + h2]);
            float Ls = 0.f, os = 0.f;
            if (M > -INFINITY) {
#pragma unroll
                for (int c = 0; c < NC; ++c) { const float f = __builtin_amdgcn_exp2f(LM[(t * NC + c) * 4 + h2] - M); Ls += LL[(t * NC + c) * 4 + h2] * f; os += LO[(t * NC + c) * 512 + tid] * f; }
            }
            float* pp = PART + ((size_t)((db * 8 + t) * 4 + h2) * PSLOTS + slot) * PSTRIDE;
            pg8::st_wt4((unsigned*)(pp + d), __float_as_uint(os));
            if (d == 0) { pg8::st_wt4((unsigned*)(pp + 128), __float_as_uint(M)); pg8::st_wt4((unsigned*)(pp + 129), __float_as_uint(Ls)); }
            if (G == 2 && COPY == 2) { pg8::st_wt4((unsigned*)(pp + PSTRIDE + d), 0u); if (d == 0) { pg8::st_wt4((unsigned*)(pp + PSTRIDE + 128), __float_as_uint(-INFINITY)); pg8::st_wt4((unsigned*)(pp + PSTRIDE + 129), 0u); } }
        }
    }
    __syncthreads();
}
__device__ __forceinline__ void merge_unit(const Frame& F, const Args& A, int r) {
    unsigned char* ws = A.ws;
    const int h2 = F.tid >> 7, d = F.tid & 127;
    const float* pp = (const float*)(ws + WS_PART) + (size_t)(r * 4 + h2) * PSLOTS * PSTRIDE;
    float ms[PSLOTS], M = -INFINITY;
#pragma unroll
    for (int s2 = 0; s2 < PSLOTS; ++s2) { ms[s2] = pp[s2 * PSTRIDE + 128]; M = fmaxf(M, ms[s2]); }
    float Ls = 0.f, os = 0.f;
#pragma unroll
    for (int s2 = 0; s2 < PSLOTS; ++s2) { const float f = __builtin_amdgcn_exp2f(ms[s2] - M); Ls += pp[s2 * PSTRIDE + 129] * f; os += pp[s2 * PSTRIDE + d] * f; }
    const size_t o2 = (size_t)(MP + r) * DAO + F.tid;
    const float sg = pg8::silu_f(__uint_as_float((unsigned)((const bf16*)(ws + WS_SGB))[o2] << 16));
    pg8::st_wt2((unsigned short*)(ws + WS_ACAT) + (size_t)(MP + r) * KCAT + 1024 + F.tid, cvtpk(os / Ls * sg, 0.f) & 0xffffu);
}

template <int MODE>
__device__ __forceinline__ void skinny_unit(const Frame& F, const Args& A, int unit) {
    typedef float f32x16 __attribute__((ext_vector_type(16)));
    unsigned char* ws = A.ws;
    const int rb = unit >> 5, cb = unit & 31, row0 = MP + 32 * rb, col0 = 32 * cb;
    int tid = F.tid; asm volatile("" : "+v"(tid));
    const int lane = tid & 63, wave = F.wave, r = lane & 31, h = lane >> 5;
    LAS float* RED = (LAS float*)(F.lds);
    const int idx = 2 * tid, orow = idx >> 5, ocol = idx & 31;
    const size_t grow = (size_t)(row0 + orow);
    unsigned gr = 0, g2 = 0; f32x2 xres = (f32x2){0.f, 0.f};
    if (MODE == 0) { const bf16* GM = (const bf16*)(ws + WS_GM); gr = *(const unsigned*)(GM + grow * 2048 + col0 + ocol); g2 = *(const unsigned*)(GM + grow * 2048 + 1024 + col0 + ocol); }
    else xres = *(const f32x2*)(A.in[1] + (grow - MP) * 1024 + col0 + ocol);
    const bf16* Ap = (MODE == 0 ? (const bf16*)(ws + WS_ACAT) + (size_t)(row0 + r) * KCAT : (const bf16*)(ws + WS_MG) + (size_t)(row0 + r) * 1024) + 128 * wave + 8 * h;
    const bf16* Wp = (MODE == 0 ? (const bf16*)(ws + WS_WCAT) + (size_t)(col0 + r) * KCAT : (const bf16*)(ws + WS_WOUT) + (size_t)(col0 + r) * 1024) + 128 * wave + 8 * h;
    bf16x8 a[8], b[8], a2[4], b2[4];
#pragma unroll
    for (int s2 = 0; s2 < 8; ++s2) { a[s2] = *(const bf16x8*)(Ap + 16 * s2); b[s2] = *(const bf16x8*)(Wp + 16 * s2); }
    if (MODE == 0) {
        const bf16* Ap2 = (const bf16*)(ws + WS_ACAT) + (size_t)(row0 + r) * KCAT + 1024 + 64 * wave + 8 * h;
        const bf16* Wp2 = (const bf16*)(ws + WS_WCAT) + (size_t)(col0 + r) * KCAT + 1024 + 64 * wave + 8 * h;
#pragma unroll
        for (int s2 = 0; s2 < 4; ++s2) { a2[s2] = *(const bf16x8*)(Ap2 + 16 * s2); b2[s2] = *(const bf16x8*)(Wp2 + 16 * s2); }
    }
    f32x16 acc1, acc2;
#pragma unroll
    for (int e = 0; e < 16; ++e) { acc1[e] = 0.f; acc2[e] = 0.f; }
#pragma unroll
    for (int s2 = 0; s2 < 8; ++s2) acc1 = __builtin_amdgcn_mfma_f32_32x32x16_bf16(a[s2], b[s2], acc1, 0, 0, 0);
    if (MODE == 0) {
#pragma unroll
        for (int s2 = 0; s2 < 4; ++s2) acc2 = __builtin_amdgcn_mfma_f32_32x32x16_bf16(a2[s2], b2[s2], acc2, 0, 0, 0);
    }
#pragma unroll
    for (int e = 0; e < 16; ++e) { const int row = (e & 3) + 8 * (e >> 2) + 4 * h;
        RED[(wave * 2 + 0) * 1024 + row * 32 + r] = acc1[e];
        if (MODE == 0) RED[(wave * 2 + 1) * 1024 + row * 32 + r] = acc2[e]; }
    __syncthreads();
    {
        f32x2 ya = (f32x2){0.f, 0.f}, yb = ya;
#pragma unroll
        for (int w = 0; w < 8; ++w) { ya += *(const LAS f32x2*)(RED + (w * 2 + 0) * 1024 + idx); if (MODE == 0) yb += *(const LAS f32x2*)(RED + (w * 2 + 1) * 1024 + idx); }
        if (MODE == 0) pg8::st_wt4((unsigned*)((bf16*)(ws + WS_MG) + grow * 1024 + col0 + ocol), cvtpk(bflo(g2) * (bflo(gr) * ya[0] + yb[0]), bfhi(g2) * (bfhi(gr) * ya[1] + yb[1])));
        else *(f32x2*)(A.out + grow * 1024 + col0 + ocol) = xres + ya;
    }
    __syncthreads();
}

__device__ __forceinline__ void a1_item(const Frame& F, const Args& A, int cidx) {
    unsigned char* ws = A.ws;
    const bf16* HL = (const bf16*)(ws + WS_HL); const bf16* PP = (const bf16*)(ws + WS_PP); const bf16* SGA = (const bf16*)(ws + WS_SGA); bf16* A1 = (bf16*)(ws + WS_A1);
    const float* PEND = (const float*)(ws + WS_PEND); const float* HEND = (const float*)(ws + WS_HEND);
    const bool prompt = cidx < 128; const int b = cidx >> 4, c = cidx & 15;
    const int m0 = prompt ? b * 2048 + c * 128 : MP + (cidx - 128) * 128;
    const int ch0 = 4 * (F.tid & 255), half = F.tid >> 8;
    f32x4 H = (f32x4){0.f, 0.f, 0.f, 0.f};
    if (prompt) {
        for (int cc = 0; cc < c; ++cc) { const f32x4 p = *(const f32x4*)(PEND + (b * 16 + cc) * 1024 + ch0), hh = *(const f32x4*)(HEND + (b * 16 + cc) * 1024 + ch0); H = p * H + hh; }
        if (c == 15 && half == 0) { const f32x4 p = *(const f32x4*)(PEND + cidx * 1024 + ch0), hh = *(const f32x4*)(HEND + cidx * 1024 + ch0); *(f32x4*)(A.out + O_HP + b * 1024 + ch0) = p * H + hh; }
    }
#pragma unroll 4
    for (int i = 0; i < 64; ++i) {
        const size_t off = (size_t)(m0 + half * 64 + i) * 1024 + ch0;
        const u32x2 hl = *(const u32x2*)(HL + off), pp = *(const u32x2*)(PP + off), sg = *(const u32x2*)(SGA + off);
        const float h0 = (bflo(hl.x) + bflo(pp.x) * H[0]) * silu_lo(sg.x), h1 = (bfhi(hl.x) + bfhi(pp.x) * H[1]) * silu_hi(sg.x);
        const float h2 = (bflo(hl.y) + bflo(pp.y) * H[2]) * silu_lo(sg.y), h3 = (bfhi(hl.y) + bfhi(pp.y) * H[3]) * silu_hi(sg.y);
        u32x2 w; w.x = cvtpk(h0, h1); w.y = cvtpk(h2, h3);
        *(u32x2*)(A1 + off) = w;
    }
}
__device__ __forceinline__ void a2_item(const Frame& F, const Args& A, int it) {
    unsigned char* ws = A.ws;
    const bf16* Ob = (const bf16*)(ws + WS_O); const float* LSE = (const float*)(ws + WS_LSE); const bf16* SGB = (const bf16*)(ws + WS_SGB); bf16* A2 = (bf16*)(ws + WS_ACAT);
    const int tl = F.tid >> 6, k = F.tid & 63, hh = k >> 4, d0 = 8 * (k & 15);
    const pg8::wt_rsrc rsA = pg8::wt_make(A2, (unsigned)((size_t)MT * KCAT * 2));
#pragma unroll
    for (int i = 0; i < 8; ++i) {
        const size_t m = (size_t)it * 64 + i * 8 + tl;
        const float l0 = LSE[m * NHEAD + hh], l1 = LSE[m * NHEAD + 4 + hh], l2 = LSE[m * NHEAD + 8 + hh];
        const float mx = fmaxf(l0, fmaxf(l1, l2));
        float w0 = __builtin_amdgcn_exp2f((l0 - mx) * LOG2E), w1 = __builtin_amdgcn_exp2f((l1 - mx) * LOG2E), w2 = __builtin_amdgcn_exp2f((l2 - mx) * LOG2E);
        const float inv = 1.0f / (w0 + w1 + w2); w0 *= inv; w1 *= inv; w2 *= inv;
        const v4u o0 = __builtin_nontemporal_load((const v4u*)(Ob + m * DQKV + hh * 128 + d0)), o1 = __builtin_nontemporal_load((const v4u*)(Ob + m * DQKV + (4 + hh) * 128 + d0)), o2 = __builtin_nontemporal_load((const v4u*)(Ob + m * DQKV + (8 + hh) * 128 + d0));
        const v4u sg = __builtin_nontemporal_load((const v4u*)(SGB + m * DAO + hh * 128 + d0));
        v4u w;
        w.x = cvtpk((w0 * bflo(o0.x) + w1 * bflo(o1.x) + w2 * bflo(o2.x)) * silu_lo(sg.x), (w0 * bfhi(o0.x) + w1 * bfhi(o1.x) + w2 * bfhi(o2.x)) * silu_hi(sg.x));
        w.y = cvtpk((w0 * bflo(o0.y) + w1 * bflo(o1.y) + w2 * bflo(o2.y)) * silu_lo(sg.y), (w0 * bfhi(o0.y) + w1 * bfhi(o1.y) + w2 * bfhi(o2.y)) * silu_hi(sg.y));
        w.z = cvtpk((w0 * bflo(o0.z) + w1 * bflo(o1.z) + w2 * bflo(o2.z)) * silu_lo(sg.z), (w0 * bfhi(o0.z) + w1 * bfhi(o1.z) + w2 * bfhi(o2.z)) * silu_hi(sg.z));
        w.w = cvtpk((w0 * bflo(o0.w) + w1 * bflo(o1.w) + w2 * bflo(o2.w)) * silu_lo(sg.w), (w0 * bfhi(o0.w) + w1 * bfhi(o1.w) + w2 * bfhi(o2.w)) * silu_hi(sg.w));
        pg8::st_wt16(rsA, (unsigned)(m * KCAT + 1024 + hh * 128 + d0) * 2u, w);
    }
}

__device__ __forceinline__ void chain_signal(unsigned* c0, unsigned* c1) {
    asm volatile("s_waitcnt vmcnt(0)" ::: "memory");
    __syncthreads();
    if (threadIdx.x == 0) {
        (void)xb_add(c0, 1u); if (c1 != nullptr) (void)xb_add(c1, 1u);
    }
}
__device__ __forceinline__ void chain_signal_rel(unsigned* c0) {
    asm volatile("s_waitcnt vmcnt(0)" ::: "memory");
    __syncthreads();
    if (threadIdx.x == 0) {
        __builtin_amdgcn_fence(__ATOMIC_RELEASE, "agent");
        asm volatile("s_waitcnt vmcnt(0)" ::: "memory");
        (void)xb_add(c0, 1u);
    }
}
__device__ __forceinline__ void chain_wait(unsigned* c, unsigned target, unsigned* bar) {
    if (threadIdx.x == 0) {
        XB_SPIN(xb_ld(c) < target, bar);
        __builtin_amdgcn_fence(__ATOMIC_ACQUIRE, "agent");
        asm volatile("s_waitcnt vmcnt(0)" ::: "memory");
    }
    __syncthreads();
}
__device__ __forceinline__ pg8::EpiIn make_epi_in(const Frame& F, const Args& args) {
    unsigned char* ws = args.ws; pg8::EpiIn E;
    E.XA = (bf16*)(ws + WS_XA); E.SGA = (bf16*)(ws + WS_SGA); E.Q = (bf16*)(ws + WS_Q); E.Kb = (bf16*)(ws + WS_K); E.Vb = (bf16*)(ws + WS_V); E.SGB = (bf16*)(ws + WS_SGB); E.GM = (bf16*)(ws + WS_GM);
    E.out = args.out; E.b_merge = args.in[9]; E.g_q = args.in[17]; E.g_k = args.in[18]; E.scr = (LAS float*)(F.lds + EPI_OFF); E.qscale = QSCALE;
    E.o_kv128p = O_KV128P; E.o_kv512p = O_KV512P; E.o_kv2048p = O_KV2048P; E.o_convp = O_CONVP; E.o_kv128s = O_KV128S; E.o_kv512s = O_KV512S; E.o_kv2048s = O_KV2048S; E.o_convs = O_CONVS;
    return E;
}
constexpr int NPHASE = 7;
#ifndef P1_SP2
#define P1_SP2 true
#endif
#ifdef PROBE_EXTRA
#define MK_N_LAUNCHES 6
#endif
#ifndef MK_N_LAUNCHES
#define MK_N_LAUNCHES 1
#endif
__global__ void __launch_bounds__(NWAVES * 64, 2) mixer_fwd(Args args) {
    extern __shared__ __attribute__((aligned(16))) unsigned char lds[];
    Frame F;
    F.lds = (LAS unsigned char*)lds;
    F.tid = threadIdx.x; F.lane = F.tid & 63; F.wave = __builtin_amdgcn_readfirstlane(F.tid >> 6);
    F.G = gridDim.x; { const int bx = blockIdx.x; F.vcu = (F.G % 8 == 0) ? (bx % 8) * (F.G / 8) + bx / 8 : bx; }
    unsigned char* ws = args.ws;
    volatile LAS unsigned* MISC = (volatile LAS unsigned*)(F.lds + MISC_OFF);
    if (F.tid < 32) MISC[F.tid] = 0u;
    __syncthreads();
    XcdBarrier bar; bar.bar = (unsigned*)(ws + WS_CTL) + CW_BAR; bar.x = 0; bar.st = nullptr;
    if (MK_N_LAUNCHES == 1) bar = xcd_barrier_post((unsigned*)(ws + WS_CTL) + CW_BAR, MISC + 8);
    const int lo = args.ph_lo, hi = args.ph_hi;
#ifndef PROBE_REP
#define PROBE_REP 0
#endif
#define IN(k) (lo <= (k) && (k) < hi)
#define REP(k) for (int rep_ = 0; rep_ < 1 + ((PROBE_REP >> (k)) & 1); ++rep_, (rep_ < 1 + ((PROBE_REP >> (k)) & 1)) ? xcd_barrier(bar) : (void)0)
#ifdef PROBE_DBLBAR
#define SEAM(k) do { if (IN(k) && IN((k) + 1)) { xcd_barrier(bar); xcd_barrier(bar); } } while (0)
#else
#define SEAM(k) do { if (IN(k) && IN((k) + 1)) xcd_barrier(bar); } while (0)
#endif

    if (IN(0)) REP(0) { p0_prologue(F, args); }
    SEAM(0);
    if (IN(1)) REP(1) {
#ifdef P1_STAGGER
        { const unsigned long long t0 = __builtin_amdgcn_s_memrealtime(), dl = (unsigned long long)(((blockIdx.x >> 3) & 3) * P1_STAGGER);
          while (__builtin_amdgcn_s_memrealtime() - t0 < dl) __builtin_amdgcn_s_sleep(8); }
#endif
        pg8::Gemm g{(const bf16*)(ws + WS_XN), (const bf16*)(ws + WS_WIN), MP, DIN, 1024}; pg8::TileOrder S; S.init(MP, DIN, F.G, (int)blockIdx.x); S.single = false;
        const pg8::EpiIn E = make_epi_in(F, args);
        pg8::gemm_phase<pg8::EpiIn, pg8::TileOrder, true, P1_SP2>(F.lds + RING_OFF, g, S, E);
    }
    SEAM(1);
    unsigned* const chain = (unsigned*)(ws + WS_CTL) + CW_CHAIN;
    const bool chain23 = IN(2) && IN(3), chain24 = IN(2) && IN(4), chain34 = IN(3) && IN(4), chain45 = IN(4) && IN(5), chain56 = IN(5) && IN(6);
    if (IN(2)) {
        if (args.sub & 2) lru_prompt_wg(F, args, (int)blockIdx.x);
        if (blockIdx.x < 36 && (args.sub & 4)) {
            pg8::Gemm g{(const bf16*)(ws + WS_XN), (const bf16*)(ws + WS_WIN), MT, DIN, 1024}; pg8::TileOrder S; S.init(MT, DIN, F.G, (int)blockIdx.x); S.single = true; S.spm = 64; S.spn = (int)blockIdx.x;
            const pg8::EpiIn E = make_epi_in(F, args);
            pg8::gemm_phase<pg8::EpiIn, pg8::TileOrder, true, true>(F.lds + RING_OFF, g, S, E);
            if (chain23) chain_signal_rel(chain + CH_S1);
        }
        if ((args.sub & 1) && blockIdx.x >= 36) attn_prompt_wg(F, args, (int)blockIdx.x - 36, (int)F.G - 36);
        if (chain24) chain_signal(chain + CH_P2, nullptr);
    }
    if (IN(3)) REP(3) {
        if (chain23) chain_wait(chain + CH_S1, 36u, bar.bar);
        unsigned* qctr = (unsigned*)(ws + WS_CTL) + CW_Q3 + 64 * args.qslot;
        if (F.tid == 0) MISC[16] = atomicAdd(qctr, 1u);
        __syncthreads();
        int cur = (int)MISC[16];
        while (cur < 416 + 16) {
            unsigned nxt = 0; if (F.tid == 0) nxt = atomicAdd(qctr, 1u);
            if (cur < 416) {
                if (args.sub & 2) {
                    if (cur < 32) stream_item<0, 1>(F, args, cur, 0);
                    else if (cur < 160) stream_item<1, 1>(F, args, (cur - 32) >> 2, (cur - 32) & 3);
                    else stream_item<2, 2>(F, args, (cur - 160) >> 3, 2 * ((cur - 160) & 7));
                }
            } else { if (args.sub & 4) lru_item(F, args, 1024 + (cur - 416), -1); }
            __syncthreads();
            if (F.tid == 0) MISC[16] = nxt;
            __syncthreads();
            cur = (int)MISC[16];
        }
        if (chain34) chain_signal(chain + CH_P3, nullptr);
    }
    pg8::Unit u56; { pg8::TileOrder S; S.init(MP, 1024, F.G, (int)blockIdx.x); S.single = false; if (!S.next(0, u56)) { u56.pm = 0; u56.pn = 0; } }
    if (IN(4)) REP(4) {
        for (int it = blockIdx.x; it < 256; it += F.G) {
            if (chain24) chain_wait(chain + CH_P2, F.G, bar.bar);
            a2_item(F, args, it);
            if (chain34) chain_wait(chain + CH_P3, F.G, bar.bar);
            merge_unit(F, args, it);
            if (chain45) chain_signal(chain + CH_A2 + 16 * (it >> 2), chain + CH_M + 16 * (it >> 5));
        }
    }
    if (IN(5)) REP(5) {
        if (chain45) chain_wait(chain + CH_A2 + 16 * u56.pm, 4u, bar.bar);
        {
          pg8::Gemm g{(const bf16*)(ws + WS_ACAT), (const bf16*)(ws + WS_WCAT), MP, 1024, KCAT}; pg8::TileOrder S; S.init(MP, 1024, F.G, (int)blockIdx.x); S.single = false;
          pg8::EpiMerge E{(const bf16*)(ws + WS_GM), (bf16*)(ws + WS_MG)};
          pg8::gemm_phase<pg8::EpiMerge, pg8::TileOrder, true, true>(F.lds + RING_OFF, g, S, E);
        }
        for (int u = blockIdx.x; u < 256; u += F.G) { if (chain45) chain_wait(chain + CH_M + 16 * (u >> 5), 32u, bar.bar); skinny_unit<0>(F, args, u); if (chain56) chain_signal(chain + CH_5 + 16 * u56.pm, chain + CH_S + 16 * (u >> 5)); }
    }
    if (IN(6)) REP(6) {
        if (chain56) chain_wait(chain + CH_5 + 16 * u56.pm, 4u, bar.bar);
        pg8::Gemm g{(const bf16*)(ws + WS_MG), (const bf16*)(ws + WS_WOUT), MP, 1024, 1024}; pg8::TileOrder S; S.init(MP, 1024, F.G, (int)blockIdx.x); S.single = false;
        pg8::EpiOut E{args.in[0], args.in[1], args.out};
        pg8::gemm_phase<pg8::EpiOut, pg8::TileOrder, true, true>(F.lds + RING_OFF, g, S, E);
        for (int u = blockIdx.x; u < 256; u += F.G) { if (chain56) chain_wait(chain + CH_S + 16 * (u >> 5), 32u, bar.bar); skinny_unit<1>(F, args, u); }
    }
#undef IN
#undef SEAM
}

extern "C" void kernel_launch(void* const* d_in, const int* in_sizes, int n_in, void* d_out, int out_size, void* d_ws, size_t ws_size, hipStream_t stream) {
    static int grid = 0;
    if (grid == 0) {
        if (n_in != 23 || (size_t)out_size != O_END || ws_size < WS_END) { fprintf(stderr, "kernel_launch: unexpected shapes: n_in %d out %d (want %zu) ws %zu (want >= %zu)\n", n_in, out_size, (size_t)O_END, ws_size, (size_t)WS_END); grid = -1; return; }
        int dev = 0, cus = 0;
        if (hipGetDevice(&dev) != hipSuccess || hipDeviceGetAttribute(&cus, hipDeviceAttributeMultiprocessorCount, dev) != hipSuccess) { grid = -1; return; }
        if (hipFuncSetAttribute((const void*)mixer_fwd, hipFuncAttributeMaxDynamicSharedMemorySize, LDS_BYTES) != hipSuccess) { fprintf(stderr, "kernel_launch: hipFuncSetAttribute failed\n"); grid = -1; return; }
        (void)hipGetLastError();
        if (cus != 256) { fprintf(stderr, "kernel_launch: built for a 256-CU device (one workgroup per CU), found %d CUs; nothing launched\n", cus); grid = -1; return; }
        grid = cus;
    }
    if (grid < 0) return;
    if (hipMemsetAsync((char*)d_ws + WS_CTL, 0, CTL_ZERO_BYTES, stream) != hipSuccess) return;
    Args a{};
    for (int i = 0; i < 23; ++i) a.in[i] = (const float*)d_in[i];
    a.out = (float*)d_out; a.ws = (unsigned char*)d_ws;
#ifdef PROBE_EXTRA
#ifndef PROBE_SUB
#define PROBE_SUB 7
#endif
    for (int p = 0; p < NPHASE; ++p) for (int k = 0; k < 1 + (p == PROBE_EXTRA ? 1 : 0); ++k) { a.ph_lo = p; a.ph_hi = p + 1; a.qslot = k; a.sub = k ? PROBE_SUB : 7; hipLaunchKernelGGL(mixer_fwd, dim3(grid), dim3(NWAVES * 64), LDS_BYTES, stream, a); }
#else
    a.sub = 7;
    if (MK_N_LAUNCHES == 1) { a.ph_lo = 0; a.ph_hi = NPHASE; hipLaunchKernelGGL(mixer_fwd, dim3(grid), dim3(NWAVES * 64), LDS_BYTES, stream, a); }
    else for (int p = 0; p < NPHASE; ++p) { a.ph_lo = p; a.ph_hi = p + 1; hipLaunchKernelGGL(mixer_fwd, dim3(grid), dim3(NWAVES * 64), LDS_BYTES, stream, a); }
#endif
}
```

```cpp
#include <hip/hip_runtime.h>
#include <cstdio>
#include <cstdint>
#include <cmath>
namespace pg8 {
#define PG8_LAS __attribute__((address_space(3)))
typedef unsigned short bf16_t;
typedef short bf16x8 __attribute__((ext_vector_type(8)));
typedef float f32x4 __attribute__((ext_vector_type(4)));
typedef unsigned u32x4 __attribute__((ext_vector_type(4)));
constexpr int BM = 256, BK = 64, HALF = 128, HTB = HALF * BK * 2  , STAGE_BYTES = 8 * HTB, NXCD = 8, WGM = 2;

__host__ __device__ __forceinline__ int lds_byte(int r, int c) { const int st = (r >> 4) * 2 + (c >> 5), rr = r & 15, cc = c & 31, ob = rr * 64 + cc * 2; return st * 1024 + (ob ^ (((ob >> 9) & 1) << 5)); }
__host__ __device__ __forceinline__ void stage_rc(int b, int& R, int& C) { const int st = b / 1024, sb = b % 1024, swz = sb ^ (((sb >> 9) & 1) << 5); R = (st >> 1) * 16 + swz / 64; C = (st & 1) * 32 + (swz % 64) / 2; }
__host__ __device__ __forceinline__ int perm32(int rho) { const int n = rho >> 4, i = rho & 15; return 8 * (i >> 2) + 4 * n + (i & 3); }

struct Unit { int pm, pn; };
struct Gemm { const bf16_t* A; const bf16_t* Bt; int M, N, K; };

struct StaticOrder {
    int nM, nN, nwg, G, c;
    __host__ __device__ void init(int M, int N, int G_, int c_) { nM = M / BM; nN = N / BM; nwg = nM * nN; G = G_; c = c_; }
    __host__ __device__ bool next(int i, Unit& u) const {
        const long L = (long)i * G + c; if (L >= nwg) return false;
        int wgid = (int)L; { const int q = nwg / NXCD, r = nwg % NXCD, xcd = wgid % NXCD, off = wgid / NXCD; wgid = (xcd < r ? xcd * (q + 1) : r * (q + 1) + (xcd - r) * q) + off; }
        const int nig = WGM * nN, gid = wgid / nig, fm = gid * WGM, gsz = (nM - fm) < WGM ? (nM - fm) : WGM;
        u.pm = fm + ((wgid % nig) % gsz); u.pn = (wgid % nig) / gsz; return true;
    }
    __device__ __forceinline__ void a_ready(const Unit&) const {}
    __device__ __forceinline__ void done(const Unit&) const {}
};


__device__ __forceinline__ unsigned cvt_pk_bf16(float lo, float hi) { unsigned r; asm volatile("v_cvt_pk_bf16_f32 %0, %1, %2" : "=v"(r) : "v"(lo), "v"(hi)); return r; }
__device__ __forceinline__ float bf_lo(unsigned w) { return __uint_as_float(w << 16); }
__device__ __forceinline__ float bf_hi(unsigned w) { return __uint_as_float(w & 0xffff0000u); }
__device__ __forceinline__ float sigmoid_f(float x) { return __builtin_amdgcn_rcpf(1.0f + __builtin_amdgcn_exp2f(-1.4426950408889634f * x)); }
__device__ __forceinline__ float silu_f(float x) { return x * sigmoid_f(x); }
__device__ __forceinline__ float sum_fq(float s) {
    { const auto r = __builtin_amdgcn_permlane16_swap(__float_as_uint(s), __float_as_uint(s), false, false); s = __uint_as_float(r[0]) + __uint_as_float(r[1]); }
    { const auto r = __builtin_amdgcn_permlane32_swap(__float_as_uint(s), __float_as_uint(s), false, false); s = __uint_as_float(r[0]) + __uint_as_float(r[1]); }
    return s;
}
__device__ __forceinline__ u32x4 pack8(const f32x4& a, const f32x4& b) { u32x4 w; w.x = cvt_pk_bf16(a[0], a[1]); w.y = cvt_pk_bf16(a[2], a[3]); w.z = cvt_pk_bf16(b[0], b[1]); w.w = cvt_pk_bf16(b[2], b[3]); return w; }

typedef __amdgpu_buffer_rsrc_t wt_rsrc;
__device__ __forceinline__ wt_rsrc wt_make(void* base, unsigned bytes) { return __builtin_amdgcn_make_buffer_rsrc(base, 0, bytes, 0x00020000); }
__device__ __forceinline__ void st_wt16(wt_rsrc rs, unsigned byte_off, const u32x4& v) { __builtin_amdgcn_raw_buffer_store_b128(v, rs, byte_off, 0, 16); }
__device__ __forceinline__ void st_wt4(unsigned* p, unsigned v) { __hip_atomic_store(p, v, __ATOMIC_RELAXED, __HIP_MEMORY_SCOPE_AGENT); }
__device__ __forceinline__ void st_wt2(unsigned short* p, unsigned v) { __hip_atomic_store(p, (unsigned short)v, __ATOMIC_RELAXED, __HIP_MEMORY_SCOPE_AGENT); }
struct TileOrder : StaticOrder {
    bool single; int spm, spn;
    __device__ __forceinline__ bool next(int i, Unit& u) const { if (single) { if (i != 0) return false; u.pm = spm; u.pn = spn; return true; } return StaticOrder::next(i, u); }
};
struct NoCopy { static constexpr bool ON = false; };
struct KvCopy {
    static constexpr bool ON = true;
    const float *c128, *c512, *c2048; float *o128, *o512, *o2048; float* dummy; int c0, nsteps; int ring_off;
    __device__ __forceinline__ void addr(int q, const float*& src, float*& dst) const {
        int c = c0 + q;
        if (c < 1920) { const int db = c / 60, r = c - db * 60; src = c128 + ((size_t)db * 128 + 8) * 1024 + (size_t)r * 2048; dst = o128 + (size_t)db * 128 * 1024 + (size_t)r * 2048; }
        else if (c < 1920 + 8064) { c -= 1920; const int db = c / 252, r = c - db * 252; src = c512 + ((size_t)db * 512 + 8) * 1024 + (size_t)r * 2048; dst = o512 + (size_t)db * 512 * 1024 + (size_t)r * 2048; }
        else { c -= 9984; const int db = c / 1020, r = c - db * 1020; src = c2048 + ((size_t)db * 2048 + 8) * 1024 + (size_t)r * 2048; dst = o2048 + (size_t)db * 2048 * 1024 + (size_t)r * 2048; }
    }
    __device__ __forceinline__ void dma(PG8_LAS unsigned char* lds, int q, int tid, int wid) const {
        const float* src; float* dst; addr(q < nsteps ? q : nsteps - 1, src, dst);
        __builtin_amdgcn_global_load_lds((const unsigned*)(src + tid * 4), (PG8_LAS unsigned*)(lds + ring_off + (q % 3) * 8192 + wid * 1024), 16, 0, 2);
    }
    __device__ __forceinline__ u32x4 rd(PG8_LAS unsigned char* lds, int q, int tid) const { return *(const PG8_LAS u32x4*)(lds + ring_off + ((q + 3) % 3) * 8192 + tid * 16); }
    __device__ __forceinline__ void st(const u32x4& v, int q, int tid) const {
        const float* src; float* dst = dummy;
        if (q >= 0 && q < nsteps) addr(q, src, dst);
        __builtin_nontemporal_store(v, (u32x4*)(dst + tid * 4));
    }
};
constexpr int MP_ = 16384;
struct EpiIn {
    static constexpr bool PERM = true, AFTER_DRAIN = false; static constexpr int MIDK = -1;
    bf16_t *XA, *SGA, *Q, *Kb, *Vb, *SGB, *GM;
    float* out;
    const float *b_merge, *g_q, *g_k;
    PG8_LAS float* scr;
    float qscale;
    size_t o_kv128p, o_kv512p, o_kv2048p, o_convp, o_kv128s, o_kv512s, o_kv2048s, o_convs;
    __device__ __forceinline__ void operator()(const f32x4 (&acc)[2][2][4][2], const Unit& u, int wr, int wc, int fr, int fq) const {
        const int pn = u.pn, pm = u.pm;
        const int rowl0 = wr * 64 + fr;
        const int cl0 = wc * 32 + 8 * fq;
        if (pn >= 8 && pn < 20) {
            const bool isk = pn >= 14;
            const float* gw = isk ? g_k : g_q;
            const f32x4 g0 = *(const f32x4*)(gw + cl0), g1 = *(const f32x4*)(gw + cl0 + 4);
            const float sc = isk ? 1.0f : qscale;
            const int colt = (pn - (isk ? 14 : 8)) * 256;
            bf16_t* dst = isk ? Kb : Q;
            const int grp = colt / 512;
#pragma unroll
            for (int ai = 0; ai < 2; ++ai) {
#pragma unroll
                for (int m = 0; m < 4; ++m)
#pragma unroll
                    for (int bj = 0; bj < 2; ++bj) {
                        const f32x4 a = acc[ai][bj][m][0], b = acc[ai][bj][m][1];
                        float s = (a[0] * a[0] + a[1] * a[1]) + (a[2] * a[2] + a[3] * a[3]) + (b[0] * b[0] + b[1] * b[1]) + (b[2] * b[2] + b[3] * b[3]);
                        s = sum_fq(s);
                        if (fq == 0) scr[((rowl0 + m * 16) * 2 + bj) * 4 + wc] = s;
                    }
                asm volatile("s_waitcnt lgkmcnt(0)" ::: "memory"); __builtin_amdgcn_s_barrier(); asm volatile("" ::: "memory");
#pragma unroll
                for (int m = 0; m < 4; ++m) {
                    const int rl = ai * 128 + rowl0 + m * 16; const int row = pm * 256 + rl;
                    float* kvrow = nullptr;
                    if (isk) {
                        if (row < MP_) { const int b = row >> 11, t = row & 2047;
                            if (grp == 0) { if (t >= 1920) kvrow = out + o_kv128p + ((size_t)(b * 128 + (t - 1920))) * 1024; }
                            else if (grp == 1) { if (t >= 1536) kvrow = out + o_kv512p + ((size_t)(b * 512 + (t - 1536))) * 1024; }
                            else kvrow = out + o_kv2048p + ((size_t)(b * 2048 + t)) * 1024;
                        } else { const int rs = row - MP_, db = rs >> 3, t = rs & 7;
                            if (grp == 0) kvrow = out + o_kv128s + ((size_t)(db * 128 + 120 + t)) * 1024;
                            else if (grp == 1) kvrow = out + o_kv512s + ((size_t)(db * 512 + 504 + t)) * 1024;
                            else kvrow = out + o_kv2048s + ((size_t)(db * 2048 + 2040 + t)) * 1024;
                        }
                    }
#pragma unroll
                    for (int bj = 0; bj < 2; ++bj) {
                        const f32x4 p = *(const PG8_LAS f32x4*)(scr + ((rowl0 + m * 16) * 2 + bj) * 4);
                        const float rs_ = __builtin_amdgcn_rsqf(((p[0] + p[1]) + (p[2] + p[3])) * (1.0f / 128.0f) + 1e-6f);
                        f32x4 a = acc[ai][bj][m][0] * rs_ * g0, b = acc[ai][bj][m][1] * rs_ * g1;
                        if (kvrow) { float* kp = kvrow + ((colt & 511) + bj * 128 + cl0); __builtin_nontemporal_store(a, (f32x4*)kp); __builtin_nontemporal_store(b, (f32x4*)(kp + 4)); }
                        a = a * sc; b = b * sc;
                        *(u32x4*)(dst + (size_t)row * 1536 + colt + bj * 128 + cl0) = pack8(a, b);
                    }
                }
                if (ai == 0) { asm volatile("s_waitcnt lgkmcnt(0)" ::: "memory"); __builtin_amdgcn_s_barrier(); asm volatile("" ::: "memory"); }
            }
            return;
        }
        int mode, ld, colt; bf16_t* dst;
        if (pn < 4)       { mode = 0; dst = XA;  ld = 1024; colt = pn * 256; }
        else if (pn < 8)  { mode = 4; dst = SGA; ld = 1024; colt = (pn - 4) * 256; }
        else if (pn < 26) { mode = 2; dst = Vb;  ld = 1536; colt = (pn - 20) * 256; }
        else if (pn < 28) { mode = 4; dst = SGB; ld = 512;  colt = (pn - 26) * 256; }
        else              { mode = 3; dst = GM;  ld = 2048; colt = (pn - 28) * 256; }
        f32x4 bm[2][2];
#pragma unroll
        for (int bj = 0; bj < 2; ++bj)
#pragma unroll
            for (int n = 0; n < 2; ++n) bm[bj][n] = (mode == 3) ? *(const f32x4*)(b_merge + bj * 1024 + colt / 2 + cl0 + 4 * n) : (f32x4){0.f, 0.f, 0.f, 0.f};
        const int grp = colt / 512;
#pragma unroll
        for (int ai = 0; ai < 2; ++ai)
#pragma unroll
            for (int m = 0; m < 4; ++m) {
                const int rl = ai * 128 + rowl0 + m * 16; const int row = pm * 256 + rl;
                float* frow = nullptr;
                if (mode == 2) {
                    if (row < MP_) { const int b = row >> 11, t = row & 2047;
                        if (grp == 0) { if (t >= 1920) frow = out + o_kv128p + ((size_t)(b * 128 + (t - 1920))) * 1024; }
                        else if (grp == 1) { if (t >= 1536) frow = out + o_kv512p + ((size_t)(b * 512 + (t - 1536))) * 1024; }
                        else frow = out + o_kv2048p + ((size_t)(b * 2048 + t)) * 1024;
                    } else { const int rs = row - MP_, db = rs >> 3, t = rs & 7;
                        if (grp == 0) frow = out + o_kv128s + ((size_t)(db * 128 + 120 + t)) * 1024;
                        else if (grp == 1) frow = out + o_kv512s + ((size_t)(db * 512 + 504 + t)) * 1024;
                        else frow = out + o_kv2048s + ((size_t)(db * 2048 + 2040 + t)) * 1024;
                    }
                    if (frow) frow += 512 + (colt & 511);
                } else if (mode == 0) {
                    if (row < MP_) { const int b = row >> 11, t = row & 2047; if (t >= 2045) frow = out + o_convp + ((size_t)(b * 3 + (t - 2045))) * 1024 + colt; }
                    else { const int rs = row - MP_, db = rs >> 3, t = rs & 7; if (t >= 5) frow = out + o_convs + ((size_t)(db * 3 + (t - 5))) * 1024 + colt; }
                }
#pragma unroll
                for (int bj = 0; bj < 2; ++bj) {
                    f32x4 a = acc[ai][bj][m][0], b = acc[ai][bj][m][1];
                    if (frow) { float* kp = frow + bj * 128 + cl0; __builtin_nontemporal_store(a, (f32x4*)kp); __builtin_nontemporal_store(b, (f32x4*)(kp + 4)); }
                    if (mode == 1) {
#pragma unroll
                        for (int e = 0; e < 4; ++e) { a[e] = silu_f(a[e]); b[e] = silu_f(b[e]); }
                    } else if (mode == 3) {
                        if (bj == 1) continue;
                        const f32x4 pa0 = a + bm[0][0], pa1 = b + bm[0][1], pb0 = acc[ai][1][m][0] + bm[1][0], pb1 = acc[ai][1][m][1] + bm[1][1];
                        f32x4 r0, r1, h0, h1;
#pragma unroll
                        for (int e = 0; e < 4; ++e) {
                            const float ea0 = __builtin_amdgcn_exp2f(-1.4426950408889634f * pa0[e]), eb0 = fminf(__builtin_amdgcn_exp2f(-1.4426950408889634f * pb0[e]), 1.1529215e18f);
                            const float ea1 = __builtin_amdgcn_exp2f(-1.4426950408889634f * pa1[e]), eb1 = fminf(__builtin_amdgcn_exp2f(-1.4426950408889634f * pb1[e]), 1.1529215e18f);
                            r0[e] = (1.0f + eb0) * __builtin_amdgcn_rcpf(1.0f + ea0); h0[e] = __builtin_amdgcn_rcpf(1.0f + eb0);
                            r1[e] = (1.0f + eb1) * __builtin_amdgcn_rcpf(1.0f + ea1); h1[e] = __builtin_amdgcn_rcpf(1.0f + eb1);
                        }
                        *(u32x4*)(dst + (size_t)row * 2048 + colt / 2 + cl0) = pack8(r0, r1);
                        *(u32x4*)(dst + (size_t)row * 2048 + 1024 + colt / 2 + cl0) = pack8(h0, h1);
                        continue;
                    }
                    *(u32x4*)(dst + (size_t)row * ld + colt + bj * 128 + cl0) = pack8(a, b);
                }
            }
    }
};

struct EpiG1 {
    static constexpr bool PERM = true, AFTER_DRAIN = false; static constexpr int MIDK = -1;
    const bf16_t* GM; float* T1;
    __device__ __forceinline__ void operator()(const f32x4 (&acc)[2][2][4][2], const Unit& u, int wr, int wc, int fr, int fq) const {
        const int row0 = u.pm * 256 + wr * 64 + fr, col0 = u.pn * 256 + wc * 32 + 8 * fq;
#pragma unroll
        for (int ai = 0; ai < 2; ++ai)
#pragma unroll
            for (int m = 0; m < 4; ++m) { const int row = row0 + ai * 128 + m * 16;
#pragma unroll
                for (int bj = 0; bj < 2; ++bj) { const int col = col0 + bj * 128;
                    const u32x4 g = *(const u32x4*)(GM + (size_t)row * 2048 + col);
                    f32x4 a = acc[ai][bj][m][0], b = acc[ai][bj][m][1];
                    a[0] *= bf_lo(g.x); a[1] *= bf_hi(g.x); a[2] *= bf_lo(g.y); a[3] *= bf_hi(g.y);
                    b[0] *= bf_lo(g.z); b[1] *= bf_hi(g.z); b[2] *= bf_lo(g.w); b[3] *= bf_hi(g.w);
                    float* p = T1 + (size_t)row * 1024 + col; *(f32x4*)p = a; *(f32x4*)(p + 4) = b; } }
    }
};
struct EpiG2 {
    static constexpr bool PERM = true, AFTER_DRAIN = false; static constexpr int MIDK = -1;
    const bf16_t* GM; const float* T1; bf16_t* MG;
    __device__ __forceinline__ void operator()(const f32x4 (&acc)[2][2][4][2], const Unit& u, int wr, int wc, int fr, int fq) const {
        const int row0 = u.pm * 256 + wr * 64 + fr, col0 = u.pn * 256 + wc * 32 + 8 * fq;
#pragma unroll
        for (int ai = 0; ai < 2; ++ai)
#pragma unroll
            for (int m = 0; m < 4; ++m) { const int row = row0 + ai * 128 + m * 16;
#pragma unroll
                for (int bj = 0; bj < 2; ++bj) { const int col = col0 + bj * 128;
                    const u32x4 g = *(const u32x4*)(GM + (size_t)row * 2048 + 1024 + col);
                    const float* p = T1 + (size_t)row * 1024 + col; f32x4 a = *(const f32x4*)p, b = *(const f32x4*)(p + 4);
                    const f32x4 x = acc[ai][bj][m][0], y = acc[ai][bj][m][1];
                    a[0] += x[0] * bf_lo(g.x); a[1] += x[1] * bf_hi(g.x); a[2] += x[2] * bf_lo(g.y); a[3] += x[3] * bf_hi(g.y);
                    b[0] += y[0] * bf_lo(g.z); b[1] += y[1] * bf_hi(g.z); b[2] += y[2] * bf_lo(g.w); b[3] += y[3] * bf_hi(g.w);
                    *(u32x4*)(MG + (size_t)row * 1024 + col) = pack8(a, b); } }
    }
};
struct EpiMerge {
    static constexpr bool PERM = true, AFTER_DRAIN = false; static constexpr int MIDK = 16;
    const bf16_t* GM; bf16_t* MG;
    __device__ __forceinline__ void mid(f32x4 (&acc)[2][2][4][2], const Unit& u, int, int, int, int) const {
        int t_ = threadIdx.x; asm volatile("" : "+v"(t_));
        const int wid_ = t_ >> 6, wr = wid_ >> 2, wc = wid_ & 3, fr = t_ & 15, fq = (t_ >> 4) & 3;
        const bf16_t* gp = GM + (size_t)(u.pm * 256 + wr * 64 + fr) * 2048 + u.pn * 256 + wc * 32 + 8 * fq;
#pragma unroll
        for (int ai = 0; ai < 2; ++ai) {
#pragma unroll
            for (int m = 0; m < 4; ++m)
#pragma unroll
                for (int bj = 0; bj < 2; ++bj) {
                    const u32x4 g1 = __builtin_nontemporal_load((const u32x4*)(gp + (size_t)(ai * 128 + m * 16) * 2048 + bj * 128));
                    f32x4 a = acc[ai][bj][m][0], b = acc[ai][bj][m][1];
                    a[0] *= bf_lo(g1.x); a[1] *= bf_hi(g1.x); a[2] *= bf_lo(g1.y); a[3] *= bf_hi(g1.y);
                    b[0] *= bf_lo(g1.z); b[1] *= bf_hi(g1.z); b[2] *= bf_lo(g1.w); b[3] *= bf_hi(g1.w);
                    acc[ai][bj][m][0] = a; acc[ai][bj][m][1] = b; }
            asm volatile("" ::: "memory");
        }
    }
    __device__ __forceinline__ void operator()(const f32x4 (&acc)[2][2][4][2], const Unit& u, int wr, int wc, int fr, int fq) const {
        const int row0 = u.pm * 256 + wr * 64 + fr, col0 = u.pn * 256 + wc * 32 + 8 * fq;
        const wt_rsrc rs = wt_make(MG, (unsigned)(16640u * 1024u * 2u));
#pragma unroll
        for (int ai = 0; ai < 2; ++ai)
#pragma unroll
            for (int m = 0; m < 4; ++m) { const int row = row0 + ai * 128 + m * 16;
#pragma unroll
                for (int bj = 0; bj < 2; ++bj) { const int col = col0 + bj * 128;
                    const u32x4 g2 = __builtin_nontemporal_load((const u32x4*)(GM + (size_t)row * 2048 + 1024 + col));
                    f32x4 a = acc[ai][bj][m][0], b = acc[ai][bj][m][1];
                    a[0] *= bf_lo(g2.x); a[1] *= bf_hi(g2.x); a[2] *= bf_lo(g2.y); a[3] *= bf_hi(g2.y);
                    b[0] *= bf_lo(g2.z); b[1] *= bf_hi(g2.z); b[2] *= bf_lo(g2.w); b[3] *= bf_hi(g2.w);
                    st_wt16(rs, (unsigned)(row * 1024 + col) * 2u, pack8(a, b)); } }
    }
};
struct EpiOut {
    static constexpr bool PERM = true, AFTER_DRAIN = false; static constexpr int MIDK = -1;
    const float *xp, *xs; float* y;
    __device__ __forceinline__ void operator()(const f32x4 (&acc)[2][2][4][2], const Unit& u, int wr, int wc, int fr, int fq) const {
        const int row0 = u.pm * 256 + wr * 64 + fr, col0 = u.pn * 256 + wc * 32 + 8 * fq;
        const float* xb = (u.pm < 64) ? xp : (xs - (size_t)MP_ * 1024);
#pragma unroll
        for (int ai = 0; ai < 2; ++ai)
#pragma unroll
            for (int m = 0; m < 4; ++m) { const int row = row0 + ai * 128 + m * 16;
#pragma unroll
                for (int bj = 0; bj < 2; ++bj) { const size_t off = (size_t)row * 1024 + col0 + bj * 128;
                    const f32x4 a = __builtin_nontemporal_load((const f32x4*)(xb + off)) + acc[ai][bj][m][0], b = __builtin_nontemporal_load((const f32x4*)(xb + off + 4)) + acc[ai][bj][m][1];
                    __builtin_nontemporal_store(a, (f32x4*)(y + off)); __builtin_nontemporal_store(b, (f32x4*)(y + off + 4)); } }
    }
};

template <class Epi, class Sched, bool ALIGN_EPI = false, bool SP2 = false, class CP = NoCopy>
__device__ __forceinline__ void gemm_phase(PG8_LAS unsigned char* lds, const Gemm g, const Sched& S, const Epi& E, const CP& cp = CP()) {
    int tid_ = threadIdx.x; asm volatile("" : "+v"(tid_));
    const int tid = tid_, wid = __builtin_amdgcn_readfirstlane(tid >> 6), lane = tid & 63, wr = wid >> 2, wc = wid & 3, fr = lane & 15, fq = lane >> 4;
    const int K = g.K, nt = K / BK;
    unsigned voffA[2], voffB[2];
#pragma unroll
    for (int i = 0; i < 2; ++i) { int R, C; stage_rc(tid * 16 + i * 8192, R, C); const int Rb = Epi::PERM ? ((R & ~31) + perm32(R & 31)) : R;
        voffA[i] = (unsigned)(R * K + C) * 2u; voffB[i] = (unsigned)(Rb * K + C) * 2u; }
    const size_t kstep = (size_t)(BK * 2);
    const size_t hstep = (size_t)HALF * K * 2;
    const size_t tstep = 2 * hstep;
    const unsigned ldsw = (unsigned)wid * 1024u;
    const int aoff = lds_byte(wr * 64 + fr, fq * 8), boff = lds_byte(wc * 32 + fr, fq * 8);
#define PG8_SA(b, h) (((b) * 2 + (h)) * HTB)
#define PG8_SB(b, h) ((4 + (b) * 2 + (h)) * HTB)
#define PG8_STAGE(bufoff, gbase, voff) do { _Pragma("unroll") for (int _i = 0; _i < 2; ++_i) \
        __builtin_amdgcn_global_load_lds((const unsigned*)((const char*)(gbase) + (voff)[_i]), (PG8_LAS unsigned*)(lds + (bufoff) + ldsw + _i * 8192), 16, 0, 0); } while (0)
#define PG8_LDA(dst, b, h) do { _Pragma("unroll") for (int m = 0; m < 4; ++m) _Pragma("unroll") for (int k = 0; k < 2; ++k) dst[m][k] = *(const PG8_LAS bf16x8*)(lds + PG8_SA(b, h) + aoff + m * 2048 + k * 1024); } while (0)
#define PG8_LDB(dst, b, h) do { _Pragma("unroll") for (int n = 0; n < 2; ++n) _Pragma("unroll") for (int k = 0; k < 2; ++k) dst[n][k] = *(const PG8_LAS bf16x8*)(lds + PG8_SB(b, h) + boff + n * 2048 + k * 1024); } while (0)
#define PG8_MMA(ai, bj, At, Bt) do { __builtin_amdgcn_s_setprio(1); _Pragma("unroll") for (int m = 0; m < 4; ++m) _Pragma("unroll") for (int n = 0; n < 2; ++n) _Pragma("unroll") for (int k = 0; k < 2; ++k) \
        acc[ai][bj][m][n] = __builtin_amdgcn_mfma_f32_16x16x32_bf16(Bt[n][k], At[m][k], acc[ai][bj][m][n], 0, 0, 0); __builtin_amdgcn_s_setprio(0); } while (0)
#define PG8_WAIT_V(n) asm volatile("s_waitcnt vmcnt(" #n ")" ::: "memory")
#define PG8_WAIT_L(n) asm volatile("s_waitcnt lgkmcnt(" #n ")" ::: "memory")
#define PG8_BAR __builtin_amdgcn_s_barrier()
#define PG8_SCHED __builtin_amdgcn_sched_barrier(0)
    Unit cur, nxt; int ui = 0;
    if (!S.next(0, cur)) return;
    f32x4 acc[2][2][4][2];
#pragma unroll
    for (int a = 0; a < 2; ++a)
#pragma unroll
        for (int b = 0; b < 2; ++b)
#pragma unroll
            for (int m = 0; m < 4; ++m)
#pragma unroll
                for (int n = 0; n < 2; ++n) acc[a][b][m][n] = (f32x4){0.f, 0.f, 0.f, 0.f};
    bf16x8 At[4][2], B0[2][2], B1[2][2];
    int cq = 0; u32x4 cpv = (u32x4){0u, 0u, 0u, 0u}; (void)cq; (void)cpv;
    const char* cA = (const char*)g.A + (size_t)cur.pm * tstep; const char* cB = (const char*)g.Bt + (size_t)cur.pn * tstep;
    S.a_ready(cur);
    if constexpr (SP2) {
        PG8_STAGE(PG8_SB(0, 0), cB, voffB); PG8_STAGE(PG8_SB(0, 1), cB + hstep, voffB); PG8_STAGE(PG8_SA(0, 0), cA, voffA); PG8_STAGE(PG8_SA(0, 1), cA + hstep, voffA);
        if (wr == 1) PG8_BAR;
        PG8_WAIT_V(2); PG8_BAR;
        PG8_STAGE(PG8_SB(1, 0), cB + kstep, voffB); PG8_STAGE(PG8_SA(1, 0), cA + kstep, voffA); PG8_STAGE(PG8_SB(1, 1), cB + hstep + kstep, voffB);
        PG8_WAIT_V(6); PG8_BAR;
        if constexpr (CP::ON) cp.st(cp.rd(lds, -1, tid), -1, tid);
    } else {
        PG8_STAGE(PG8_SB(0, 0), cB, voffB); PG8_STAGE(PG8_SA(0, 0), cA, voffA); PG8_STAGE(PG8_SB(0, 1), cB + hstep, voffB); PG8_STAGE(PG8_SA(0, 1), cA + hstep, voffA);
        if (wr == 1) PG8_BAR;
        PG8_WAIT_V(4); PG8_BAR;
        PG8_STAGE(PG8_SB(1, 0), cB + kstep, voffB); PG8_STAGE(PG8_SA(1, 0), cA + kstep, voffA); PG8_STAGE(PG8_SB(1, 1), cB + hstep + kstep, voffB);
        PG8_WAIT_V(6); PG8_BAR;
    }
    for (;;) {
        const bool has_next = S.next(ui + 1, nxt);
        const char* nA = has_next ? (const char*)g.A + (size_t)nxt.pm * tstep : cA; const char* nB = has_next ? (const char*)g.Bt + (size_t)nxt.pn * tstep : cB;
        for (int t = 0; t < nt; t += 2) {
            if constexpr (Epi::MIDK >= 0) { if (t == Epi::MIDK) E.mid(acc, cur, wr, wc, fr, fq); }
            const bool last = (t == nt - 2);
            const char* a1 = cA + (size_t)(t + 1) * kstep;
            const char* a2 = last ? nA : cA + (size_t)(t + 2) * kstep; const char* b2 = last ? nB : cB + (size_t)(t + 2) * kstep;
            const char* a3 = a2 + kstep; const char* b3 = b2 + kstep;
            if (last && has_next) S.a_ready(nxt);
            if constexpr (SP2) {
#define PG8_WAIT_VC() do { if constexpr (CP::ON) PG8_WAIT_V(12); else PG8_WAIT_V(8); } while (0)
#define PG8_CP_DMA() do { if constexpr (CP::ON) cp.dma(lds, cq, tid, wid); } while (0)
#define PG8_CP_RD() do { if constexpr (CP::ON) cpv = cp.rd(lds, cq - 2, tid); } while (0)
#define PG8_CP_ST() do { if constexpr (CP::ON) { cp.st(cpv, cq - 2, tid); ++cq; } } while (0)
            PG8_LDB(B0, 0, 0); PG8_LDB(B1, 0, 1); PG8_SCHED; PG8_LDA(At, 0, 0); PG8_CP_DMA(); PG8_STAGE(PG8_SA(1, 1), a1 + hstep, voffA);
            PG8_WAIT_VC(); PG8_CP_RD(); PG8_WAIT_L(0); PG8_BAR; PG8_CP_ST(); PG8_MMA(0, 0, At, B0); PG8_MMA(0, 1, At, B1); PG8_BAR; PG8_SCHED;
            PG8_LDA(At, 0, 1); PG8_CP_DMA(); PG8_STAGE(PG8_SB(0, 0), b2, voffB); PG8_STAGE(PG8_SB(0, 1), b2 + hstep, voffB); PG8_STAGE(PG8_SA(0, 0), a2, voffA);
            PG8_WAIT_VC(); PG8_CP_RD(); PG8_WAIT_L(0); PG8_BAR; PG8_CP_ST(); PG8_MMA(1, 0, At, B0); PG8_MMA(1, 1, At, B1); PG8_BAR; PG8_SCHED;
            PG8_LDB(B0, 1, 0); PG8_LDB(B1, 1, 1); PG8_SCHED; PG8_LDA(At, 1, 0); PG8_CP_DMA(); PG8_STAGE(PG8_SA(0, 1), a2 + hstep, voffA);
            PG8_WAIT_VC(); PG8_CP_RD(); PG8_WAIT_L(0); PG8_BAR; PG8_CP_ST(); PG8_MMA(0, 0, At, B0); PG8_MMA(0, 1, At, B1); PG8_BAR; PG8_SCHED;
            PG8_LDA(At, 1, 1); PG8_CP_DMA(); PG8_STAGE(PG8_SB(1, 0), b3, voffB); PG8_STAGE(PG8_SB(1, 1), b3 + hstep, voffB); PG8_STAGE(PG8_SA(1, 0), a3, voffA);
            PG8_WAIT_VC(); PG8_CP_RD(); PG8_WAIT_L(0); PG8_BAR; PG8_CP_ST(); PG8_MMA(1, 0, At, B0); PG8_MMA(1, 1, At, B1); PG8_BAR; PG8_SCHED;
            } else {
            PG8_LDB(B0, 0, 0); PG8_SCHED; PG8_LDA(At, 0, 0); PG8_STAGE(PG8_SA(1, 1), a1 + hstep, voffA);
            PG8_WAIT_L(8); PG8_BAR; PG8_WAIT_L(0); PG8_MMA(0, 0, At, B0); PG8_BAR; PG8_SCHED;
            PG8_LDB(B1, 0, 1); PG8_STAGE(PG8_SB(0, 0), b2, voffB);
            PG8_BAR; PG8_WAIT_L(0); PG8_MMA(0, 1, At, B1); PG8_BAR;
            PG8_LDA(At, 0, 1); PG8_STAGE(PG8_SA(0, 0), a2, voffA);
            PG8_BAR; PG8_WAIT_L(0); PG8_MMA(1, 0, At, B0); PG8_BAR; PG8_SCHED;
            PG8_STAGE(PG8_SB(0, 1), b2 + hstep, voffB);
            PG8_WAIT_V(6); PG8_BAR; PG8_MMA(1, 1, At, B1); PG8_BAR;
            PG8_LDB(B0, 1, 0); PG8_SCHED; PG8_LDA(At, 1, 0); PG8_STAGE(PG8_SA(0, 1), a2 + hstep, voffA);
            PG8_WAIT_L(8); PG8_BAR; PG8_WAIT_L(0); PG8_MMA(0, 0, At, B0); PG8_BAR; PG8_SCHED;
            PG8_LDB(B1, 1, 1); PG8_STAGE(PG8_SB(1, 0), b3, voffB);
            PG8_BAR; PG8_WAIT_L(0); PG8_MMA(0, 1, At, B1); PG8_BAR;
            PG8_LDA(At, 1, 1); PG8_STAGE(PG8_SA(1, 0), a3, voffA);
            PG8_BAR; PG8_WAIT_L(0); PG8_MMA(1, 0, At, B0); PG8_BAR; PG8_SCHED;
            PG8_STAGE(PG8_SB(1, 1), b3 + hstep, voffB);
            PG8_WAIT_V(6); PG8_BAR; PG8_MMA(1, 1, At, B1); PG8_BAR;
            }
        }
        if constexpr (ALIGN_EPI) { if (wr == 0) PG8_BAR; }
        if constexpr (!Epi::AFTER_DRAIN) { E(acc, cur, wr, wc, fr, fq); S.done(cur); }
        if (!has_next) break;
#pragma unroll
        for (int a = 0; a < 2; ++a)
#pragma unroll
            for (int b = 0; b < 2; ++b)
#pragma unroll
                for (int m = 0; m < 4; ++m)
#pragma unroll
                    for (int n = 0; n < 2; ++n) acc[a][b][m][n] = (f32x4){0.f, 0.f, 0.f, 0.f};
        cur = nxt; cA = nA; cB = nB; ++ui;
        if constexpr (ALIGN_EPI) { if (wr == 1) PG8_BAR; }
    }
    PG8_WAIT_V(0);
    if constexpr (!ALIGN_EPI) { if (wr == 0) PG8_BAR; }
    PG8_BAR;
    if constexpr (Epi::AFTER_DRAIN) { E.fused(acc, cur, wr, wc, fr, fq, lds, wid, lane); S.done(cur); }
#undef PG8_SA
#undef PG8_SB
#undef PG8_STAGE
#undef PG8_LDA
#undef PG8_LDB
#undef PG8_MMA
#undef PG8_WAIT_V
#undef PG8_WAIT_VC
#undef PG8_CP_DMA
#undef PG8_CP_RD
#undef PG8_CP_ST
#undef PG8_WAIT_L
#undef PG8_BAR
#undef PG8_SCHED
}
}
#define GAS __attribute__((address_space(1)))
#define LAS __attribute__((address_space(3)))
typedef unsigned short bf16;
typedef unsigned v4u __attribute__((ext_vector_type(4)));
typedef float f32x4 __attribute__((ext_vector_type(4)));
typedef short bf16x8 __attribute__((ext_vector_type(8)));
typedef GAS unsigned gu32;
typedef GAS unsigned long long gu64;
#define RLX_AGENT __ATOMIC_RELAXED, __HIP_MEMORY_SCOPE_AGENT
#define LDS_WAIT() asm volatile("s_waitcnt lgkmcnt(0)" ::: "memory")
#define VM_WAIT() asm volatile("s_waitcnt vmcnt(0)" ::: "memory")
__device__ __forceinline__ unsigned long long rt() { return __builtin_amdgcn_s_memrealtime(); }
__device__ __forceinline__ unsigned f2bf(float f) { unsigned u = __builtin_bit_cast(unsigned, f); return (u + 0x7fffu + ((u >> 16) & 1u)) >> 16; }
__device__ __forceinline__ unsigned pk2(float lo, float hi) { return f2bf(lo) | (f2bf(hi) << 16); }
#define XB_TMO      128
#define XB_XCNT(j)  (256  + 64 * (j))
#define XB_XSUB(j)  (1280 + 64 * (j))
#define XB_XGEN(j)  (2304 + 64 * (j))
#define XB_TOP      3328
#define XB_TOPGEN   3392
#define XCD_BAR_WORDS 3456
#define XB_SPIN_CAP (1u << 18)

__device__ __forceinline__ unsigned xb_ld(unsigned* p)              { return __hip_atomic_load(p, __ATOMIC_RELAXED, __HIP_MEMORY_SCOPE_AGENT); }
__device__ __forceinline__ unsigned xb_add(unsigned* p, unsigned v) { return __hip_atomic_fetch_add(p, v, __ATOMIC_RELAXED, __HIP_MEMORY_SCOPE_AGENT); }
__device__ __forceinline__ unsigned xb_xcc_id() { return (unsigned)__builtin_amdgcn_s_getreg((3 << 11) | 20) & 0xFu; }
#define XB_SPIN(cond, bar) do { unsigned _sp = 0; while (cond) { __builtin_amdgcn_s_sleep(1); \
    if ((++_sp & 255u) == 0u) { if (xb_ld(&(bar)[XB_TMO])) break; if (_sp > XB_SPIN_CAP) { atomicAdd(&(bar)[XB_TMO], 1u); break; } } } } while (0)

struct XcdBarrier {
    unsigned* bar; unsigned x;
    volatile LAS unsigned* st;
};

__device__ __forceinline__ XcdBarrier xcd_barrier_post(unsigned* bar, volatile LAS unsigned* st) {
    XcdBarrier b; b.bar = bar; b.x = xb_xcc_id(); b.st = st;
    if (threadIdx.x == 0) (void)xb_add(&bar[XB_XCNT(b.x)], 1u);
    return b;
}
__device__ __forceinline__ void xcd_barrier_complete(unsigned* bar, unsigned x, unsigned& nloc, unsigned& nx) {
    const unsigned G = gridDim.x * gridDim.y * gridDim.z;
    unsigned sum, cnt, mine, sp = 0u;
    for (;;) {
        sum = 0u; cnt = 0u; mine = 0u;
#pragma unroll
        for (unsigned j = 0; j < 16; ++j) { const unsigned c = xb_ld(&bar[XB_XCNT(j)]); sum += c; cnt += (c > 0u) ? 1u : 0u; mine = (j == x) ? c : mine; }
        if (sum == G) break;
        __builtin_amdgcn_s_sleep(1);
        if ((++sp & 255u) == 0u) { if (xb_ld(&bar[XB_TMO])) break; if (sp > XB_SPIN_CAP) { atomicAdd(&bar[XB_TMO], 1u); break; } }
    }
    nloc = mine > 0u ? mine : 1u; nx = cnt > 0u ? cnt : 1u;
}

__device__ __forceinline__ void xcd_barrier(const XcdBarrier& b) {
    asm volatile("s_waitcnt vmcnt(0)" ::: "memory");
    __syncthreads();
    if (threadIdx.x == 0) {
        unsigned* bar = b.bar;
        __builtin_amdgcn_s_waitcnt(0);
        unsigned nloc = b.st[0], nx = b.st[1];
        if (nloc == 0u) { xcd_barrier_complete(bar, b.x, nloc, nx); b.st[0] = nloc; b.st[1] = nx; }
        const unsigned old = xb_add(&bar[XB_XSUB(b.x)], 1u);
        const unsigned gen = old / nloc;
        if (old + 1u == (gen + 1u) * nloc) {
            __builtin_amdgcn_fence(__ATOMIC_RELEASE, "agent");
            asm volatile("s_waitcnt vmcnt(0)" ::: "memory");
            const unsigned og = xb_add(&bar[XB_TOP], 1u);
            const unsigned tg = og / nx;
            if (og + 1u == (tg + 1u) * nx) xb_add(&bar[XB_TOPGEN], 1u);
            else XB_SPIN(xb_ld(&bar[XB_TOPGEN]) == tg, bar);
            __builtin_amdgcn_fence(__ATOMIC_ACQUIRE, "agent");
            xb_add(&bar[XB_XGEN(b.x)], 1u);
            asm volatile("s_waitcnt vmcnt(0)" ::: "memory");
        } else {
            XB_SPIN(xb_ld(&bar[XB_XGEN(b.x)]) == gen, bar);
            __builtin_amdgcn_fence(__ATOMIC_ACQUIRE, "agent");
            asm volatile("s_waitcnt vmcnt(0)" ::: "memory");
        }
    }
    __syncthreads();
}

constexpr int NWAVES = 8;
constexpr int MP = 16384, MS = 256, MT = MP + MS;
constexpr int DMOD = 1024, DIN = 9216, DQKV = 1536, DAO = 512, NHEAD = 12, KCAT = 1536;
constexpr float LOG2E = 1.4426950408889634f, LN2 = 0.6931471805599453f;
constexpr float QSCALE = 0.08838834764831845f * LOG2E;
constexpr int TABW = 192;
constexpr size_t O_YP = 0, O_YS = O_YP + (size_t)MP * 1024, O_KV128P = O_YS + (size_t)MS * 1024, O_KV512P = O_KV128P + (size_t)8 * 128 * 1024,
                 O_KV2048P = O_KV512P + (size_t)8 * 512 * 1024, O_CONVP = O_KV2048P + (size_t)8 * 2048 * 1024, O_HP = O_CONVP + 8 * 3 * 1024,
                 O_KV128S = O_HP + 8 * 1024, O_KV512S = O_KV128S + (size_t)32 * 128 * 1024, O_KV2048S = O_KV512S + (size_t)32 * 512 * 1024,
                 O_CONVS = O_KV2048S + (size_t)32 * 2048 * 1024, O_HS = O_CONVS + 32 * 3 * 1024, O_END = O_HS + 32 * 1024;
constexpr size_t MiB = 1u << 20;
constexpr size_t WS_CTL = 0, CTL_ZERO_BYTES = 64 * 1024;
constexpr size_t WS_BT = 1 * MiB, WS_WIN = 2 * MiB, WS_WLRU = 20 * MiB, WS_WATT = 22 * MiB, WS_WOUT = 23 * MiB, WS_WA = 25 * MiB, WS_WX = 25 * MiB + 512 * 1024,
                 WS_PEND = 26 * MiB, WS_HEND = 27 * MiB, WS_LSE = 28 * MiB,
                 WS_XN = 32 * MiB, WS_XA = 65 * MiB, WS_SGA = 98 * MiB, WS_Q = 131 * MiB, WS_K = 180 * MiB, WS_V = 229 * MiB, WS_SGB = 278 * MiB, WS_GM = 295 * MiB,
                 WS_O = 360 * MiB, WS_HL = 409 * MiB, WS_PP = 442 * MiB, WS_A1 = 475 * MiB, WS_A2 = 508 * MiB, WS_T1 = 525 * MiB, WS_MG = 590 * MiB, WS_PART = 623 * MiB, WS_DUMMY = 636 * MiB, WS_WCAT = 639 * MiB, WS_ACAT = 409 * MiB  , WS_END = 643 * MiB;
constexpr int CW_BAR = 1024, CW_Q2 = 512, CW_MRG = 896, CW_LFLAG = 8192, CW_Q3 = 640;
constexpr int CW_CHAIN = 5120, CH_A2 = 0, CH_M = 64 * 16, CH_5 = 72 * 16, CH_S = 136 * 16, CH_S1 = 144 * 16, CH_P2 = 145 * 16, CH_P3 = 146 * 16;
constexpr int PSLOTS = 21, PSTRIDE = 132;
static_assert((CW_BAR + XCD_BAR_WORDS) * 4 <= (int)CTL_ZERO_BYTES, "ctl");
constexpr int RING_OFF = 0, RING_BYTES = 131072, CPR_OFF = 131072  , EPI_OFF = CPR_OFF + 24576  ,
              SCR_OFF = CPR_OFF, TAB_OFF = EPI_OFF + 4096, MISC_OFF = TAB_OFF + 1024, LDS_BYTES = 163840;
static_assert(MISC_OFF + 128 <= LDS_BYTES, "LDS map");

typedef unsigned u32x2 __attribute__((ext_vector_type(2)));
typedef short v4i16_t __attribute__((ext_vector_type(4)));
typedef float f32x2 __attribute__((ext_vector_type(2)));

struct Args {
    const float* in[23]; float* out; unsigned char* ws; int ph_lo, ph_hi, qslot, sub;
};
struct Frame {
    LAS unsigned char* lds; int tid, lane, wave, vcu, G;
};
__device__ __forceinline__ float wave_sum(float v) {
#pragma unroll
    for (int o = 1; o < 64; o <<= 1) v += __shfl_xor(v, o);
    return v;
}
__device__ __forceinline__ unsigned cvtpk(float lo, float hi) { return pg8::cvt_pk_bf16(lo, hi); }
__device__ __forceinline__ float bflo(unsigned w) { return __uint_as_float(w << 16); }
__device__ __forceinline__ float bfhi(unsigned w) { return __uint_as_float(w & 0xffff0000u); }
__device__ __forceinline__ float silu_lo(unsigned w) { return pg8::silu_f(bflo(w)); }
__device__ __forceinline__ float silu_hi(unsigned w) { return pg8::silu_f(bfhi(w)); }
__device__ __forceinline__ unsigned off_b(unsigned row, unsigned ch) { return 256u * row + 16u * (ch ^ (((row & 3u) << 2) | ((row >> 2) & 3u))); }

struct BgCopy { v4u r[16]; };
__device__ __forceinline__ void bg_addr(const Args& A, int c, const float*& src, float*& dst) {
    if (c < 1920) { const int db = c / 60, r = c - db * 60; src = A.in[2] + ((size_t)db * 128 + 8) * 1024 + (size_t)r * 2048; dst = A.out + O_KV128S + (size_t)db * 128 * 1024 + (size_t)r * 2048; }
    else if (c < 1920 + 8064) { c -= 1920; const int db = c / 252, r = c - db * 252; src = A.in[3] + ((size_t)db * 512 + 8) * 1024 + (size_t)r * 2048; dst = A.out + O_KV512S + (size_t)db * 512 * 1024 + (size_t)r * 2048; }
    else { c -= 9984; const int db = c / 1020, r = c - db * 1020; src = A.in[4] + ((size_t)db * 2048 + 8) * 1024 + (size_t)r * 2048; dst = A.out + O_KV2048S + (size_t)db * 2048 * 1024 + (size_t)r * 2048; }
}
__device__ __forceinline__ void bg_load(const Args& A, int cu, int tid, BgCopy& B) {
#pragma unroll
    for (int i = 0; i < 16; ++i) { const float* src; float* dst; bg_addr(A, 16 * cu + i, src, dst); B.r[i] = __builtin_nontemporal_load((const v4u*)src + tid); }
}
__device__ __forceinline__ void bg_store(const Args& A, int cu, int tid, const BgCopy& B) {
#pragma unroll
    for (int i = 0; i < 16; ++i) { const float* src; float* dst; bg_addr(A, 16 * cu + i, src, dst); __builtin_nontemporal_store(B.r[i], (v4u*)dst + tid); }
}
constexpr int BG_UNITS = 2664;
struct BgHalf { v4u r[8]; };
__device__ __forceinline__ void bg2h_load(const Args& A, int u, int hf, int tid, BgHalf& B) {
    const int db = u >> 5, rg0 = 4 * (u & 31) + 2 * hf;
#pragma unroll
    for (int i = 0; i < 2; ++i) { const v4u* src = (const v4u*)(A.in[4] + ((size_t)db * 2048 + 16 * (rg0 + i) + 8) * 1024);
#pragma unroll
        for (int j = 0; j < 4; ++j) B.r[4 * i + j] = __builtin_nontemporal_load(src + tid + 512 * j); }
}
__device__ __forceinline__ void bg2h_store(const Args& A, int u, int hf, int tid, const BgHalf& B) {
    const int db = u >> 5, rg0 = 4 * (u & 31) + 2 * hf;
#pragma unroll
    for (int i = 0; i < 2; ++i) { v4u* dst = (v4u*)(A.out + O_KV2048S + ((size_t)db * 2048 + 16 * (rg0 + i)) * 1024);
#pragma unroll
        for (int j = 0; j < 4; ++j) __builtin_nontemporal_store(B.r[4 * i + j], dst + tid + 512 * j); }
}
__device__ __forceinline__ void bg2_load(const Args& A, int u, int tid, BgCopy& B) {
    const int db = u >> 5, rg0 = 4 * (u & 31);
#pragma unroll
    for (int i = 0; i < 4; ++i) { const v4u* src = (const v4u*)(A.in[4] + ((size_t)db * 2048 + 16 * (rg0 + i) + 8) * 1024);
#pragma unroll
        for (int j = 0; j < 4; ++j) B.r[4 * i + j] = __builtin_nontemporal_load(src + tid + 512 * j); }
}
__device__ __forceinline__ void bg2_store(const Args& A, int u, int tid, const BgCopy& B) {
    const int db = u >> 5, rg0 = 4 * (u & 31);
#pragma unroll
    for (int i = 0; i < 4; ++i) { v4u* dst = (v4u*)(A.out + O_KV2048S + ((size_t)db * 2048 + 16 * (rg0 + i)) * 1024);
#pragma unroll
        for (int j = 0; j < 4; ++j) __builtin_nontemporal_store(B.r[4 * i + j], dst + tid + 512 * j); }
}

__device__ __forceinline__ void p0_transpose_item(const float* W, int K, int N, bf16* WT, LAS float* scr, int item, int lane, int ldo = 0, int koff = 0, bool gmil = false) {
    if (ldo == 0) ldo = K;
    const int nblk = N / 32, kb = item / nblk, nb = item % nblk, k0 = 64 * kb, n0 = 32 * nb;
    int nd0 = n0;
    if (gmil && n0 >= 7168) { const int cc = n0 - 7168, sel = cc >> 10, chn = cc & 1023; nd0 = 7168 + 256 * (chn >> 7) + 128 * sel + (chn & 127); }
#pragma unroll 8
    for (int i = 0; i < 32; ++i) { const int kk = 2 * i + (lane >> 5); scr[kk * 33 + (lane & 31)] = __builtin_nontemporal_load(W + (size_t)(k0 + kk) * N + n0 + (lane & 31)); }
    LDS_WAIT(); asm volatile("" ::: "memory");
    const int c = lane & 7;
#pragma unroll
    for (int j = 0; j < 4; ++j) { const int n = (lane >> 3) + 8 * j; const LAS float* s = scr + (8 * c) * 33 + n;
        v4u o; o.x = pk2(s[0 * 33], s[1 * 33]); o.y = pk2(s[2 * 33], s[3 * 33]); o.z = pk2(s[4 * 33], s[5 * 33]); o.w = pk2(s[6 * 33], s[7 * 33]);
        *(GAS v4u*)(WT + (size_t)(nd0 + n) * ldo + koff + k0 + 8 * c) = o; }
    LDS_WAIT(); asm volatile("" ::: "memory");
}
__device__ __forceinline__ int t5_bucket(int dist) {
    if (dist < 16) return dist;
    const int large = 16 + (int)(log((double)dist / 16.0) / log(128.0) * 16.0);
    return large < 31 ? large : 31;
}
template <int L>
__device__ __forceinline__ void copy_region(const float* src, float* dst, unsigned gt, unsigned nt) {
    constexpr unsigned per = (unsigned)(L - 8) * 256u, total = 32u * per;
    for (unsigned i = gt; i < total; i += 4 * nt) {
        f32x4 v[4];
#pragma unroll
        for (int k = 0; k < 4; ++k) { const unsigned j = i + k * nt; if (j < total) { const unsigned db = j / per, rem = j - db * per; v[k] = __builtin_nontemporal_load((const f32x4*)(src + ((size_t)db * L + 8) * 1024) + rem); } }
#pragma unroll
        for (int k = 0; k < 4; ++k) { const unsigned j = i + k * nt; if (j < total) { const unsigned db = j / per, rem = j - db * per; __builtin_nontemporal_store(v[k], (f32x4*)(dst + (size_t)db * L * 1024) + rem); } }
    }
}
__device__ __forceinline__ void p0_prologue(const Frame& F, const Args& A) {
    unsigned char* ws = A.ws;
    LAS float* scr = (LAS float*)(F.lds + RING_OFF + F.wave * 16384);
    const int gw = F.vcu * NWAVES + F.wave, NGW = F.G * NWAVES;
    constexpr int I_IN = (1024 / 64) * (DIN / 32), I_LRU = 16 * 32, I_ATT = (512 / 64) * 32, I_OUT = 16 * 32, I_G = 8 * (2 * 4);
    constexpr int NITEMS = I_IN + I_LRU + I_ATT + I_OUT + 2 * I_G;
    for (int it = gw; it < NITEMS; it += NGW) {
        int r = it;
        if (r < I_IN) { p0_transpose_item(A.in[8], 1024, DIN, (bf16*)(ws + WS_WIN), scr, r, F.lane, 0, 0, true); continue; } r -= I_IN;
        if (r < I_LRU) { p0_transpose_item(A.in[20], 1024, 1024, (bf16*)(ws + WS_WCAT), scr, r, F.lane, KCAT, 0); continue; } r -= I_LRU;
        if (r < I_ATT) { p0_transpose_item(A.in[21], 512, 1024, (bf16*)(ws + WS_WCAT), scr, r, F.lane, KCAT, 1024); continue; } r -= I_ATT;
        if (r < I_OUT) { p0_transpose_item(A.in[22], 1024, 1024, (bf16*)(ws + WS_WOUT), scr, r, F.lane); continue; } r -= I_OUT;
        if (r < I_G) { const int n = r >> 3; p0_transpose_item(A.in[12] + n * 16384, 128, 128, (bf16*)(ws + WS_WA) + n * 16384, scr, r & 7, F.lane); continue; } r -= I_G;
        { const int n = r >> 3; p0_transpose_item(A.in[14] + n * 16384, 128, 128, (bf16*)(ws + WS_WX) + n * 16384, scr, r & 7, F.lane); }
    }
    {
        const float* gn = A.in[7]; bf16* XN = (bf16*)(ws + WS_XN);
        f32x4 gv[4];
#pragma unroll
        for (int j = 0; j < 4; ++j) gv[j] = ((const f32x4*)gn)[F.lane + 64 * j];
        for (int m = gw; m < MT; m += NGW) {
            const float* xrow = (m < MP) ? A.in[0] + (size_t)m * 1024 : A.in[1] + (size_t)(m - MP) * 1024;
            const f32x4* xr = (const f32x4*)xrow + F.lane;
            f32x4 v[4]; float s = 0.f;
#pragma unroll
            for (int j = 0; j < 4; ++j) { v[j] = __builtin_nontemporal_load(xr + 64 * j); s += (v[j].x * v[j].x + v[j].y * v[j].y) + (v[j].z * v[j].z + v[j].w * v[j].w); }
            const float rs = 1.f / sqrtf(wave_sum(s) * (1.f / 1024.f) + 1e-6f);
            unsigned long long* o8 = (unsigned long long*)(XN + (size_t)m * 1024) + F.lane;
#pragma unroll
            for (int j = 0; j < 4; ++j) { const f32x4 y = v[j] * rs * gv[j]; o8[64 * j] = (unsigned long long)cvtpk(y.x, y.y) | ((unsigned long long)cvtpk(y.z, y.w) << 32); }
        }
    }
    {
        const int gt = F.vcu * 512 + F.tid;
        if (gt < NHEAD * TABW) {
            const int h = gt / TABW, idx = gt % TABW, dist = idx - 31, g = h >> 2, dil = 1 << (2 * g);
            float v = -INFINITY;
            if (dist >= 0 && dist <= 128) v = A.in[19][t5_bucket(dist * dil) * NHEAD + h] * LOG2E;
            ((float*)(ws + WS_BT))[gt] = v;
        }
    }
}

constexpr int AT_K = 0, AT_V = 65536;
__device__ __forceinline__ void attn_prompt_unit(const Frame& F, const Args& A, int u, int cu) {
    unsigned char* ws = A.ws;
    const bf16* Qb = (const bf16*)(ws + WS_Q); const bf16* Kb = (const bf16*)(ws + WS_K); const bf16* Vb = (const bf16*)(ws + WS_V);
    bf16* Ob = (bf16*)(ws + WS_O); float* LSE = (float*)(ws + WS_LSE);
    const int b = u / 192, rem = u % 192, h = rem >> 4, x = rem & 15, g = h >> 2, dsh = 2 * g, dil = 1 << dsh, r = x & (dil - 1), n = x >> dsh;
    int tid_o = F.tid; asm volatile("" : "+v"(tid_o));
    const int lane = tid_o & 63, wave = F.wave, l15 = lane & 15, g4 = lane >> 4;
    LAS float* TAB = (LAS float*)(F.lds + TAB_OFF);
    if (tid_o < TABW) TAB[tid_o] = ((const float*)(ws + WS_BT))[h * TABW + tid_o];
    const int klo = (n == 0) ? 128 : 0;
    BgCopy bgc; if (cu >= 0) bg_load(A, cu, tid_o, bgc);
#pragma unroll
    for (int i = 0; i < 8; ++i) {
        const int inst = wave * 8 + i, row0 = 4 * inst;
        if (row0 >= klo) {
            const int row = row0 + g4, ch = l15 ^ (((row & 3) << 2) | ((row >> 2) & 3));
            const int t = (((n - 1) * 128 + row) << dsh) + r;
            const size_t eoff = ((size_t)(b * 2048 + t) * DQKV + h * 128) + ch * 8;
            __builtin_amdgcn_global_load_lds((const unsigned*)(Kb + eoff), (LAS unsigned*)(F.lds + AT_K + inst * 1024), 16, 0, 0);
            __builtin_amdgcn_global_load_lds((const unsigned*)(Vb + eoff), (LAS unsigned*)(F.lds + AT_V + inst * 1024), 16, 0, 0);
        }
    }
    const int qi = 16 * wave + l15, tq = ((n * 128 + qi) << dsh) + r;
    const size_t qrow = (size_t)(b * 2048 + tq);
    bf16x8 qf[4];
#pragma unroll
    for (int s = 0; s < 4; ++s) qf[s] = *(const bf16x8*)(Qb + qrow * DQKV + h * 128 + 32 * s + 8 * g4);
    VM_WAIT(); __syncthreads();
    if (cu >= 0) bg_store(A, cu, tid_o, bgc);
    const int kb0 = 32 * (wave >> 1);
    f32x4 sc[5][2];
#pragma unroll
    for (int ss = 0; ss < 5; ++ss) {
        const int kb = kb0 + 32 * ss;
        if (kb < klo) { sc[ss][0] = (f32x4){-INFINITY, -INFINITY, -INFINITY, -INFINITY}; sc[ss][1] = sc[ss][0]; continue; }
#pragma unroll
        for (int t = 0; t < 2; ++t) {
            const unsigned key = kb + 8 * (l15 >> 2) + 4 * t + (l15 & 3);
            f32x4 acc = (f32x4){0.f, 0.f, 0.f, 0.f};
#pragma unroll
            for (int s = 0; s < 4; ++s) { const bf16x8 a = *(const LAS bf16x8*)(F.lds + AT_K + off_b(key, 4 * s + g4)); acc = __builtin_amdgcn_mfma_f32_16x16x32_bf16(a, qf[s], acc, 0, 0, 0); }
            const int d0 = qi + 128 - (kb + 8 * g4 + 4 * t) + 31;
#pragma unroll
            for (int e = 0; e < 4; ++e) acc[e] += TAB[d0 - e];
            sc[ss][t] = acc;
        }
    }
    float mx = -INFINITY;
#pragma unroll
    for (int ss = 0; ss < 5; ++ss)
#pragma unroll
        for (int t = 0; t < 2; ++t)
#pragma unroll
            for (int e = 0; e < 4; ++e) mx = fmaxf(mx, sc[ss][t][e]);
    mx = fmaxf(mx, __shfl_xor(mx, 16)); mx = fmaxf(mx, __shfl_xor(mx, 32));
    float sum = 0.f; bf16x8 pf[5];
#pragma unroll
    for (int ss = 0; ss < 5; ++ss) {
        float p[8];
#pragma unroll
        for (int t = 0; t < 2; ++t)
#pragma unroll
            for (int e = 0; e < 4; ++e) { p[4 * t + e] = __builtin_amdgcn_exp2f(sc[ss][t][e] - mx); sum += p[4 * t + e]; }
        v4u w; w.x = cvtpk(p[0], p[1]); w.y = cvtpk(p[2], p[3]); w.z = cvtpk(p[4], p[5]); w.w = cvtpk(p[6], p[7]);
        pf[ss] = __builtin_bit_cast(bf16x8, w);
    }
    sum += __shfl_xor(sum, 16); sum += __shfl_xor(sum, 32);
    const float inv = 1.0f / sum;
    const unsigned q4 = l15 >> 2, p4 = lane & 3;
#pragma unroll
    for (int c = 0; c < 8; ++c) {
        f32x4 acc = (f32x4){0.f, 0.f, 0.f, 0.f};
#pragma unroll
        for (int ss = 0; ss < 5; ++ss) {
            const int kb = kb0 + 32 * ss;
            if (kb < klo) continue;
            const unsigned a0 = AT_V + off_b(kb + 8 * g4 + q4, 2 * c + (p4 >> 1)) + 8 * (p4 & 1);
            const unsigned a1 = AT_V + off_b(kb + 8 * g4 + 4 + q4, 2 * c + (p4 >> 1)) + 8 * (p4 & 1);
            const v4i16_t lo = __builtin_amdgcn_ds_read_tr16_b64_v4i16((LAS v4i16_t*)(F.lds + a0));
            const v4i16_t hi = __builtin_amdgcn_ds_read_tr16_b64_v4i16((LAS v4i16_t*)(F.lds + a1));
            const bf16x8 vf = (bf16x8){lo[0], lo[1], lo[2], lo[3], hi[0], hi[1], hi[2], hi[3]};
            acc = __builtin_amdgcn_mfma_f32_16x16x32_bf16(vf, pf[ss], acc, 0, 0, 0);
        }
        acc = acc * inv;
        u32x2 w; w.x = cvtpk(acc[0], acc[1]); w.y = cvtpk(acc[2], acc[3]);
        *(u32x2*)(Ob + qrow * DQKV + h * 128 + 16 * c + 4 * g4) = w;
    }
    if (g4 == 0) LSE[qrow * NHEAD + h] = (mx + __builtin_amdgcn_logf(sum)) * LN2;
    __syncthreads();
}

struct AUnit { int b, h, dsh, r, n, klo; };
__device__ __forceinline__ AUnit attn_decode(int u) { AUnit d; d.b = u / 192; const int rem = u % 192; d.h = rem >> 4; const int x = rem & 15, g = d.h >> 2; d.dsh = 2 * g; const int dil = 1 << d.dsh; d.r = x & (dil - 1); d.n = x >> d.dsh; d.klo = (d.n == 0) ? 128 : 0; return d; }
__device__ __forceinline__ void attn_dma_tile(const Frame& F, const bf16* base, const AUnit& d, int lds_off, int wave, int l15, int g4) {
#pragma unroll
    for (int i = 0; i < 8; ++i) {
        const int inst = wave * 8 + i, row0 = 4 * inst;
        if (row0 >= d.klo) {
            const int row = row0 + g4, ch = l15 ^ (((row & 3) << 2) | ((row >> 2) & 3));
            const int t = (((d.n - 1) * 128 + row) << d.dsh) + d.r;
            const size_t eoff = ((size_t)(d.b * 2048 + t) * DQKV + d.h * 128) + ch * 8;
            __builtin_amdgcn_global_load_lds((const unsigned*)(base + eoff), (LAS unsigned*)(F.lds + lds_off + inst * 1024), 16, 0, 0);
        }
    }
}
__device__ __forceinline__ void attn_prompt_wg(const Frame& F, const Args& A, int u0, int ustride) {
    unsigned char* ws = A.ws;
    const bf16* Qb = (const bf16*)(ws + WS_Q); const bf16* Kb = (const bf16*)(ws + WS_K); const bf16* Vb = (const bf16*)(ws + WS_V);
    bf16* Ob = (bf16*)(ws + WS_O); float* LSE = (float*)(ws + WS_LSE); const float* BT = (const float*)(ws + WS_BT);
    if (u0 >= 1536) return;
    int tid_o = F.tid; asm volatile("" : "+v"(tid_o));
    const int lane = tid_o & 63, wave = F.wave, l15 = lane & 15, g4 = lane >> 4;
    LAS float* TAB2 = (LAS float*)(F.lds + SCR_OFF + 8192);
    int u = u0, pb = 0;
    AUnit d = attn_decode(u);
    bf16x8 qf[4];
    {
        attn_dma_tile(F, Kb, d, AT_K, wave, l15, g4);
        const int qi = 16 * wave + l15, tq = ((d.n * 128 + qi) << d.dsh) + d.r; const size_t qrow = (size_t)(d.b * 2048 + tq);
#pragma unroll
        for (int s2 = 0; s2 < 4; ++s2) qf[s2] = *(const bf16x8*)(Qb + qrow * DQKV + d.h * 128 + 32 * s2 + 8 * g4);
        if (tid_o < TABW) TAB2[tid_o] = BT[d.h * TABW + tid_o];
        VM_WAIT(); __syncthreads();
    }
#pragma unroll 1
    for (;;) {
        const LAS float* TAB = TAB2 + pb * TABW;
        const int klo = d.klo;
        const int qi = 16 * wave + l15, tq = ((d.n * 128 + qi) << d.dsh) + d.r; const size_t qrow = (size_t)(d.b * 2048 + tq);
        attn_dma_tile(F, Vb, d, AT_V, wave, l15, g4);
        const int kb0 = 32 * (wave >> 1);
        f32x4 sc[5][2];
#pragma unroll
        for (int ss = 0; ss < 5; ++ss) {
            const int kb = kb0 + 32 * ss;
            if (kb < klo) { sc[ss][0] = (f32x4){-INFINITY, -INFINITY, -INFINITY, -INFINITY}; sc[ss][1] = sc[ss][0]; continue; }
#pragma unroll
            for (int t = 0; t < 2; ++t) {
                const unsigned key = kb + 8 * (l15 >> 2) + 4 * t + (l15 & 3);
                f32x4 acc = (f32x4){0.f, 0.f, 0.f, 0.f};
#pragma unroll
                for (int s2 = 0; s2 < 4; ++s2) { const bf16x8 a = *(const LAS bf16x8*)(F.lds + AT_K + off_b(key, 4 * s2 + g4)); acc = __builtin_amdgcn_mfma_f32_16x16x32_bf16(a, qf[s2], acc, 0, 0, 0); }
                const int d0 = qi + 128 - (kb + 8 * g4 + 4 * t) + 31;
#pragma unroll
                for (int e = 0; e < 4; ++e) acc[e] += TAB[d0 - e];
                sc[ss][t] = acc;
            }
        }
        float mx = -INFINITY;
#pragma unroll
        for (int ss = 0; ss < 5; ++ss)
#pragma unroll
            for (int t = 0; t < 2; ++t)
#pragma unroll
                for (int e = 0; e < 4; ++e) mx = fmaxf(mx, sc[ss][t][e]);
        mx = fmaxf(mx, __shfl_xor(mx, 16)); mx = fmaxf(mx, __shfl_xor(mx, 32));
        float sum = 0.f; bf16x8 pf[5];
#pragma unroll
        for (int ss = 0; ss < 5; ++ss) {
            float pv[8];
#pragma unroll
            for (int t = 0; t < 2; ++t)
#pragma unroll
                for (int e = 0; e < 4; ++e) { pv[4 * t + e] = __builtin_amdgcn_exp2f(sc[ss][t][e] - mx); sum += pv[4 * t + e]; }
            v4u w; w.x = cvtpk(pv[0], pv[1]); w.y = cvtpk(pv[2], pv[3]); w.z = cvtpk(pv[4], pv[5]); w.w = cvtpk(pv[6], pv[7]);
            pf[ss] = __builtin_bit_cast(bf16x8, w);
        }
        sum += __shfl_xor(sum, 16); sum += __shfl_xor(sum, 32);
        const float inv = 1.0f / sum;
        VM_WAIT(); __syncthreads();
        const int un = u + ustride; const bool has_next = un < 1536;
        AUnit dn = d; bf16x8 qn[4]; float tabn = 0.f;
        if (has_next) {
            dn = attn_decode(un);
            attn_dma_tile(F, Kb, dn, AT_K, wave, l15, g4);
            const int tqn = ((dn.n * 128 + qi) << dn.dsh) + dn.r; const size_t qrn = (size_t)(dn.b * 2048 + tqn);
#pragma unroll
            for (int s2 = 0; s2 < 4; ++s2) qn[s2] = *(const bf16x8*)(Qb + qrn * DQKV + dn.h * 128 + 32 * s2 + 8 * g4);
            if (tid_o < TABW) tabn = BT[dn.h * TABW + tid_o];
        }
        const unsigned q4 = l15 >> 2, p4 = lane & 3;
#pragma unroll
        for (int c = 0; c < 8; ++c) {
            f32x4 acc = (f32x4){0.f, 0.f, 0.f, 0.f};
#pragma unroll
            for (int ss = 0; ss < 5; ++ss) {
                const int kb = kb0 + 32 * ss;
                if (kb < klo) continue;
                const unsigned a0 = AT_V + off_b(kb + 8 * g4 + q4, 2 * c + (p4 >> 1)) + 8 * (p4 & 1);
                const unsigned a1 = AT_V + off_b(kb + 8 * g4 + 4 + q4, 2 * c + (p4 >> 1)) + 8 * (p4 & 1);
                const v4i16_t lo = __builtin_amdgcn_ds_read_tr16_b64_v4i16((LAS v4i16_t*)(F.lds + a0));
                const v4i16_t hi = __builtin_amdgcn_ds_read_tr16_b64_v4i16((LAS v4i16_t*)(F.lds + a1));
                const bf16x8 vf = (bf16x8){lo[0], lo[1], lo[2], lo[3], hi[0], hi[1], hi[2], hi[3]};
                acc = __builtin_amdgcn_mfma_f32_16x16x32_bf16(vf, pf[ss], acc, 0, 0, 0);
            }
            acc = acc * inv;
            u32x2 w; w.x = cvtpk(acc[0], acc[1]); w.y = cvtpk(acc[2], acc[3]);
            *(u32x2*)(Ob + qrow * DQKV + d.h * 128 + 16 * c + 4 * g4) = w;
        }
        if (g4 == 0) LSE[qrow * NHEAD + d.h] = (mx + __builtin_amdgcn_logf(sum)) * LN2;
        asm volatile("" ::: "memory");
        if (has_next && tid_o < TABW) TAB2[(pb ^ 1) * TABW + tid_o] = tabn;
        VM_WAIT(); __syncthreads();
        if (!has_next) break;
        u = un; d = dn; pb ^= 1;
#pragma unroll
        for (int s2 = 0; s2 < 4; ++s2) qf[s2] = qn[s2];
    }
}

constexpr int LR_XCF = 0, LR_XCB = 65536, LR_PPL = 98304;
__device__ __forceinline__ void lru_item(const Frame& F, const Args& A, int it, int cu) {
    unsigned char* ws = A.ws;
    const bf16* XA = (const bf16*)(ws + WS_XA);
    const bool prompt = it < 1024;
    const int n = it & 7; int b = 0, c = 0, cs = 0;
    if (prompt) { c = it >> 6; b = (it >> 3) & 7; } else cs = (it - 1024) >> 3;
    const int m0 = prompt ? b * 2048 + c * 128 : MP + cs * 128, cidx = prompt ? b * 16 + c : 128 + cs;
    int tid = F.tid; asm volatile("" : "+v"(tid));
    const int lane = tid & 63, wave = F.wave, l15 = lane & 15, g4 = lane >> 4;
    LAS float* XCF = (LAS float*)(F.lds + LR_XCF);
    LAS bf16* PPL = (LAS bf16*)(F.lds + LR_PPL);
    BgCopy bgc; if (cu >= 0) bg_load(A, 2 * cu, tid, bgc);
    {
        const int tg = tid >> 4, c8 = tid & 15, ch0 = n * 128 + 8 * c8;
        float xin[7][8];
#pragma unroll
        for (int j = 0; j < 7; ++j) {
            const int trel = 4 * tg - 3 + j;
            const bool from_xa = prompt ? (c * 128 + trel >= 0) : (((tg & 1) != 0) || j >= 3);
            if (from_xa) { const v4u w = *(const v4u*)(XA + (size_t)(m0 + trel) * 1024 + ch0);
                xin[j][0] = bflo(w.x); xin[j][1] = bfhi(w.x); xin[j][2] = bflo(w.y); xin[j][3] = bfhi(w.y); xin[j][4] = bflo(w.z); xin[j][5] = bfhi(w.z); xin[j][6] = bflo(w.w); xin[j][7] = bfhi(w.w); }
            else if (!prompt) { const int db = (cs * 128 + 4 * tg) >> 3; const float* sp = A.in[5] + ((size_t)db * 3 + j) * 1024 + ch0; const f32x4 a = *(const f32x4*)sp, bq = *(const f32x4*)(sp + 4);
                xin[j][0] = a[0]; xin[j][1] = a[1]; xin[j][2] = a[2]; xin[j][3] = a[3]; xin[j][4] = bq[0]; xin[j][5] = bq[1]; xin[j][6] = bq[2]; xin[j][7] = bq[3]; }
            else {
#pragma unroll
                for (int e = 0; e < 8; ++e) xin[j][e] = 0.f; }
        }
        float cw[4][8], cb[8];
#pragma unroll
        for (int jj = 0; jj < 4; ++jj) { const f32x4 a = *(const f32x4*)(A.in[10] + jj * 1024 + ch0), bq = *(const f32x4*)(A.in[10] + jj * 1024 + ch0 + 4);
            cw[jj][0] = a[0]; cw[jj][1] = a[1]; cw[jj][2] = a[2]; cw[jj][3] = a[3]; cw[jj][4] = bq[0]; cw[jj][5] = bq[1]; cw[jj][6] = bq[2]; cw[jj][7] = bq[3]; }
        { const f32x4 a = *(const f32x4*)(A.in[11] + ch0), bq = *(const f32x4*)(A.in[11] + ch0 + 4); cb[0] = a[0]; cb[1] = a[1]; cb[2] = a[2]; cb[3] = a[3]; cb[4] = bq[0]; cb[5] = bq[1]; cb[6] = bq[2]; cb[7] = bq[3]; }
#pragma unroll
        for (int i = 0; i < 4; ++i) {
            float y[8];
#pragma unroll
            for (int e = 0; e < 8; ++e) y[e] = cb[e] + ((cw[0][e] * xin[i][e] + cw[1][e] * xin[i + 1][e]) + (cw[2][e] * xin[i + 2][e] + cw[3][e] * xin[i + 3][e]));
            const int tok = 4 * tg + i;
            *(LAS f32x4*)(XCF + tok * 128 + 8 * c8) = (f32x4){y[0], y[1], y[2], y[3]};
            *(LAS f32x4*)(XCF + tok * 128 + 8 * c8 + 4) = (f32x4){y[4], y[5], y[6], y[7]};
            v4u w; w.x = cvtpk(y[0], y[1]); w.y = cvtpk(y[2], y[3]); w.z = cvtpk(y[4], y[5]); w.w = cvtpk(y[6], y[7]);
            *(LAS v4u*)(F.lds + LR_XCB + off_b(tok, c8)) = w;
        }
    }
    const int chl = 16 * wave + l15, ch = n * 128 + chl;
    bf16x8 wa[4], wx[4];
    {
        const bf16* WA = (const bf16*)(ws + WS_WA) + n * 16384 + chl * 128 + 8 * g4; const bf16* WX = (const bf16*)(ws + WS_WX) + n * 16384 + chl * 128 + 8 * g4;
#pragma unroll
        for (int s = 0; s < 4; ++s) { wa[s] = *(const bf16x8*)(WA + 32 * s); wx[s] = *(const bf16x8*)(WX + 32 * s); }
    }
    const float ba = A.in[13][ch], bx = A.in[15][ch];
    const float lam = A.in[16][ch];
    const float sp8 = -8.0f * log1pf(expf(-lam));
    __syncthreads();
    if (cu >= 0) { bg_store(A, 2 * cu, tid, bgc); bg_load(A, 2 * cu + 1, tid, bgc); }
    float Hin = 0.f, Pin = 1.f;
#pragma unroll 1
    for (int tb = 0; tb < 8; ++tb) {
        if (tb == 4 && cu >= 0) bg_store(A, 2 * cu + 1, tid, bgc);
        f32x4 ga = (f32x4){0.f, 0.f, 0.f, 0.f}, gx = ga;
#pragma unroll
        for (int s = 0; s < 4; ++s) {
            const bf16x8 a = *(const LAS bf16x8*)(F.lds + LR_XCB + off_b(16 * tb + l15, 4 * s + g4));
            ga = __builtin_amdgcn_mfma_f32_16x16x32_bf16(a, wa[s], ga, 0, 0, 0);
            gx = __builtin_amdgcn_mfma_f32_16x16x32_bf16(a, wx[s], gx, 0, 0, 0);
        }
        float av[4], uv[4];
#pragma unroll
        for (int e = 0; e < 4; ++e) {
            const int tok = 16 * tb + 4 * g4 + e;
            const float rr = pg8::sigmoid_f(ga[e] + ba), ii = pg8::sigmoid_f(gx[e] + bx);
            const float la = sp8 * rr;
            float a = __builtin_amdgcn_exp2f(la * LOG2E);
            const float x2 = 2.0f * la;
            const float tay = -x2 * (1.0f + x2 * (0.5f + x2 * (0.16666667f + x2 * (0.041666668f + x2 * (0.0083333338f + x2 * 0.0013888889f)))));
            const float om = (x2 > -0.25f) ? tay : (1.0f - __builtin_amdgcn_exp2f(x2 * LOG2E));
            const float mult = __builtin_amdgcn_sqrtf(om);
            float uu = mult * (ii * XCF[tok * 128 + chl]);
            if (!prompt && e == 0 && (g4 & 1) == 0) { const int db = (cs * 128 + tok) >> 3; uu = a * A.in[6][(size_t)db * 1024 + ch] + uu; a = 0.f; }
            av[e] = a; uv[e] = uu;
        }
        float Ac[4], Uc[4];
        Ac[0] = av[0]; Uc[0] = uv[0];
#pragma unroll
        for (int e = 1; e < 4; ++e) { Ac[e] = av[e] * Ac[e - 1]; Uc[e] = av[e] * Uc[e - 1] + uv[e]; }
        float hst = Hin, pst = Pin, hrun = Hin, prun = Pin;
#pragma unroll
        for (int gg = 0; gg < 4; ++gg) {
            const float ar = __shfl(Ac[3], l15 + 16 * gg), ur = __shfl(Uc[3], l15 + 16 * gg);
            if (g4 == gg) { hst = hrun; pst = prun; }
            hrun = ar * hrun + ur; prun = ar * prun;
        }
        Hin = hrun; Pin = prun;
#pragma unroll
        for (int e = 0; e < 4; ++e) {
            const int tok = 16 * tb + 4 * g4 + e;
            const float hh = Ac[e] * hst + Uc[e], pp = Ac[e] * pst;
            if (prompt) {
                XCF[tok * 128 + chl] = hh;
                PPL[tok * 128 + chl] = (bf16)(cvtpk(pp, 0.f) & 0xffffu);
            } else {
                const size_t o1 = (size_t)(m0 + tok) * 1024 + ch;
                const float sg = pg8::silu_f(__uint_as_float((unsigned)((const bf16*)(ws + WS_SGA))[o1] << 16));
                pg8::st_wt2((unsigned short*)(ws + WS_ACAT) + (size_t)(m0 + tok) * KCAT + ch, cvtpk(hh * sg, 0.f) & 0xffffu);
                if (e == 3 && (g4 & 1) == 1) { const int db = (cs * 128 + tok) >> 3; A.out[O_HS + (size_t)db * 1024 + ch] = hh; }
            }
        }
    }
    if (!prompt) { __syncthreads(); return; }
    typedef float f32x2_ __attribute__((ext_vector_type(2)));
    f32x2_* AGG = (f32x2_*)(ws + WS_PEND);
    unsigned* FLG = (unsigned*)(ws + WS_CTL) + CW_LFLAG;
    if (g4 == 0) __hip_atomic_store((unsigned long long*)(AGG + cidx * 1024 + ch), ((unsigned long long)__float_as_uint(Hin) << 32) | __float_as_uint(Pin), RLX_AGENT);
    const int tg = tid >> 4, c8 = tid & 15;
    v4u sg4[4];
#pragma unroll
    for (int i = 0; i < 4; ++i) sg4[i] = *(const v4u*)((const bf16*)(ws + WS_SGA) + (size_t)(m0 + 4 * tg + i) * 1024 + n * 128 + 8 * c8);
    VM_WAIT(); __syncthreads();
    if (tid == 0) __hip_atomic_store(FLG + it, 1u, RLX_AGENT);
    float Hc = 0.f;
    if (c > 0) {
        if (wave == 0) {
            unsigned* barw = (unsigned*)(ws + WS_CTL) + CW_BAR; unsigned sp = 0;
            const int cc = lane < c ? lane : 0;
            for (;;) {
                const bool ok = (lane >= c) || (xb_ld(FLG + (cc * 64 + b * 8 + n)) != 0u);
                if (__all(ok)) break;
                __builtin_amdgcn_s_sleep(1);
                if ((++sp & 1023u) == 0u) { if (xb_ld(&barw[XB_TMO])) break; if (sp > (1u << 22)) { atomicAdd(&barw[XB_TMO], 1u); break; } }
            }
        }
        __syncthreads();
        f32x2_ ag[4];
#pragma unroll
        for (int k = 0; k < 4; ++k) { const int cc = g4 + 4 * k; ag[k] = (f32x2_){1.f, 0.f};
            if (cc < c) { const unsigned long long w = __hip_atomic_load((unsigned long long*)(AGG + (b * 16 + cc) * 1024 + ch), RLX_AGENT); ag[k] = (f32x2_){__uint_as_float((unsigned)w), __uint_as_float((unsigned)(w >> 32))}; } }
#pragma unroll
        for (int cc = 0; cc < 15; ++cc) {
            const float pc = __shfl(ag[cc >> 2][0], l15 + 16 * (cc & 3)), hc = __shfl(ag[cc >> 2][1], l15 + 16 * (cc & 3));
            if (cc < c) Hc = pc * Hc + hc;
        }
    }
    if (c == 15 && g4 == 0) A.out[O_HP + (size_t)b * 1024 + ch] = Pin * Hc + Hin;
    LAS float* HCL = (LAS float*)(F.lds + SCR_OFF);
    if (g4 == 0) HCL[chl] = Hc;
    __syncthreads();
    {
        const f32x4 h0 = *(const LAS f32x4*)(HCL + 8 * c8), h1 = *(const LAS f32x4*)(HCL + 8 * c8 + 4);
#pragma unroll
        for (int i = 0; i < 4; ++i) {
            const int tok = 4 * tg + i;
            const f32x4 l0 = *(const LAS f32x4*)(XCF + tok * 128 + 8 * c8), l1 = *(const LAS f32x4*)(XCF + tok * 128 + 8 * c8 + 4);
            const v4u pw = *(const LAS v4u*)(PPL + tok * 128 + 8 * c8); const v4u sw = sg4[i];
            v4u w;
            w.x = cvtpk((l0[0] + bflo(pw.x) * h0[0]) * silu_lo(sw.x), (l0[1] + bfhi(pw.x) * h0[1]) * silu_hi(sw.x));
            w.y = cvtpk((l0[2] + bflo(pw.y) * h0[2]) * silu_lo(sw.y), (l0[3] + bfhi(pw.y) * h0[3]) * silu_hi(sw.y));
            w.z = cvtpk((l1[0] + bflo(pw.z) * h1[0]) * silu_lo(sw.z), (l1[1] + bfhi(pw.z) * h1[1]) * silu_hi(sw.z));
            w.w = cvtpk((l1[2] + bflo(pw.w) * h1[2]) * silu_lo(sw.w), (l1[3] + bfhi(pw.w) * h1[3]) * silu_hi(sw.w));
            *(v4u*)((bf16*)(ws + WS_ACAT) + (size_t)(m0 + tok) * KCAT + n * 128 + 8 * c8) = w;
        }
    }
    __syncthreads();
}

__device__ __forceinline__ void lru_prompt_wg(const Frame& F, const Args& A, int w) {
    unsigned char* ws = A.ws;
    const bf16* XA = (const bf16*)(ws + WS_XA);
    const int n = w & 7, b = (w >> 3) & 7, c0 = w >> 6;
    int tid0 = F.tid; asm volatile("" : "+v"(tid0)); const int tid = tid0;
    const int lane = tid & 63, wave = F.wave, l15 = lane & 15, g4 = lane >> 4;
    const int tg = tid >> 4, c8 = tid & 15, ch0 = n * 128 + 8 * c8;
    LAS float* XCF = (LAS float*)(F.lds + LR_XCF);
    LAS bf16* PPL = (LAS bf16*)(F.lds + LR_PPL);
    LAS float* HCL = (LAS float*)(F.lds + SCR_OFF);
    typedef float f32x2_ __attribute__((ext_vector_type(2)));
    f32x2_* AGG = (f32x2_*)(ws + WS_PEND);
    unsigned* FLG = (unsigned*)(ws + WS_CTL) + CW_LFLAG;
    LAS float* CWL = (LAS float*)(F.lds + SCR_OFF + 1024);
    for (int i = tid; i < 640; i += 512) CWL[i] = (i < 512) ? A.in[10][(i >> 7) * 1024 + n * 128 + (i & 127)] : A.in[11][n * 128 + (i - 512)];
    __syncthreads();
    const int chl = 16 * wave + l15, ch = n * 128 + chl;
    bf16x8 wa[4], wx[4];
    {
        const bf16* WA = (const bf16*)(ws + WS_WA) + n * 16384 + chl * 128 + 8 * g4; const bf16* WX = (const bf16*)(ws + WS_WX) + n * 16384 + chl * 128 + 8 * g4;
#pragma unroll
        for (int s2 = 0; s2 < 4; ++s2) { wa[s2] = *(const bf16x8*)(WA + 32 * s2); wx[s2] = *(const bf16x8*)(WX + 32 * s2); }
    }
    const float ba = A.in[13][ch], bx = A.in[15][ch];
    const float sp8 = -8.0f * log1pf(expf(-A.in[16][ch]));
    v4u xr[7];
    {
        const int m0 = b * 2048 + c0 * 128;
#pragma unroll
        for (int j = 0; j < 7; ++j) { const int trel = 4 * tg - 3 + j; const bool ok = (c0 * 128 + trel >= 0); xr[j] = *(const v4u*)(XA + (size_t)(m0 + (ok ? trel : 0)) * 1024 + ch0); if (!ok) xr[j] = (v4u){0u, 0u, 0u, 0u}; }
    }
#pragma unroll 1
    for (int k = 0; k < 4; ++k) {
        const int c = c0 + 4 * k, it = c * 64 + b * 8 + n, m0 = b * 2048 + c * 128, cidx = b * 16 + c;
        int tid = tid0; asm volatile("" : "+v"(tid));
        const int lane = tid & 63, l15 = lane & 15, g4 = lane >> 4, tg = tid >> 4, c8 = tid & 15, ch0 = n * 128 + 8 * c8, chl = 16 * wave + l15, ch = n * 128 + chl;
        {
            float cw[4][8], cb[8];
#pragma unroll
            for (int jj = 0; jj < 5; ++jj) { const f32x4 a = *(const LAS f32x4*)(CWL + jj * 128 + 8 * c8), bq = *(const LAS f32x4*)(CWL + jj * 128 + 8 * c8 + 4);
                float* d = (jj < 4) ? cw[jj < 4 ? jj : 0] : cb;
                d[0] = a[0]; d[1] = a[1]; d[2] = a[2]; d[3] = a[3]; d[4] = bq[0]; d[5] = bq[1]; d[6] = bq[2]; d[7] = bq[3]; }
            float xin[7][8];
#pragma unroll
            for (int j = 0; j < 7; ++j) { const v4u wv = xr[j];
                xin[j][0] = bflo(wv.x); xin[j][1] = bfhi(wv.x); xin[j][2] = bflo(wv.y); xin[j][3] = bfhi(wv.y); xin[j][4] = bflo(wv.z); xin[j][5] = bfhi(wv.z); xin[j][6] = bflo(wv.w); xin[j][7] = bfhi(wv.w); }
#pragma unroll
            for (int i = 0; i < 4; ++i) {
                float y[8];
#pragma unroll
                for (int e = 0; e < 8; ++e) y[e] = cb[e] + ((cw[0][e] * xin[i][e] + cw[1][e] * xin[i + 1][e]) + (cw[2][e] * xin[i + 2][e] + cw[3][e] * xin[i + 3][e]));
                const int tok = 4 * tg + i;
                *(LAS f32x4*)(XCF + tok * 128 + 8 * c8) = (f32x4){y[0], y[1], y[2], y[3]};
                *(LAS f32x4*)(XCF + tok * 128 + 8 * c8 + 4) = (f32x4){y[4], y[5], y[6], y[7]};
                v4u wv; wv.x = cvtpk(y[0], y[1]); wv.y = cvtpk(y[2], y[3]); wv.z = cvtpk(y[4], y[5]); wv.w = cvtpk(y[6], y[7]);
                *(LAS v4u*)(F.lds + LR_XCB + off_b(tok, c8)) = wv;
            }
        }
        v4u sg4[4];
        __syncthreads();
        BgHalf bgc; bg2h_load(A, it, 0, tid, bgc);
        float Hin = 0.f, Pin = 1.f;
#pragma unroll 4
        for (int tb = 0; tb < 8; ++tb) {
            if (tb == 2) { bg2h_store(A, it, 0, tid, bgc); bg2h_load(A, it, 1, tid, bgc); }
            if (tb == 5) {
                bg2h_store(A, it, 1, tid, bgc);
                if (k < 3) {
                    const int m1 = m0 + 512;
#pragma unroll
                    for (int j = 0; j < 7; ++j) xr[j] = *(const v4u*)(XA + (size_t)(m1 + 4 * tg - 3 + j) * 1024 + ch0);
                }
#pragma unroll
                for (int i = 0; i < 4; ++i) sg4[i] = __builtin_nontemporal_load((const v4u*)((const bf16*)(ws + WS_SGA) + (size_t)(m0 + 4 * tg + i) * 1024 + n * 128 + 8 * c8));
            }
            f32x4 ga = (f32x4){0.f, 0.f, 0.f, 0.f}, gx = ga;
#pragma unroll
            for (int s2 = 0; s2 < 4; ++s2) {
                const bf16x8 a = *(const LAS bf16x8*)(F.lds + LR_XCB + off_b(16 * tb + l15, 4 * s2 + g4));
                ga = __builtin_amdgcn_mfma_f32_16x16x32_bf16(a, wa[s2], ga, 0, 0, 0);
                gx = __builtin_amdgcn_mfma_f32_16x16x32_bf16(a, wx[s2], gx, 0, 0, 0);
            }
            float Ac[4], Uc[4];
#pragma unroll
            for (int e = 0; e < 4; ++e) {
                const int tok = 16 * tb + 4 * g4 + e;
                const float rr = pg8::sigmoid_f(ga[e] + ba), ii = pg8::sigmoid_f(gx[e] + bx);
                const float la = sp8 * rr;
                const float a = __builtin_amdgcn_exp2f(la * LOG2E);
                const float x2 = 2.0f * la;
                const float tay = -x2 * (1.0f + x2 * (0.5f + x2 * (0.16666667f + x2 * (0.041666668f + x2 * (0.0083333338f + x2 * 0.0013888889f)))));
                const float om = (x2 > -0.25f) ? tay : (1.0f - __builtin_amdgcn_exp2f(x2 * LOG2E));
                const float uu = __builtin_amdgcn_sqrtf(om) * (ii * XCF[tok * 128 + chl]);
                if (e == 0) { Ac[0] = a; Uc[0] = uu; } else { Ac[e] = a * Ac[e - 1]; Uc[e] = a * Uc[e - 1] + uu; }
            }
            float hst = Hin, pst = Pin, hrun = Hin, prun = Pin;
#pragma unroll
            for (int gg = 0; gg < 4; ++gg) {
                const float ar = __shfl(Ac[3], l15 + 16 * gg), ur = __shfl(Uc[3], l15 + 16 * gg);
                if (g4 == gg) { hst = hrun; pst = prun; }
                hrun = ar * hrun + ur; prun = ar * prun;
            }
            Hin = hrun; Pin = prun;
#pragma unroll
            for (int e = 0; e < 4; ++e) {
                const int tok = 16 * tb + 4 * g4 + e;
                XCF[tok * 128 + chl] = Ac[e] * hst + Uc[e];
                PPL[tok * 128 + chl] = (bf16)(cvtpk(Ac[e] * pst, 0.f) & 0xffffu);
            }
        }
        if (g4 == 0) __hip_atomic_store((unsigned long long*)(AGG + cidx * 1024 + ch), ((unsigned long long)__float_as_uint(Hin) << 32) | __float_as_uint(Pin), RLX_AGENT);
        VM_WAIT(); __syncthreads();
        if (tid == 0) __hip_atomic_store(FLG + it, 1u, RLX_AGENT);
        float Hc = 0.f;
        if (c > 0) {
            if (wave == 0) {
                unsigned* barw = (unsigned*)(ws + WS_CTL) + CW_BAR; unsigned sp = 0;
                const int cc = lane < c ? lane : 0;
                for (;;) {
                    const bool ok = (lane >= c) || (xb_ld(FLG + (cc * 64 + b * 8 + n)) != 0u);
                    if (__all(ok)) break;
                    __builtin_amdgcn_s_sleep(1);
                    if ((++sp & 1023u) == 0u) { if (xb_ld(&barw[XB_TMO])) break; if (sp > (1u << 22)) { atomicAdd(&barw[XB_TMO], 1u); break; } }
                }
            }
            __syncthreads();
            f32x2_ ag[4];
#pragma unroll
            for (int q = 0; q < 4; ++q) { const int cc = g4 + 4 * q; ag[q] = (f32x2_){1.f, 0.f};
                if (cc < c) { const unsigned long long wv = __hip_atomic_load((unsigned long long*)(AGG + (b * 16 + cc) * 1024 + ch), RLX_AGENT); ag[q] = (f32x2_){__uint_as_float((unsigned)wv), __uint_as_float((unsigned)(wv >> 32))}; } }
#pragma unroll
            for (int cc = 0; cc < 15; ++cc) {
                const float pc = __shfl(ag[cc >> 2][0], l15 + 16 * (cc & 3)), hc = __shfl(ag[cc >> 2][1], l15 + 16 * (cc & 3));
                if (cc < c) Hc = pc * Hc + hc;
            }
        }
        if (c == 15 && g4 == 0) A.out[O_HP + (size_t)b * 1024 + ch] = Pin * Hc + Hin;
        if (g4 == 0) HCL[chl] = Hc;
        __syncthreads();
        {
            const f32x4 h0 = *(const LAS f32x4*)(HCL + 8 * c8), h1 = *(const LAS f32x4*)(HCL + 8 * c8 + 4);
#pragma unroll
            for (int i = 0; i < 4; ++i) {
                const int tok = 4 * tg + i;
                const f32x4 l0 = *(const LAS f32x4*)(XCF + tok * 128 + 8 * c8), l1 = *(const LAS f32x4*)(XCF + tok * 128 + 8 * c8 + 4);
                const v4u pw = *(const LAS v4u*)(PPL + tok * 128 + 8 * c8); const v4u sw = sg4[i];
                v4u wv;
                wv.x = cvtpk((l0[0] + bflo(pw.x) * h0[0]) * silu_lo(sw.x), (l0[1] + bfhi(pw.x) * h0[1]) * silu_hi(sw.x));
                wv.y = cvtpk((l0[2] + bflo(pw.y) * h0[2]) * silu_lo(sw.y), (l0[3] + bfhi(pw.y) * h0[3]) * silu_hi(sw.y));
                wv.z = cvtpk((l1[0] + bflo(pw.z) * h1[0]) * silu_lo(sw.z), (l1[1] + bfhi(pw.z) * h1[1]) * silu_hi(sw.z));
                wv.w = cvtpk((l1[2] + bflo(pw.w) * h1[2]) * silu_lo(sw.w), (l1[3] + bfhi(pw.w) * h1[3]) * silu_hi(sw.w));
                *(v4u*)((bf16*)(ws + WS_ACAT) + (size_t)(m0 + tok) * KCAT + n * 128 + 8 * c8) = wv;
            }
        }
        __syncthreads();
    }
}

__device__ __forceinline__ float dpp_row_sum(float s) {
    s += __builtin_bit_cast(float, __builtin_amdgcn_update_dpp(0, __builtin_bit_cast(int, s), 0xB1, 0xF, 0xF, false));
    s += __builtin_bit_cast(float, __builtin_amdgcn_update_dpp(0, __builtin_bit_cast(int, s), 0x4E, 0xF, 0xF, false));
    s += __builtin_bit_cast(float, __builtin_amdgcn_update_dpp(0, __builtin_bit_cast(int, s), 0x141, 0xF, 0xF, false));
    s += __builtin_bit_cast(float, __builtin_amdgcn_update_dpp(0, __builtin_bit_cast(int, s), 0x140, 0xF, 0xF, false));
    return s;
}
template <int G, int RB, int COPY>
__device__ __forceinline__ void stream_load(f32x4 (&kv)[RB][4], const float* cache, const float* okv, int bi, int wave, int p, int lane, bool lastp) {
    constexpr int L = 128 << (2 * G);
    const int fo = (lane >> 4) * 32 + (lane & 15);
#pragma unroll
    for (int i = 0; i < RB; ++i) {
        const int slot = RB * bi + i;
        if (COPY == 0 && G == 2 && slot >= 8 && slot < 16) continue;
        if (slot < 16) {
            const int idx = (G == 0) ? wave + 8 * slot : (G == 1 ? 128 * p + (wave & 3) + 4 * (2 * slot + (wave >> 2)) : (COPY == 2 ? 128 * (p + (slot >> 3)) + wave + 16 * (slot & 7) : 128 * p + wave + 16 * (slot & 7) + (slot & 8)));
            const f32x4* rp = (const f32x4*)(cache + (size_t)idx * 1024) + fo;
            kv[i][0] = __builtin_nontemporal_load(rp); kv[i][1] = __builtin_nontemporal_load(rp + 16); kv[i][2] = __builtin_nontemporal_load(rp + 128); kv[i][3] = __builtin_nontemporal_load(rp + 144);
        } else if (slot == 16 && lastp) {
            const f32x4* rp = (const f32x4*)(okv + (size_t)(L + wave - 8) * 1024) + fo;
            kv[i][0] = rp[0]; kv[i][1] = rp[16]; kv[i][2] = rp[128]; kv[i][3] = rp[144];
        }
    }
}
template <int G, int RB, int NT, int COPY>
__device__ __forceinline__ void stream_proc(const f32x4 (&kv)[RB][4], float* okv, int bi, int wave, int p, int lane, bool lastp,
                                            const v4u (&qp)[NT], float (&m)[NT], float (&l)[NT], float (&o)[NT][8], const LAS float* bt) {
    constexpr int DSH = 2 * G, DIL = 1 << DSH, L = 128 * DIL;
    const int fo = (lane >> 4) * 32 + (lane & 15);
#pragma unroll
    for (int i = 0; i < RB; ++i) {
        const int slot = RB * bi + i;
        if (slot > 16 || (slot == 16 && !lastp)) continue;
        const int idx = (slot < 16) ? ((G == 0) ? wave + 8 * slot : (G == 1 ? 128 * p + (wave & 3) + 4 * (2 * slot + (wave >> 2)) : (COPY == 2 ? 128 * (p + (slot >> 3)) + wave + 16 * (slot & 7) : 128 * p + wave + 16 * (slot & 7) + (slot & 8)))) : L + wave;
        if (COPY && slot < 16 && idx >= 8) { f32x4* wp = (f32x4*)(okv + (size_t)(idx - 8) * 1024) + fo;
            __builtin_nontemporal_store(kv[i][0], wp); __builtin_nontemporal_store(kv[i][1], wp + 16); __builtin_nontemporal_store(kv[i][2], wp + 128); __builtin_nontemporal_store(kv[i][3], wp + 144); }
        if (G == 2 && COPY != 2 && slot >= 8 && slot < 16) continue;
#pragma unroll
        for (int ts = 0; ts < NT; ++ts) {
            const int t = (G == 0) ? ts : (G == 1 ? (wave & 3) + 4 * ts : wave);
            const int jn = L + t - idx;
            if (jn >= 0 && jn <= 128 * DIL) {
                const v4u w = qp[ts];
                float s = (bflo(w.x) * kv[i][0][0] + bfhi(w.x) * kv[i][0][1]) + (bflo(w.y) * kv[i][0][2] + bfhi(w.y) * kv[i][0][3])
                        + (bflo(w.z) * kv[i][1][0] + bfhi(w.z) * kv[i][1][1]) + (bflo(w.w) * kv[i][1][2] + bfhi(w.w) * kv[i][1][3]);
                s = dpp_row_sum(s) + bt[jn >> DSH];
                const float mn = fmaxf(m[ts], s), corr = __builtin_amdgcn_exp2f(m[ts] - mn), pw = __builtin_amdgcn_exp2f(s - mn);
                l[ts] = l[ts] * corr + pw; m[ts] = mn;
#pragma unroll
                for (int e = 0; e < 4; ++e) { o[ts][e] = o[ts][e] * corr + pw * kv[i][2][e]; o[ts][4 + e] = o[ts][4 + e] * corr + pw * kv[i][3][e]; }
            }
        }
    }
}
template <int G, int COPY>
__device__ __forceinline__ void stream_item(const Frame& F, const Args& A, int db, int p) {
    constexpr int DSH = 2 * G, DIL = 1 << DSH, L = 128 * DIL, NT = (G == 0) ? 8 : (G == 1 ? 2 : 1), NC = (G == 0) ? 8 : (G == 1 ? 2 : 1), NPART = L / 128;
    constexpr int RB = (G == 0) ? 2 : 4, NB = (17 + RB - 1) / RB;
    unsigned char* ws = A.ws;
    int tid = F.tid; asm volatile("" : "+v"(tid));
    const int lane = tid & 63, wave = F.wave, hh = lane >> 4, c4 = 4 * (lane & 15);
    const float* cache = A.in[2 + G] + (size_t)db * L * 1024;
    float* okv = A.out + (G == 0 ? O_KV128S : (G == 1 ? O_KV512S : O_KV2048S)) + (size_t)db * L * 1024;
    LAS float* TABS = (LAS float*)(F.lds + SCR_OFF + 4096);
    for (int i = tid; i < 4 * 129; i += 512) { const int h_ = i / 129, j_ = i - 129 * h_; TABS[h_ * 132 + j_] = ((const float*)(ws + WS_BT))[(G * 4 + h_) * TABW + 31 + j_]; }
    __syncthreads();
    const LAS float* bt = TABS + hh * 132;
    v4u qp[NT]; float m[NT], l[NT], o[NT][8];
#pragma unroll
    for (int ts = 0; ts < NT; ++ts) {
        const int t = (G == 0) ? ts : (G == 1 ? (wave & 3) + 4 * ts : wave);
        const bf16* qr = (const bf16*)(ws + WS_Q) + (size_t)(MP + db * 8 + t) * DQKV + (G * 4 + hh) * 128 + c4;
        const u32x2 q0 = *(const u32x2*)qr, q1 = *(const u32x2*)(qr + 64);
        qp[ts] = (v4u){q0.x, q0.y, q1.x, q1.y};
        m[ts] = -INFINITY; l[ts] = 0.f;
#pragma unroll
        for (int e = 0; e < 8; ++e) o[ts][e] = 0.f;
    }
    const bool lastp = (G == 2 && COPY == 2) ? (p + 1 == NPART - 1) : (p == NPART - 1);
    f32x4 kvA[RB][4], kvB[RB][4];
    stream_load<G, RB, COPY>(kvA, cache, okv, 0, wave, p, lane, lastp);
#pragma unroll 1
    for (int bi = 0; bi < NB; bi += 2) {
        if (bi + 1 < NB) stream_load<G, RB, COPY>(kvB, cache, okv, bi + 1, wave, p, lane, lastp);
        stream_proc<G, RB, NT, COPY>(kvA, okv, bi, wave, p, lane, lastp, qp, m, l, o, bt);
        if (bi + 2 < NB) stream_load<G, RB, COPY>(kvA, cache, okv, bi + 2, wave, p, lane, lastp);
        if (bi + 1 < NB) stream_proc<G, RB, NT, COPY>(kvB, okv, bi + 1, wave, p, lane, lastp, qp, m, l, o, bt);
    }
    LAS float* LO = (LAS float*)(F.lds);
    LAS float* LM = (LAS float*)(F.lds + SCR_OFF);
    LAS float* LL = LM + 8 * NC * 4;
#pragma unroll
    for (int ts = 0; ts < NT; ++ts) {
        const int t = (G == 0) ? ts : (G == 1 ? (wave & 3) + 4 * ts : wave), c = (G == 0) ? wave : (G == 1 ? (wave >> 2) : 0);
        *(LAS f32x4*)(LO + (t * NC + c) * 512 + hh * 128 + c4) = (f32x4){o[ts][0], o[ts][1], o[ts][2], o[ts][3]};
        *(LAS f32x4*)(LO + (t * NC + c) * 512 + hh * 128 + 64 + c4) = (f32x4){o[ts][4], o[ts][5], o[ts][6], o[ts][7]};
        if ((lane & 15) == 0) { LM[(t * NC + c) * 4 + hh] = m[ts]; LL[(t * NC + c) * 4 + hh] = l[ts]; }
    }
    __syncthreads();
    {
        const int h2 = tid >> 7, d = tid & 127, slot = (G == 0) ? 0 : (G == 1 ? 1 + p : 5 + p);
        float* PART = (float*)(ws + WS_PART);
#pragma unroll 1
        for (int t = 0; t < 8; ++t) {
            float M = -INFINITY;
#pragma unroll
            for (int c = 0; c < NC; ++c) M = fmaxf(M, LM[(t * NC + c) * 4 + h2]);
            float Ls = 0.f, os = 0.f;
            if (M > -INFINITY) {
#pragma unroll
                for (int c = 0; c < NC; ++c) { const float f = __builtin_amdgcn_exp2f(LM[(t * NC + c) * 4 + h2] - M); Ls += LL[(t * NC + c) * 4 + h2] * f; os += LO[(t * NC + c) * 512 + tid] * f; }
            }
            float* pp = PART + ((size_t)((db * 8 + t) * 4 + h2) * PSLOTS + slot) * PSTRIDE;
            pg8::st_wt4((unsigned*)(pp + d), __float_as_uint(os));
            if (d == 0) { pg8::st_wt4((unsigned*)(pp + 128), __float_as_uint(M)); pg8::st_wt4((unsigned*)(pp + 129), __float_as_uint(Ls)); }
            if (G == 2 && COPY == 2) { pg8::st_wt4((unsigned*)(pp + PSTRIDE + d), 0u); if (d == 0) { pg8::st_wt4((unsigned*)(pp + PSTRIDE + 128), __float_as_uint(-INFINITY)); pg8::st_wt4((unsigned*)(pp + PSTRIDE + 129), 0u); } }
        }
    }
    __syncthreads();
}
__device__ __forceinline__ void merge_unit(const Frame& F, const Args& A, int r) {
    unsigned char* ws = A.ws;
    const int h2 = F.tid >> 7, d = F.tid & 127;
    const float* pp = (const float*)(ws + WS_PART) + (size_t)(r * 4 + h2) * PSLOTS * PSTRIDE;
    float ms[PSLOTS], M = -INFINITY;
#pragma unroll
    for (int s2 = 0; s2 < PSLOTS; ++s2) { ms[s2] = pp[s2 * PSTRIDE + 128]; M = fmaxf(M, ms[s2]); }
    float Ls = 0.f, os = 0.f;
#pragma unroll
    for (int s2 = 0; s2 < PSLOTS; ++s2) { const float f = __builtin_amdgcn_exp2f(ms[s2] - M); Ls += pp[s2 * PSTRIDE + 129] * f; os += pp[s2 * PSTRIDE + d] * f; }
    const size_t o2 = (size_t)(MP + r) * DAO + F.tid;
    const float sg = pg8::silu_f(__uint_as_float((unsigned)((const bf16*)(ws + WS_SGB))[o2] << 16));
    pg8::st_wt2((unsigned short*)(ws + WS_ACAT) + (size_t)(MP + r) * KCAT + 1024 + F.tid, cvtpk(os / Ls * sg, 0.f) & 0xffffu);
}

template <int MODE>
__device__ __forceinline__ void skinny_unit(const Frame& F, const Args& A, int unit) {
    typedef float f32x16 __attribute__((ext_vector_type(16)));
    unsigned char* ws = A.ws;
    const int rb = unit >> 5, cb = unit & 31, row0 = MP + 32 * rb, col0 = 32 * cb;
    int tid = F.tid; asm volatile("" : "+v"(tid));
    const int lane = tid & 63, wave = F.wave, r = lane & 31, h = lane >> 5;
    LAS float* RED = (LAS float*)(F.lds);
    const int idx = 2 * tid, orow = idx >> 5, ocol = idx & 31;
    const size_t grow = (size_t)(row0 + orow);
    unsigned gr = 0, g2 = 0; f32x2 xres = (f32x2){0.f, 0.f};
    if (MODE == 0) { const bf16* GM = (const bf16*)(ws + WS_GM); gr = *(const unsigned*)(GM + grow * 2048 + col0 + ocol); g2 = *(const unsigned*)(GM + grow * 2048 + 1024 + col0 + ocol); }
    else xres = *(const f32x2*)(A.in[1] + (grow - MP) * 1024 + col0 + ocol);
    const bf16* Ap = (MODE == 0 ? (const bf16*)(ws + WS_ACAT) + (size_t)(row0 + r) * KCAT : (const bf16*)(ws + WS_MG) + (size_t)(row0 + r) * 1024) + 128 * wave + 8 * h;
    const bf16* Wp = (MODE == 0 ? (const bf16*)(ws + WS_WCAT) + (size_t)(col0 + r) * KCAT : (const bf16*)(ws + WS_WOUT) + (size_t)(col0 + r) * 1024) + 128 * wave + 8 * h;
    bf16x8 a[8], b[8], a2[4], b2[4];
#pragma unroll
    for (int s2 = 0; s2 < 8; ++s2) { a[s2] = *(const bf16x8*)(Ap + 16 * s2); b[s2] = *(const bf16x8*)(Wp + 16 * s2); }
    if (MODE == 0) {
        const bf16* Ap2 = (const bf16*)(ws + WS_ACAT) + (size_t)(row0 + r) * KCAT + 1024 + 64 * wave + 8 * h;
        const bf16* Wp2 = (const bf16*)(ws + WS_WCAT) + (size_t)(col0 + r) * KCAT + 1024 + 64 * wave + 8 * h;
#pragma unroll
        for (int s2 = 0; s2 < 4; ++s2) { a2[s2] = *(const bf16x8*)(Ap2 + 16 * s2); b2[s2] = *(const bf16x8*)(Wp2 + 16 * s2); }
    }
    f32x16 acc1, acc2;
#pragma unroll
    for (int e = 0; e < 16; ++e) { acc1[e] = 0.f; acc2[e] = 0.f; }
#pragma unroll
    for (int s2 = 0; s2 < 8; ++s2) acc1 = __builtin_amdgcn_mfma_f32_32x32x16_bf16(a[s2], b[s2], acc1, 0, 0, 0);
    if (MODE == 0) {
#pragma unroll
        for (int s2 = 0; s2 < 4; ++s2) acc2 = __builtin_amdgcn_mfma_f32_32x32x16_bf16(a2[s2], b2[s2], acc2, 0, 0, 0);
    }
#pragma unroll
    for (int e = 0; e < 16; ++e) { const int row = (e & 3) + 8 * (e >> 2) + 4 * h;
        RED[(wave * 2 + 0) * 1024 + row * 32 + r] = acc1[e];
        if (MODE == 0) RED[(wave * 2 + 1) * 1024 + row * 32 + r] = acc2[e]; }
    __syncthreads();
    {
        f32x2 ya = (f32x2){0.f, 0.f}, yb = ya;
#pragma unroll
        for (int w = 0; w < 8; ++w) { ya += *(const LAS f32x2*)(RED + (w * 2 + 0) * 1024 + idx); if (MODE == 0) yb += *(const LAS f32x2*)(RED + (w * 2 + 1) * 1024 + idx); }
        if (MODE == 0) pg8::st_wt4((unsigned*)((bf16*)(ws + WS_MG) + grow * 1024 + col0 + ocol), cvtpk(bflo(g2) * (bflo(gr) * ya[0] + yb[0]), bfhi(g2) * (bfhi(gr) * ya[1] + yb[1])));
        else *(f32x2*)(A.out + grow * 1024 + col0 + ocol) = xres + ya;
    }
    __syncthreads();
}

__device__ __forceinline__ void a1_item(const Frame& F, const Args& A, int cidx) {
    unsigned char* ws = A.ws;
    const bf16* HL = (const bf16*)(ws + WS_HL); const bf16* PP = (const bf16*)(ws + WS_PP); const bf16* SGA = (const bf16*)(ws + WS_SGA); bf16* A1 = (bf16*)(ws + WS_A1);
    const float* PEND = (const float*)(ws + WS_PEND); const float* HEND = (const float*)(ws + WS_HEND);
    const bool prompt = cidx < 128; const int b = cidx >> 4, c = cidx & 15;
    const int m0 = prompt ? b * 2048 + c * 128 : MP + (cidx - 128) * 128;
    const int ch0 = 4 * (F.tid & 255), half = F.tid >> 8;
    f32x4 H = (f32x4){0.f, 0.f, 0.f, 0.f};
    if (prompt) {
        for (int cc = 0; cc < c; ++cc) { const f32x4 p = *(const f32x4*)(PEND + (b * 16 + cc) * 1024 + ch0), hh = *(const f32x4*)(HEND + (b * 16 + cc) * 1024 + ch0); H = p * H + hh; }
        if (c == 15 && half == 0) { const f32x4 p = *(const f32x4*)(PEND + cidx * 1024 + ch0), hh = *(const f32x4*)(HEND + cidx * 1024 + ch0); *(f32x4*)(A.out + O_HP + b * 1024 + ch0) = p * H + hh; }
    }
#pragma unroll 4
    for (int i = 0; i < 64; ++i) {
        const size_t off = (size_t)(m0 + half * 64 + i) * 1024 + ch0;
        const u32x2 hl = *(const u32x2*)(HL + off), pp = *(const u32x2*)(PP + off), sg = *(const u32x2*)(SGA + off);
        const float h0 = (bflo(hl.x) + bflo(pp.x) * H[0]) * silu_lo(sg.x), h1 = (bfhi(hl.x) + bfhi(pp.x) * H[1]) * silu_hi(sg.x);
        const float h2 = (bflo(hl.y) + bflo(pp.y) * H[2]) * silu_lo(sg.y), h3 = (bfhi(hl.y) + bfhi(pp.y) * H[3]) * silu_hi(sg.y);
        u32x2 w; w.x = cvtpk(h0, h1); w.y = cvtpk(h2, h3);
        *(u32x2*)(A1 + off) = w;
    }
}
__device__ __forceinline__ void a2_item(const Frame& F, const Args& A, int it) {
    unsigned char* ws = A.ws;
    const bf16* Ob = (const bf16*)(ws + WS_O); const float* LSE = (const float*)(ws + WS_LSE); const bf16* SGB = (const bf16*)(ws + WS_SGB); bf16* A2 = (bf16*)(ws + WS_ACAT);
    const int tl = F.tid >> 6, k = F.tid & 63, hh = k >> 4, d0 = 8 * (k & 15);
    const pg8::wt_rsrc rsA = pg8::wt_make(A2, (unsigned)((size_t)MT * KCAT * 2));
#pragma unroll
    for (int i = 0; i < 8; ++i) {
        const size_t m = (size_t)it * 64 + i * 8 + tl;
        const float l0 = LSE[m * NHEAD + hh], l1 = LSE[m * NHEAD + 4 + hh], l2 = LSE[m * NHEAD + 8 + hh];
        const float mx = fmaxf(l0, fmaxf(l1, l2));
        float w0 = __builtin_amdgcn_exp2f((l0 - mx) * LOG2E), w1 = __builtin_amdgcn_exp2f((l1 - mx) * LOG2E), w2 = __builtin_amdgcn_exp2f((l2 - mx) * LOG2E);
        const float inv = 1.0f / (w0 + w1 + w2); w0 *= inv; w1 *= inv; w2 *= inv;
        const v4u o0 = __builtin_nontemporal_load((const v4u*)(Ob + m * DQKV + hh * 128 + d0)), o1 = __builtin_nontemporal_load((const v4u*)(Ob + m * DQKV + (4 + hh) * 128 + d0)), o2 = __builtin_nontemporal_load((const v4u*)(Ob + m * DQKV + (8 + hh) * 128 + d0));
        const v4u sg = __builtin_nontemporal_load((const v4u*)(SGB + m * DAO + hh * 128 + d0));
        v4u w;
        w.x = cvtpk((w0 * bflo(o0.x) + w1 * bflo(o1.x) + w2 * bflo(o2.x)) * silu_lo(sg.x), (w0 * bfhi(o0.x) + w1 * bfhi(o1.x) + w2 * bfhi(o2.x)) * silu_hi(sg.x));
        w.y = cvtpk((w0 * bflo(o0.y) + w1 * bflo(o1.y) + w2 * bflo(o2.y)) * silu_lo(sg.y), (w0 * bfhi(o0.y) + w1 * bfhi(o1.y) + w2 * bfhi(o2.y)) * silu_hi(sg.y));
        w.z = cvtpk((w0 * bflo(o0.z) + w1 * bflo(o1.z) + w2 * bflo(o2.z)) * silu_lo(sg.z), (w0 * bfhi(o0.z) + w1 * bfhi(o1.z) + w2 * bfhi(o2.z)) * silu_hi(sg.z));
        w.w = cvtpk((w0 * bflo(o0.w) + w1 * bflo(o1.w) + w2 * bflo(o2.w)) * silu_lo(sg.w), (w0 * bfhi(o0.w) + w1 * bfhi(o1.w) + w2 * bfhi(o2.w)) * silu_hi(sg.w));
        pg8::st_wt16(rsA, (unsigned)(m * KCAT + 1024 + hh * 128 + d0) * 2u, w);
    }
}

__device__ __forceinline__ void chain_signal(unsigned* c0, unsigned* c1) {
    asm volatile("s_waitcnt vmcnt(0)" ::: "memory");
    __syncthreads();
    if (threadIdx.x == 0) {
        (void)xb_add(c0, 1u); if (c1 != nullptr) (void)xb_add(c1, 1u);
    }
}
__device__ __forceinline__ void chain_signal_rel(unsigned* c0) {
    asm volatile("s_waitcnt vmcnt(0)" ::: "memory");
    __syncthreads();
    if (threadIdx.x == 0) {
        __builtin_amdgcn_fence(__ATOMIC_RELEASE, "agent");
        asm volatile("s_waitcnt vmcnt(0)" ::: "memory");
        (void)xb_add(c0, 1u);
    }
}
__device__ __forceinline__ void chain_wait(unsigned* c, unsigned target, unsigned* bar) {
    if (threadIdx.x == 0) {
        XB_SPIN(xb_ld(c) < target, bar);
        __builtin_amdgcn_fence(__ATOMIC_ACQUIRE, "agent");
        asm volatile("s_waitcnt vmcnt(0)" ::: "memory");
    }
    __syncthreads();
}
__device__ __forceinline__ pg8::EpiIn make_epi_in(const Frame& F, const Args& args) {
    unsigned char* ws = args.ws; pg8::EpiIn E;
    E.XA = (bf16*)(ws + WS_XA); E.SGA = (bf16*)(ws + WS_SGA); E.Q = (bf16*)(ws + WS_Q); E.Kb = (bf16*)(ws + WS_K); E.Vb = (bf16*)(ws + WS_V); E.SGB = (bf16*)(ws + WS_SGB); E.GM = (bf16*)(ws + WS_GM);
    E.out = args.out; E.b_merge = args.in[9]; E.g_q = args.in[17]; E.g_k = args.in[18]; E.scr = (LAS float*)(F.lds + EPI_OFF); E.qscale = QSCALE;
    E.o_kv128p = O_KV128P; E.o_kv512p = O_KV512P; E.o_kv2048p = O_KV2048P; E.o_convp = O_CONVP; E.o_kv128s = O_KV128S; E.o_kv512s = O_KV512S; E.o_kv2048s = O_KV2048S; E.o_convs = O_CONVS;
    return E;
}
constexpr int NPHASE = 7;
#ifndef P1_SP2
#define P1_SP2 true
#endif
#ifdef PROBE_EXTRA
#define MK_N_LAUNCHES 6
#endif
#ifndef MK_N_LAUNCHES
#define MK_N_LAUNCHES 1
#endif
__global__ void __launch_bounds__(NWAVES * 64, 2) mixer_fwd(Args args) {
    extern __shared__ __attribute__((aligned(16))) unsigned char lds[];
    Frame F;
    F.lds = (LAS unsigned char*)lds;
    F.tid = threadIdx.x; F.lane = F.tid & 63; F.wave = __builtin_amdgcn_readfirstlane(F.tid >> 6);
    F.G = gridDim.x; { const int bx = blockIdx.x; F.vcu = (F.G % 8 == 0) ? (bx % 8) * (F.G / 8) + bx / 8 : bx; }
    unsigned char* ws = args.ws;
    volatile LAS unsigned* MISC = (volatile LAS unsigned*)(F.lds + MISC_OFF);
    if (F.tid < 32) MISC[F.tid] = 0u;
    __syncthreads();
    XcdBarrier bar; bar.bar = (unsigned*)(ws + WS_CTL) + CW_BAR; bar.x = 0; bar.st = nullptr;
    if (MK_N_LAUNCHES == 1) bar = xcd_barrier_post((unsigned*)(ws + WS_CTL) + CW_BAR, MISC + 8);
    const int lo = args.ph_lo, hi = args.ph_hi;
#ifndef PROBE_REP
#define PROBE_REP 0
#endif
#define IN(k) (lo <= (k) && (k) < hi)
#define REP(k) for (int rep_ = 0; rep_ < 1 + ((PROBE_REP >> (k)) & 1); ++rep_, (rep_ < 1 + ((PROBE_REP >> (k)) & 1)) ? xcd_barrier(bar) : (void)0)
#ifdef PROBE_DBLBAR
#define SEAM(k) do { if (IN(k) && IN((k) + 1)) { xcd_barrier(bar); xcd_barrier(bar); } } while (0)
#else
#define SEAM(k) do { if (IN(k) && IN((k) + 1)) xcd_barrier(bar); } while (0)
#endif

    if (IN(0)) REP(0) { p0_prologue(F, args); }
    SEAM(0);
    if (IN(1)) REP(1) {
#ifdef P1_STAGGER
        { const unsigned long long t0 = __builtin_amdgcn_s_memrealtime(), dl = (unsigned long long)(((blockIdx.x >> 3) & 3) * P1_STAGGER);
          while (__builtin_amdgcn_s_memrealtime() - t0 < dl) __builtin_amdgcn_s_sleep(8); }
#endif
        pg8::Gemm g{(const bf16*)(ws + WS_XN), (const bf16*)(ws + WS_WIN), MP, DIN, 1024}; pg8::TileOrder S; S.init(MP, DIN, F.G, (int)blockIdx.x); S.single = false;
        const pg8::EpiIn E = make_epi_in(F, args);
        pg8::gemm_phase<pg8::EpiIn, pg8::TileOrder, true, P1_SP2>(F.lds + RING_OFF, g, S, E);
    }
    SEAM(1);
    unsigned* const chain = (unsigned*)(ws + WS_CTL) + CW_CHAIN;
    const bool chain34 = IN(3) && IN(4), chain45 = IN(4) && IN(5), chain56 = IN(5) && IN(6);
    if (IN(2)) {
        if (args.sub & 2) lru_prompt_wg(F, args, (int)blockIdx.x);
        if (blockIdx.x < 36 && (args.sub & 4)) {
            pg8::Gemm g{(const bf16*)(ws + WS_XN), (const bf16*)(ws + WS_WIN), MT, DIN, 1024}; pg8::TileOrder S; S.init(MT, DIN, F.G, (int)blockIdx.x); S.single = true; S.spm = 64; S.spn = (int)blockIdx.x;
            const pg8::EpiIn E = make_epi_in(F, args);
            pg8::gemm_phase<pg8::EpiIn, pg8::TileOrder, true, true>(F.lds + RING_OFF, g, S, E);
        }
        if ((args.sub & 1) && blockIdx.x >= 36) attn_prompt_wg(F, args, (int)blockIdx.x - 36, (int)F.G - 36);
    }
    SEAM(2);
    if (IN(3)) REP(3) {
        unsigned* qctr = (unsigned*)(ws + WS_CTL) + CW_Q3 + 64 * args.qslot;
        if (F.tid == 0) MISC[16] = atomicAdd(qctr, 1u);
        __syncthreads();
        int cur = (int)MISC[16];
        while (cur < 416 + 16) {
            unsigned nxt = 0; if (F.tid == 0) nxt = atomicAdd(qctr, 1u);
            if (cur < 416) {
                if (args.sub & 2) {
                    if (cur < 32) stream_item<0, 1>(F, args, cur, 0);
                    else if (cur < 160) stream_item<1, 1>(F, args, (cur - 32) >> 2, (cur - 32) & 3);
                    else stream_item<2, 2>(F, args, (cur - 160) >> 3, 2 * ((cur - 160) & 7));
                }
            } else { if (args.sub & 4) lru_item(F, args, 1024 + (cur - 416), -1); }
            __syncthreads();
            if (F.tid == 0) MISC[16] = nxt;
            __syncthreads();
            cur = (int)MISC[16];
        }
        if (chain34) chain_signal(chain + CH_P3, nullptr);
    }
    pg8::Unit u56; { pg8::TileOrder S; S.init(MP, 1024, F.G, (int)blockIdx.x); S.single = false; if (!S.next(0, u56)) { u56.pm = 0; u56.pn = 0; } }
    if (IN(4)) REP(4) {
        for (int it = blockIdx.x; it < 256; it += F.G) {
            a2_item(F, args, it);
            if (chain45) chain_signal(chain + CH_A2 + 16 * (it >> 2), nullptr);
            if (chain34) chain_wait(chain + CH_P3, F.G, bar.bar);
            merge_unit(F, args, it);
            if (chain45) chain_signal(chain + CH_M + 16 * (it >> 5), nullptr);
        }
    }
    if (IN(5)) REP(5) {
        if (chain45) chain_wait(chain + CH_A2 + 16 * u56.pm, 4u, bar.bar);
        {
          pg8::Gemm g{(const bf16*)(ws + WS_ACAT), (const bf16*)(ws + WS_WCAT), MP, 1024, KCAT}; pg8::TileOrder S; S.init(MP, 1024, F.G, (int)blockIdx.x); S.single = false;
          pg8::EpiMerge E{(const bf16*)(ws + WS_GM), (bf16*)(ws + WS_MG)};
          pg8::gemm_phase<pg8::EpiMerge, pg8::TileOrder, true, true>(F.lds + RING_OFF, g, S, E);
        }
        for (int u = blockIdx.x; u < 256; u += F.G) { if (chain45) chain_wait(chain + CH_M + 16 * (u >> 5), 32u, bar.bar); skinny_unit<0>(F, args, u); if (chain56) chain_signal(chain + CH_5 + 16 * u56.pm, chain + CH_S + 16 * (u >> 5)); }
    }
    if (IN(6)) REP(6) {
        if (chain56) chain_wait(chain + CH_5 + 16 * u56.pm, 4u, bar.bar);
        pg8::Gemm g{(const bf16*)(ws + WS_MG), (const bf16*)(ws + WS_WOUT), MP, 1024, 1024}; pg8::TileOrder S; S.init(MP, 1024, F.G, (int)blockIdx.x); S.single = false;
        pg8::EpiOut E{args.in[0], args.in[1], args.out};
        pg8::gemm_phase<pg8::EpiOut, pg8::TileOrder, true, true>(F.lds + RING_OFF, g, S, E);
        for (int u = blockIdx.x; u < 256; u += F.G) { if (chain56) chain_wait(chain + CH_S + 16 * (u >> 5), 32u, bar.bar); skinny_unit<1>(F, args, u); }
    }
#undef IN
#undef SEAM
}

extern "C" void kernel_launch(void* const* d_in, const int* in_sizes, int n_in, void* d_out, int out_size, void* d_ws, size_t ws_size, hipStream_t stream) {
    static int grid = 0;
    if (grid == 0) {
        if (n_in != 23 || (size_t)out_size != O_END || ws_size < WS_END) { fprintf(stderr, "kernel_launch: unexpected shapes: n_in %d out %d (want %zu) ws %zu (want >= %zu)\n", n_in, out_size, (size_t)O_END, ws_size, (size_t)WS_END); grid = -1; return; }
        int dev = 0, cus = 0;
        if (hipGetDevice(&dev) != hipSuccess || hipDeviceGetAttribute(&cus, hipDeviceAttributeMultiprocessorCount, dev) != hipSuccess) { grid = -1; return; }
        if (hipFuncSetAttribute((const void*)mixer_fwd, hipFuncAttributeMaxDynamicSharedMemorySize, LDS_BYTES) != hipSuccess) { fprintf(stderr, "kernel_launch: hipFuncSetAttribute failed\n"); grid = -1; return; }
        (void)hipGetLastError();
        if (cus != 256) { fprintf(stderr, "kernel_launch: built for a 256-CU device (one workgroup per CU), found %d CUs; nothing launched\n", cus); grid = -1; return; }
        grid = cus;
    }
    if (grid < 0) return;
    if (hipMemsetAsync((char*)d_ws + WS_CTL, 0, CTL_ZERO_BYTES, stream) != hipSuccess) return;
    Args a{};
    for (int i = 0; i < 23; ++i) a.in[i] = (const float*)d_in[i];
    a.out = (float*)d_out; a.ws = (unsigned char*)d_ws;
#ifdef PROBE_EXTRA
#ifndef PROBE_SUB
#define PROBE_SUB 7
#endif
    for (int p = 0; p < NPHASE; ++p) for (int k = 0; k < 1 + (p == PROBE_EXTRA ? 1 : 0); ++k) { a.ph_lo = p; a.ph_hi = p + 1; a.qslot = k; a.sub = k ? PROBE_SUB : 7; hipLaunchKernelGGL(mixer_fwd, dim3(grid), dim3(NWAVES * 64), LDS_BYTES, stream, a); }
#else
    a.sub = 7;
    if (MK_N_LAUNCHES == 1) { a.ph_lo = 0; a.ph_hi = NPHASE; hipLaunchKernelGGL(mixer_fwd, dim3(grid), dim3(NWAVES * 64), LDS_BYTES, stream, a); }
    else for (int p = 0; p < NPHASE; ++p) { a.ph_lo = p; a.ph_hi = p + 1; hipLaunchKernelGGL(mixer_fwd, dim3(grid), dim3(NWAVES * 64), LDS_BYTES, stream, a); }
#endif
}
```

```cpp
#include <hip/hip_runtime.h>
#include <cstdio>
#include <cstdint>
#include <cmath>
namespace pg8 {
#define PG8_LAS __attribute__((address_space(3)))
typedef unsigned short bf16_t;
typedef short bf16x8 __attribute__((ext_vector_type(8)));
typedef float f32x4 __attribute__((ext_vector_type(4)));
typedef unsigned u32x4 __attribute__((ext_vector_type(4)));
constexpr int BM = 256, BK = 64, HALF = 128, HTB = HALF * BK * 2  , STAGE_BYTES = 8 * HTB, NXCD = 8, WGM = 2;

__host__ __device__ __forceinline__ int lds_byte(int r, int c) { const int st = (r >> 4) * 2 + (c >> 5), rr = r & 15, cc = c & 31, ob = rr * 64 + cc * 2; return st * 1024 + (ob ^ (((ob >> 9) & 1) << 5)); }
__host__ __device__ __forceinline__ void stage_rc(int b, int& R, int& C) { const int st = b / 1024, sb = b % 1024, swz = sb ^ (((sb >> 9) & 1) << 5); R = (st >> 1) * 16 + swz / 64; C = (st & 1) * 32 + (swz % 64) / 2; }
__host__ __device__ __forceinline__ int perm32(int rho) { const int n = rho >> 4, i = rho & 15; return 8 * (i >> 2) + 4 * n + (i & 3); }

struct Unit { int pm, pn; };
struct Gemm { const bf16_t* A; const bf16_t* Bt; int M, N, K; };

struct StaticOrder {
    int nM, nN, nwg, G, c;
    __host__ __device__ void init(int M, int N, int G_, int c_) { nM = M / BM; nN = N / BM; nwg = nM * nN; G = G_; c = c_; }
    __host__ __device__ bool next(int i, Unit& u) const {
        const long L = (long)i * G + c; if (L >= nwg) return false;
        int wgid = (int)L; { const int q = nwg / NXCD, r = nwg % NXCD, xcd = wgid % NXCD, off = wgid / NXCD; wgid = (xcd < r ? xcd * (q + 1) : r * (q + 1) + (xcd - r) * q) + off; }
        const int nig = WGM * nN, gid = wgid / nig, fm = gid * WGM, gsz = (nM - fm) < WGM ? (nM - fm) : WGM;
        u.pm = fm + ((wgid % nig) % gsz); u.pn = (wgid % nig) / gsz; return true;
    }
    __device__ __forceinline__ void a_ready(const Unit&) const {}
    __device__ __forceinline__ void done(const Unit&) const {}
    __device__ __forceinline__ void pre_epi(int, const Unit&) const {}
};


__device__ __forceinline__ unsigned cvt_pk_bf16(float lo, float hi) { unsigned r; asm volatile("v_cvt_pk_bf16_f32 %0, %1, %2" : "=v"(r) : "v"(lo), "v"(hi)); return r; }
__device__ __forceinline__ float bf_lo(unsigned w) { return __uint_as_float(w << 16); }
__device__ __forceinline__ float bf_hi(unsigned w) { return __uint_as_float(w & 0xffff0000u); }
__device__ __forceinline__ float sigmoid_f(float x) { return __builtin_amdgcn_rcpf(1.0f + __builtin_amdgcn_exp2f(-1.4426950408889634f * x)); }
__device__ __forceinline__ float silu_f(float x) { return x * sigmoid_f(x); }
__device__ __forceinline__ float sum_fq(float s) {
    { const auto r = __builtin_amdgcn_permlane16_swap(__float_as_uint(s), __float_as_uint(s), false, false); s = __uint_as_float(r[0]) + __uint_as_float(r[1]); }
    { const auto r = __builtin_amdgcn_permlane32_swap(__float_as_uint(s), __float_as_uint(s), false, false); s = __uint_as_float(r[0]) + __uint_as_float(r[1]); }
    return s;
}
__device__ __forceinline__ u32x4 pack8(const f32x4& a, const f32x4& b) { u32x4 w; w.x = cvt_pk_bf16(a[0], a[1]); w.y = cvt_pk_bf16(a[2], a[3]); w.z = cvt_pk_bf16(b[0], b[1]); w.w = cvt_pk_bf16(b[2], b[3]); return w; }

typedef __amdgpu_buffer_rsrc_t wt_rsrc;
__device__ __forceinline__ wt_rsrc wt_make(void* base, unsigned bytes) { return __builtin_amdgcn_make_buffer_rsrc(base, 0, bytes, 0x00020000); }
__device__ __forceinline__ void st_wt16(wt_rsrc rs, unsigned byte_off, const u32x4& v) { __builtin_amdgcn_raw_buffer_store_b128(v, rs, byte_off, 0, 16); }
__device__ __forceinline__ void st_wt4(unsigned* p, unsigned v) { __hip_atomic_store(p, v, __ATOMIC_RELAXED, __HIP_MEMORY_SCOPE_AGENT); }
__device__ __forceinline__ void st_wt2(unsigned short* p, unsigned v) { __hip_atomic_store(p, (unsigned short)v, __ATOMIC_RELAXED, __HIP_MEMORY_SCOPE_AGENT); }
struct TileOrder : StaticOrder {
    bool single; int spm, spn;
    __device__ __forceinline__ bool next(int i, Unit& u) const { if (single) { if (i != 0) return false; u.pm = spm; u.pn = spn; return true; } return StaticOrder::next(i, u); }
    unsigned* rdy = nullptr; unsigned rdy_target = 0; unsigned* rdy_tmo = nullptr;
    __device__ __forceinline__ void a_ready(const Unit&) const {
        if (rdy == nullptr) return;
        if (threadIdx.x == 0) {
            unsigned sp = 0;
            while (__hip_atomic_load(rdy, __ATOMIC_RELAXED, __HIP_MEMORY_SCOPE_AGENT) < rdy_target) { __builtin_amdgcn_s_sleep(1);
                if ((++sp & 255u) == 0u) { if (__hip_atomic_load(rdy_tmo, __ATOMIC_RELAXED, __HIP_MEMORY_SCOPE_AGENT)) break; if (sp > (1u << 18)) { atomicAdd(rdy_tmo, 1u); break; } } }
            __builtin_amdgcn_fence(__ATOMIC_ACQUIRE, "agent");
            asm volatile("s_waitcnt vmcnt(0)" ::: "memory");
        }
        __syncthreads();
    }
    int arr_ui = -1; unsigned* arr_cx = nullptr; unsigned* arr_top = nullptr; unsigned arr_x = 0; volatile PG8_LAS unsigned* arr_st = nullptr;
    const float* park_src = nullptr; float* park_dst = nullptr; PG8_LAS unsigned char* park_lds = nullptr;
    __device__ __forceinline__ bool park_addr(const Unit& u, size_t& off_src, size_t& off_dst) const {
        const int T = 36 * u.pm + u.pn; if (T >= 2048) return false;
        const int un = T >> 1, hf = T & 1, db = un >> 5, rg = 4 * (un & 31) + 3;
        off_src = ((size_t)db * 2048 + 16 * rg + 8 + 4 * hf) * 1024; off_dst = ((size_t)db * 2048 + 16 * rg + 4 * hf) * 1024; return true;
    }
    __device__ __forceinline__ void park_store(const Unit& u) const {
        size_t os, od; if (!park_addr(u, os, od)) return;
        const int t = threadIdx.x;
#pragma unroll
        for (int sl = 0; sl < 2; ++sl) { const u32x4 v = *(const PG8_LAS u32x4*)(park_lds + sl * 8192 + t * 16); __builtin_nontemporal_store(v, (u32x4*)(park_dst + od + sl * 2048) + t); }
    }
    __device__ __forceinline__ void park_load(const Unit& u) const {
        size_t os, od; if (!park_addr(u, os, od)) return;
        const int t = threadIdx.x, w = __builtin_amdgcn_readfirstlane(t >> 6);
        asm volatile("s_waitcnt lgkmcnt(0)" ::: "memory");
#pragma unroll
        for (int sl = 0; sl < 2; ++sl) __builtin_amdgcn_global_load_lds((const unsigned*)(park_src + os + sl * 2048 + t * 4), (PG8_LAS unsigned*)(park_lds + sl * 8192 + w * 1024), 16, 0, 2);
    }
    __device__ __forceinline__ void pre_epi(int ui, const Unit& cur) const {
        if (park_lds != nullptr) {
            if (ui > 0) { Unit pv; if (next(ui - 1, pv)) park_store(pv); }
            park_load(cur);
        }
        if (ui == arr_ui && threadIdx.x == 0) {
            const unsigned nloc = arr_st[0];
            const unsigned old = __hip_atomic_fetch_add(arr_cx + 16 * arr_x, 1u, __ATOMIC_RELAXED, __HIP_MEMORY_SCOPE_AGENT);
            if (old + 1u == nloc) {
                __builtin_amdgcn_fence(__ATOMIC_RELEASE, "agent");
                asm volatile("s_waitcnt vmcnt(0)" ::: "memory");
                (void)__hip_atomic_fetch_add(arr_top, 1u, __ATOMIC_RELAXED, __HIP_MEMORY_SCOPE_AGENT);
            }
        }
    }
};
struct NoCopy { static constexpr bool ON = false; };
struct KvCopy {
    static constexpr bool ON = true;
    const float *c128, *c512, *c2048; float *o128, *o512, *o2048; float* dummy; int c0, nsteps; int ring_off;
    __device__ __forceinline__ void addr(int q, const float*& src, float*& dst) const {
        int c = c0 + q;
        if (c < 1920) { const int db = c / 60, r = c - db * 60; src = c128 + ((size_t)db * 128 + 8) * 1024 + (size_t)r * 2048; dst = o128 + (size_t)db * 128 * 1024 + (size_t)r * 2048; }
        else if (c < 1920 + 8064) { c -= 1920; const int db = c / 252, r = c - db * 252; src = c512 + ((size_t)db * 512 + 8) * 1024 + (size_t)r * 2048; dst = o512 + (size_t)db * 512 * 1024 + (size_t)r * 2048; }
        else { c -= 9984; const int db = c / 1020, r = c - db * 1020; src = c2048 + ((size_t)db * 2048 + 8) * 1024 + (size_t)r * 2048; dst = o2048 + (size_t)db * 2048 * 1024 + (size_t)r * 2048; }
    }
    __device__ __forceinline__ void dma(PG8_LAS unsigned char* lds, int q, int tid, int wid) const {
        const float* src; float* dst; addr(q < nsteps ? q : nsteps - 1, src, dst);
        __builtin_amdgcn_global_load_lds((const unsigned*)(src + tid * 4), (PG8_LAS unsigned*)(lds + ring_off + (q % 3) * 8192 + wid * 1024), 16, 0, 2);
    }
    __device__ __forceinline__ u32x4 rd(PG8_LAS unsigned char* lds, int q, int tid) const { return *(const PG8_LAS u32x4*)(lds + ring_off + ((q + 3) % 3) * 8192 + tid * 16); }
    __device__ __forceinline__ void st(const u32x4& v, int q, int tid) const {
        const float* src; float* dst = dummy;
        if (q >= 0 && q < nsteps) addr(q, src, dst);
        __builtin_nontemporal_store(v, (u32x4*)(dst + tid * 4));
    }
};
constexpr int MP_ = 16384;
struct EpiIn {
    static constexpr bool PERM = true, AFTER_DRAIN = false, INIT = false; static constexpr int MIDK = -1;
    bf16_t *XA, *SGA, *Q, *Kb, *Vb, *SGB, *GM;
    float* out;
    const float *b_merge, *g_q, *g_k;
    PG8_LAS float* scr;
    float qscale;
    size_t o_kv128p, o_kv512p, o_kv2048p, o_convp, o_kv128s, o_kv512s, o_kv2048s, o_convs;
    __device__ __forceinline__ void operator()(const f32x4 (&acc)[2][2][4][2], const Unit& u, int wr, int wc, int fr, int fq) const {
        const int pn = u.pn, pm = u.pm;
        const int rowl0 = wr * 64 + fr;
        const int cl0 = wc * 32 + 8 * fq;
        if (pn >= 8 && pn < 20) {
            const bool isk = pn >= 14;
            const float* gw = isk ? g_k : g_q;
            const f32x4 g0 = *(const f32x4*)(gw + cl0), g1 = *(const f32x4*)(gw + cl0 + 4);
            const float sc = isk ? 1.0f : qscale;
            const int colt = (pn - (isk ? 14 : 8)) * 256;
            bf16_t* dst = isk ? Kb : Q;
            const int grp = colt / 512;
#pragma unroll
            for (int ai = 0; ai < 2; ++ai) {
#pragma unroll
                for (int m = 0; m < 4; ++m)
#pragma unroll
                    for (int bj = 0; bj < 2; ++bj) {
                        const f32x4 a = acc[ai][bj][m][0], b = acc[ai][bj][m][1];
                        float s = (a[0] * a[0] + a[1] * a[1]) + (a[2] * a[2] + a[3] * a[3]) + (b[0] * b[0] + b[1] * b[1]) + (b[2] * b[2] + b[3] * b[3]);
                        s = sum_fq(s);
                        if (fq == 0) scr[((rowl0 + m * 16) * 2 + bj) * 4 + wc] = s;
                    }
                asm volatile("s_waitcnt lgkmcnt(0)" ::: "memory"); __builtin_amdgcn_s_barrier(); asm volatile("" ::: "memory");
#pragma unroll
                for (int m = 0; m < 4; ++m) {
                    const int rl = ai * 128 + rowl0 + m * 16; const int row = pm * 256 + rl;
                    float* kvrow = nullptr;
                    if (isk) {
                        if (row < MP_) { const int b = row >> 11, t = row & 2047;
                            if (grp == 0) { if (t >= 1920) kvrow = out + o_kv128p + ((size_t)(b * 128 + (t - 1920))) * 1024; }
                            else if (grp == 1) { if (t >= 1536) kvrow = out + o_kv512p + ((size_t)(b * 512 + (t - 1536))) * 1024; }
                            else kvrow = out + o_kv2048p + ((size_t)(b * 2048 + t)) * 1024;
                        } else { const int rs = row - MP_, db = rs >> 3, t = rs & 7;
                            if (grp == 0) kvrow = out + o_kv128s + ((size_t)(db * 128 + 120 + t)) * 1024;
                            else if (grp == 1) kvrow = out + o_kv512s + ((size_t)(db * 512 + 504 + t)) * 1024;
                            else kvrow = out + o_kv2048s + ((size_t)(db * 2048 + 2040 + t)) * 1024;
                        }
                    }
#pragma unroll
                    for (int bj = 0; bj < 2; ++bj) {
                        const f32x4 p = *(const PG8_LAS f32x4*)(scr + ((rowl0 + m * 16) * 2 + bj) * 4);
                        const float rs_ = __builtin_amdgcn_rsqf(((p[0] + p[1]) + (p[2] + p[3])) * (1.0f / 128.0f) + 1e-6f);
                        f32x4 a = acc[ai][bj][m][0] * rs_ * g0, b = acc[ai][bj][m][1] * rs_ * g1;
                        if (kvrow) { float* kp = kvrow + ((colt & 511) + bj * 128 + cl0); __builtin_nontemporal_store(a, (f32x4*)kp); __builtin_nontemporal_store(b, (f32x4*)(kp + 4)); }
                        a = a * sc; b = b * sc;
                        *(u32x4*)(dst + (size_t)row * 1536 + colt + bj * 128 + cl0) = pack8(a, b);
                    }
                }
                if (ai == 0) { asm volatile("s_waitcnt lgkmcnt(0)" ::: "memory"); __builtin_amdgcn_s_barrier(); asm volatile("" ::: "memory"); }
            }
            return;
        }
        int mode, ld, colt; bf16_t* dst;
        if (pn < 4)       { mode = 0; dst = XA;  ld = 1024; colt = pn * 256; }
        else if (pn < 8)  { mode = 4; dst = SGA; ld = 1024; colt = (pn - 4) * 256; }
        else if (pn < 26) { mode = 2; dst = Vb;  ld = 1536; colt = (pn - 20) * 256; }
        else if (pn < 28) { mode = 4; dst = SGB; ld = 512;  colt = (pn - 26) * 256; }
        else              { mode = 3; dst = GM;  ld = 2048; colt = (pn - 28) * 256; }
        f32x4 bm[2][2];
#pragma unroll
        for (int bj = 0; bj < 2; ++bj)
#pragma unroll
            for (int n = 0; n < 2; ++n) bm[bj][n] = (mode == 3) ? *(const f32x4*)(b_merge + bj * 1024 + colt / 2 + cl0 + 4 * n) : (f32x4){0.f, 0.f, 0.f, 0.f};
        const int grp = colt / 512;
#pragma unroll
        for (int ai = 0; ai < 2; ++ai)
#pragma unroll
            for (int m = 0; m < 4; ++m) {
                const int rl = ai * 128 + rowl0 + m * 16; const int row = pm * 256 + rl;
                float* frow = nullptr;
                if (mode == 2) {
                    if (row < MP_) { const int b = row >> 11, t = row & 2047;
                        if (grp == 0) { if (t >= 1920) frow = out + o_kv128p + ((size_t)(b * 128 + (t - 1920))) * 1024; }
                        else if (grp == 1) { if (t >= 1536) frow = out + o_kv512p + ((size_t)(b * 512 + (t - 1536))) * 1024; }
                        else frow = out + o_kv2048p + ((size_t)(b * 2048 + t)) * 1024;
                    } else { const int rs = row - MP_, db = rs >> 3, t = rs & 7;
                        if (grp == 0) frow = out + o_kv128s + ((size_t)(db * 128 + 120 + t)) * 1024;
                        else if (grp == 1) frow = out + o_kv512s + ((size_t)(db * 512 + 504 + t)) * 1024;
                        else frow = out + o_kv2048s + ((size_t)(db * 2048 + 2040 + t)) * 1024;
                    }
                    if (frow) frow += 512 + (colt & 511);
                } else if (mode == 0) {
                    if (row < MP_) { const int b = row >> 11, t = row & 2047; if (t >= 2045) frow = out + o_convp + ((size_t)(b * 3 + (t - 2045))) * 1024 + colt; }
                    else { const int rs = row - MP_, db = rs >> 3, t = rs & 7; if (t >= 5) frow = out + o_convs + ((size_t)(db * 3 + (t - 5))) * 1024 + colt; }
                }
#pragma unroll
                for (int bj = 0; bj < 2; ++bj) {
                    f32x4 a = acc[ai][bj][m][0], b = acc[ai][bj][m][1];
                    if (frow) { float* kp = frow + bj * 128 + cl0; __builtin_nontemporal_store(a, (f32x4*)kp); __builtin_nontemporal_store(b, (f32x4*)(kp + 4)); }
                    if (mode == 1) {
#pragma unroll
                        for (int e = 0; e < 4; ++e) { a[e] = silu_f(a[e]); b[e] = silu_f(b[e]); }
                    } else if (mode == 3) {
                        if (bj == 1) continue;
                        const f32x4 pa0 = a + bm[0][0], pa1 = b + bm[0][1], pb0 = acc[ai][1][m][0] + bm[1][0], pb1 = acc[ai][1][m][1] + bm[1][1];
                        f32x4 r0, r1, h0, h1;
#pragma unroll
                        for (int e = 0; e < 4; ++e) {
                            const float ea0 = __builtin_amdgcn_exp2f(-1.4426950408889634f * pa0[e]), eb0 = fminf(__builtin_amdgcn_exp2f(-1.4426950408889634f * pb0[e]), 1.1529215e18f);
                            const float ea1 = __builtin_amdgcn_exp2f(-1.4426950408889634f * pa1[e]), eb1 = fminf(__builtin_amdgcn_exp2f(-1.4426950408889634f * pb1[e]), 1.1529215e18f);
                            r0[e] = (1.0f + eb0) * __builtin_amdgcn_rcpf(1.0f + ea0); h0[e] = __builtin_amdgcn_rcpf(1.0f + eb0);
                            r1[e] = (1.0f + eb1) * __builtin_amdgcn_rcpf(1.0f + ea1); h1[e] = __builtin_amdgcn_rcpf(1.0f + eb1);
                        }
                        *(u32x4*)(dst + (size_t)row * 2048 + colt / 2 + cl0) = pack8(r0, r1);
                        *(u32x4*)(dst + (size_t)row * 2048 + 1024 + colt / 2 + cl0) = pack8(h0, h1);
                        continue;
                    }
                    *(u32x4*)(dst + (size_t)row * ld + colt + bj * 128 + cl0) = pack8(a, b);
                }
            }
    }
};

struct EpiG1 {
    static constexpr bool PERM = true, AFTER_DRAIN = false, INIT = false; static constexpr int MIDK = -1;
    const bf16_t* GM; float* T1;
    __device__ __forceinline__ void operator()(const f32x4 (&acc)[2][2][4][2], const Unit& u, int wr, int wc, int fr, int fq) const {
        const int row0 = u.pm * 256 + wr * 64 + fr, col0 = u.pn * 256 + wc * 32 + 8 * fq;
#pragma unroll
        for (int ai = 0; ai < 2; ++ai)
#pragma unroll
            for (int m = 0; m < 4; ++m) { const int row = row0 + ai * 128 + m * 16;
#pragma unroll
                for (int bj = 0; bj < 2; ++bj) { const int col = col0 + bj * 128;
                    const u32x4 g = *(const u32x4*)(GM + (size_t)row * 2048 + col);
                    f32x4 a = acc[ai][bj][m][0], b = acc[ai][bj][m][1];
                    a[0] *= bf_lo(g.x); a[1] *= bf_hi(g.x); a[2] *= bf_lo(g.y); a[3] *= bf_hi(g.y);
                    b[0] *= bf_lo(g.z); b[1] *= bf_hi(g.z); b[2] *= bf_lo(g.w); b[3] *= bf_hi(g.w);
                    float* p = T1 + (size_t)row * 1024 + col; *(f32x4*)p = a; *(f32x4*)(p + 4) = b; } }
    }
};
struct EpiG2 {
    static constexpr bool PERM = true, AFTER_DRAIN = false, INIT = false; static constexpr int MIDK = -1;
    const bf16_t* GM; const float* T1; bf16_t* MG;
    __device__ __forceinline__ void operator()(const f32x4 (&acc)[2][2][4][2], const Unit& u, int wr, int wc, int fr, int fq) const {
        const int row0 = u.pm * 256 + wr * 64 + fr, col0 = u.pn * 256 + wc * 32 + 8 * fq;
#pragma unroll
        for (int ai = 0; ai < 2; ++ai)
#pragma unroll
            for (int m = 0; m < 4; ++m) { const int row = row0 + ai * 128 + m * 16;
#pragma unroll
                for (int bj = 0; bj < 2; ++bj) { const int col = col0 + bj * 128;
                    const u32x4 g = *(const u32x4*)(GM + (size_t)row * 2048 + 1024 + col);
                    const float* p = T1 + (size_t)row * 1024 + col; f32x4 a = *(const f32x4*)p, b = *(const f32x4*)(p + 4);
                    const f32x4 x = acc[ai][bj][m][0], y = acc[ai][bj][m][1];
                    a[0] += x[0] * bf_lo(g.x); a[1] += x[1] * bf_hi(g.x); a[2] += x[2] * bf_lo(g.y); a[3] += x[3] * bf_hi(g.y);
                    b[0] += y[0] * bf_lo(g.z); b[1] += y[1] * bf_hi(g.z); b[2] += y[2] * bf_lo(g.w); b[3] += y[3] * bf_hi(g.w);
                    *(u32x4*)(MG + (size_t)row * 1024 + col) = pack8(a, b); } }
    }
};
struct EpiMerge {
    static constexpr bool PERM = true, AFTER_DRAIN = false, INIT = false; static constexpr int MIDK = 16;
    const bf16_t* GM; bf16_t* MG;
    __device__ __forceinline__ void mid(f32x4 (&acc)[2][2][4][2], const Unit& u, int, int, int, int) const {
        int t_ = threadIdx.x; asm volatile("" : "+v"(t_));
        const int wid_ = t_ >> 6, wr = wid_ >> 2, wc = wid_ & 3, fr = t_ & 15, fq = (t_ >> 4) & 3;
        const bf16_t* gp = GM + (size_t)(u.pm * 256 + wr * 64 + fr) * 2048 + u.pn * 256 + wc * 32 + 8 * fq;
#pragma unroll
        for (int ai = 0; ai < 2; ++ai) {
#pragma unroll
            for (int m = 0; m < 4; ++m)
#pragma unroll
                for (int bj = 0; bj < 2; ++bj) {
                    const u32x4 g1 = __builtin_nontemporal_load((const u32x4*)(gp + (size_t)(ai * 128 + m * 16) * 2048 + bj * 128));
                    f32x4 a = acc[ai][bj][m][0], b = acc[ai][bj][m][1];
                    a[0] *= bf_lo(g1.x); a[1] *= bf_hi(g1.x); a[2] *= bf_lo(g1.y); a[3] *= bf_hi(g1.y);
                    b[0] *= bf_lo(g1.z); b[1] *= bf_hi(g1.z); b[2] *= bf_lo(g1.w); b[3] *= bf_hi(g1.w);
                    acc[ai][bj][m][0] = a; acc[ai][bj][m][1] = b; }
            asm volatile("" ::: "memory");
        }
    }
    __device__ __forceinline__ void operator()(const f32x4 (&acc)[2][2][4][2], const Unit& u, int wr, int wc, int fr, int fq) const {
        const int row0 = u.pm * 256 + wr * 64 + fr, col0 = u.pn * 256 + wc * 32 + 8 * fq;
        const wt_rsrc rs = wt_make(MG, (unsigned)(16640u * 1024u * 2u));
#pragma unroll
        for (int ai = 0; ai < 2; ++ai)
#pragma unroll
            for (int m = 0; m < 4; ++m) { const int row = row0 + ai * 128 + m * 16;
#pragma unroll
                for (int bj = 0; bj < 2; ++bj) { const int col = col0 + bj * 128;
                    const u32x4 g2 = __builtin_nontemporal_load((const u32x4*)(GM + (size_t)row * 2048 + 1024 + col));
                    f32x4 a = acc[ai][bj][m][0], b = acc[ai][bj][m][1];
                    a[0] *= bf_lo(g2.x); a[1] *= bf_hi(g2.x); a[2] *= bf_lo(g2.y); a[3] *= bf_hi(g2.y);
                    b[0] *= bf_lo(g2.z); b[1] *= bf_hi(g2.z); b[2] *= bf_lo(g2.w); b[3] *= bf_hi(g2.w);
                    st_wt16(rs, (unsigned)(row * 1024 + col) * 2u, pack8(a, b)); } }
    }
};
struct EpiOut {
    static constexpr bool PERM = true, AFTER_DRAIN = false, INIT = true; static constexpr int MIDK = -1;
    const float *xp, *xs; float* y;
    __device__ __forceinline__ void init(f32x4 (&acc)[2][2][4][2], const Unit& u, int wr, int wc, int fr, int fq) const {
        const int row0 = u.pm * 256 + wr * 64 + fr, col0 = u.pn * 256 + wc * 32 + 8 * fq;
        const float* xb = (u.pm < 64) ? xp : (xs - (size_t)MP_ * 1024);
#pragma unroll
        for (int ai = 0; ai < 2; ++ai)
#pragma unroll
            for (int m = 0; m < 4; ++m) { const int row = row0 + ai * 128 + m * 16;
#pragma unroll
                for (int bj = 0; bj < 2; ++bj) { const size_t off = (size_t)row * 1024 + col0 + bj * 128;
                    acc[ai][bj][m][0] = __builtin_nontemporal_load((const f32x4*)(xb + off)); acc[ai][bj][m][1] = __builtin_nontemporal_load((const f32x4*)(xb + off + 4)); } }
    }
    __device__ __forceinline__ void operator()(const f32x4 (&acc)[2][2][4][2], const Unit& u, int wr, int wc, int fr, int fq) const {
        const int row0 = u.pm * 256 + wr * 64 + fr, col0 = u.pn * 256 + wc * 32 + 8 * fq;
#pragma unroll
        for (int ai = 0; ai < 2; ++ai)
#pragma unroll
            for (int m = 0; m < 4; ++m) { const int row = row0 + ai * 128 + m * 16;
#pragma unroll
                for (int bj = 0; bj < 2; ++bj) { const size_t off = (size_t)row * 1024 + col0 + bj * 128;
                    __builtin_nontemporal_store(acc[ai][bj][m][0], (f32x4*)(y + off)); __builtin_nontemporal_store(acc[ai][bj][m][1], (f32x4*)(y + off + 4)); } }
    }
};

template <class Epi, class Sched, bool ALIGN_EPI = false, bool SP2 = false, class CP = NoCopy>
__device__ __forceinline__ void gemm_phase(PG8_LAS unsigned char* lds, const Gemm g, const Sched& S, const Epi& E, const CP& cp = CP()) {
    int tid_ = threadIdx.x; asm volatile("" : "+v"(tid_));
    const int tid = tid_, wid = __builtin_amdgcn_readfirstlane(tid >> 6), lane = tid & 63, wr = wid >> 2, wc = wid & 3, fr = lane & 15, fq = lane >> 4;
    const int K = g.K, nt = K / BK;
    unsigned voffA[2], voffB[2];
#pragma unroll
    for (int i = 0; i < 2; ++i) { int R, C; stage_rc(tid * 16 + i * 8192, R, C); const int Rb = Epi::PERM ? ((R & ~31) + perm32(R & 31)) : R;
        voffA[i] = (unsigned)(R * K + C) * 2u; voffB[i] = (unsigned)(Rb * K + C) * 2u; }
    const size_t kstep = (size_t)(BK * 2);
    const size_t hstep = (size_t)HALF * K * 2;
    const size_t tstep = 2 * hstep;
    const unsigned ldsw = (unsigned)wid * 1024u;
    const int aoff = lds_byte(wr * 64 + fr, fq * 8), boff = lds_byte(wc * 32 + fr, fq * 8);
#define PG8_SA(b, h) (((b) * 2 + (h)) * HTB)
#define PG8_SB(b, h) ((4 + (b) * 2 + (h)) * HTB)
#define PG8_STAGE(bufoff, gbase, voff) do { _Pragma("unroll") for (int _i = 0; _i < 2; ++_i) \
        __builtin_amdgcn_global_load_lds((const unsigned*)((const char*)(gbase) + (voff)[_i]), (PG8_LAS unsigned*)(lds + (bufoff) + ldsw + _i * 8192), 16, 0, 0); } while (0)
#define PG8_LDA(dst, b, h) do { _Pragma("unroll") for (int m = 0; m < 4; ++m) _Pragma("unroll") for (int k = 0; k < 2; ++k) dst[m][k] = *(const PG8_LAS bf16x8*)(lds + PG8_SA(b, h) + aoff + m * 2048 + k * 1024); } while (0)
#define PG8_LDB(dst, b, h) do { _Pragma("unroll") for (int n = 0; n < 2; ++n) _Pragma("unroll") for (int k = 0; k < 2; ++k) dst[n][k] = *(const PG8_LAS bf16x8*)(lds + PG8_SB(b, h) + boff + n * 2048 + k * 1024); } while (0)
#define PG8_MMA(ai, bj, At, Bt) do { __builtin_amdgcn_s_setprio(1); _Pragma("unroll") for (int m = 0; m < 4; ++m) _Pragma("unroll") for (int n = 0; n < 2; ++n) _Pragma("unroll") for (int k = 0; k < 2; ++k) \
        acc[ai][bj][m][n] = __builtin_amdgcn_mfma_f32_16x16x32_bf16(Bt[n][k], At[m][k], acc[ai][bj][m][n], 0, 0, 0); __builtin_amdgcn_s_setprio(0); } while (0)
#define PG8_WAIT_V(n) asm volatile("s_waitcnt vmcnt(" #n ")" ::: "memory")
#define PG8_WAIT_L(n) asm volatile("s_waitcnt lgkmcnt(" #n ")" ::: "memory")
#define PG8_BAR __builtin_amdgcn_s_barrier()
#define PG8_SCHED __builtin_amdgcn_sched_barrier(0)
    Unit cur, nxt; int ui = 0;
    if (!S.next(0, cur)) return;
    f32x4 acc[2][2][4][2];
    if constexpr (Epi::INIT) E.init(acc, cur, wr, wc, fr, fq);
    else {
#pragma unroll
    for (int a = 0; a < 2; ++a)
#pragma unroll
        for (int b = 0; b < 2; ++b)
#pragma unroll
            for (int m = 0; m < 4; ++m)
#pragma unroll
                for (int n = 0; n < 2; ++n) acc[a][b][m][n] = (f32x4){0.f, 0.f, 0.f, 0.f};
    }
    bf16x8 At[4][2], B0[2][2], B1[2][2];
    int cq = 0; u32x4 cpv = (u32x4){0u, 0u, 0u, 0u}; (void)cq; (void)cpv;
    const char* cA = (const char*)g.A + (size_t)cur.pm * tstep; const char* cB = (const char*)g.Bt + (size_t)cur.pn * tstep;
    S.a_ready(cur);
    if constexpr (SP2) {
        PG8_STAGE(PG8_SB(0, 0), cB, voffB); PG8_STAGE(PG8_SB(0, 1), cB + hstep, voffB); PG8_STAGE(PG8_SA(0, 0), cA, voffA); PG8_STAGE(PG8_SA(0, 1), cA + hstep, voffA);
        if (wr == 1) PG8_BAR;
        PG8_WAIT_V(2); PG8_BAR;
        PG8_STAGE(PG8_SB(1, 0), cB + kstep, voffB); PG8_STAGE(PG8_SA(1, 0), cA + kstep, voffA); PG8_STAGE(PG8_SB(1, 1), cB + hstep + kstep, voffB);
        PG8_WAIT_V(6); PG8_BAR;
        if constexpr (CP::ON) cp.st(cp.rd(lds, -1, tid), -1, tid);
    } else {
        PG8_STAGE(PG8_SB(0, 0), cB, voffB); PG8_STAGE(PG8_SA(0, 0), cA, voffA); PG8_STAGE(PG8_SB(0, 1), cB + hstep, voffB); PG8_STAGE(PG8_SA(0, 1), cA + hstep, voffA);
        if (wr == 1) PG8_BAR;
        PG8_WAIT_V(4); PG8_BAR;
        PG8_STAGE(PG8_SB(1, 0), cB + kstep, voffB); PG8_STAGE(PG8_SA(1, 0), cA + kstep, voffA); PG8_STAGE(PG8_SB(1, 1), cB + hstep + kstep, voffB);
        PG8_WAIT_V(6); PG8_BAR;
    }
    for (;;) {
        const bool has_next = S.next(ui + 1, nxt);
        const char* nA = has_next ? (const char*)g.A + (size_t)nxt.pm * tstep : cA; const char* nB = has_next ? (const char*)g.Bt + (size_t)nxt.pn * tstep : cB;
        for (int t = 0; t < nt; t += 2) {
            if constexpr (Epi::MIDK >= 0) { if (t == Epi::MIDK) E.mid(acc, cur, wr, wc, fr, fq); }
            const bool last = (t == nt - 2);
            const char* a1 = cA + (size_t)(t + 1) * kstep;
            const char* a2 = last ? nA : cA + (size_t)(t + 2) * kstep; const char* b2 = last ? nB : cB + (size_t)(t + 2) * kstep;
            const char* a3 = a2 + kstep; const char* b3 = b2 + kstep;
            if (last && has_next) S.a_ready(nxt);
            if constexpr (SP2) {
#define PG8_WAIT_VC() do { if constexpr (CP::ON) PG8_WAIT_V(12); else PG8_WAIT_V(8); } while (0)
#define PG8_CP_DMA() do { if constexpr (CP::ON) cp.dma(lds, cq, tid, wid); } while (0)
#define PG8_CP_RD() do { if constexpr (CP::ON) cpv = cp.rd(lds, cq - 2, tid); } while (0)
#define PG8_CP_ST() do { if constexpr (CP::ON) { cp.st(cpv, cq - 2, tid); ++cq; } } while (0)
            PG8_LDB(B0, 0, 0); PG8_LDB(B1, 0, 1); PG8_SCHED; PG8_LDA(At, 0, 0); PG8_CP_DMA(); PG8_STAGE(PG8_SA(1, 1), a1 + hstep, voffA);
            PG8_WAIT_VC(); PG8_CP_RD(); PG8_WAIT_L(0); PG8_BAR; PG8_CP_ST(); PG8_MMA(0, 0, At, B0); PG8_MMA(0, 1, At, B1); PG8_BAR; PG8_SCHED;
            PG8_LDA(At, 0, 1); PG8_CP_DMA(); PG8_STAGE(PG8_SB(0, 0), b2, voffB); PG8_STAGE(PG8_SB(0, 1), b2 + hstep, voffB); PG8_STAGE(PG8_SA(0, 0), a2, voffA);
            PG8_WAIT_VC(); PG8_CP_RD(); PG8_WAIT_L(0); PG8_BAR; PG8_CP_ST(); PG8_MMA(1, 0, At, B0); PG8_MMA(1, 1, At, B1); PG8_BAR; PG8_SCHED;
            PG8_LDB(B0, 1, 0); PG8_LDB(B1, 1, 1); PG8_SCHED; PG8_LDA(At, 1, 0); PG8_CP_DMA(); PG8_STAGE(PG8_SA(0, 1), a2 + hstep, voffA);
            PG8_WAIT_VC(); PG8_CP_RD(); PG8_WAIT_L(0); PG8_BAR; PG8_CP_ST(); PG8_MMA(0, 0, At, B0); PG8_MMA(0, 1, At, B1); PG8_BAR; PG8_SCHED;
            PG8_LDA(At, 1, 1); PG8_CP_DMA(); PG8_STAGE(PG8_SB(1, 0), b3, voffB); PG8_STAGE(PG8_SB(1, 1), b3 + hstep, voffB); PG8_STAGE(PG8_SA(1, 0), a3, voffA);
            PG8_WAIT_VC(); PG8_CP_RD(); PG8_WAIT_L(0); PG8_BAR; PG8_CP_ST(); PG8_MMA(1, 0, At, B0); PG8_MMA(1, 1, At, B1); PG8_BAR; PG8_SCHED;
            } else {
            PG8_LDB(B0, 0, 0); PG8_SCHED; PG8_LDA(At, 0, 0); PG8_STAGE(PG8_SA(1, 1), a1 + hstep, voffA);
            PG8_WAIT_L(8); PG8_BAR; PG8_WAIT_L(0); PG8_MMA(0, 0, At, B0); PG8_BAR; PG8_SCHED;
            PG8_LDB(B1, 0, 1); PG8_STAGE(PG8_SB(0, 0), b2, voffB);
            PG8_BAR; PG8_WAIT_L(0); PG8_MMA(0, 1, At, B1); PG8_BAR;
            PG8_LDA(At, 0, 1); PG8_STAGE(PG8_SA(0, 0), a2, voffA);
            PG8_BAR; PG8_WAIT_L(0); PG8_MMA(1, 0, At, B0); PG8_BAR; PG8_SCHED;
            PG8_STAGE(PG8_SB(0, 1), b2 + hstep, voffB);
            PG8_WAIT_V(6); PG8_BAR; PG8_MMA(1, 1, At, B1); PG8_BAR;
            PG8_LDB(B0, 1, 0); PG8_SCHED; PG8_LDA(At, 1, 0); PG8_STAGE(PG8_SA(0, 1), a2 + hstep, voffA);
            PG8_WAIT_L(8); PG8_BAR; PG8_WAIT_L(0); PG8_MMA(0, 0, At, B0); PG8_BAR; PG8_SCHED;
            PG8_LDB(B1, 1, 1); PG8_STAGE(PG8_SB(1, 0), b3, voffB);
            PG8_BAR; PG8_WAIT_L(0); PG8_MMA(0, 1, At, B1); PG8_BAR;
            PG8_LDA(At, 1, 1); PG8_STAGE(PG8_SA(1, 0), a3, voffA);
            PG8_BAR; PG8_WAIT_L(0); PG8_MMA(1, 0, At, B0); PG8_BAR; PG8_SCHED;
            PG8_STAGE(PG8_SB(1, 1), b3 + hstep, voffB);
            PG8_WAIT_V(6); PG8_BAR; PG8_MMA(1, 1, At, B1); PG8_BAR;
            }
        }
        if constexpr (ALIGN_EPI) { if (wr == 0) PG8_BAR; }
        if constexpr (ALIGN_EPI) S.pre_epi(ui, cur);
        if constexpr (!Epi::AFTER_DRAIN) { E(acc, cur, wr, wc, fr, fq); S.done(cur); }
        if (!has_next) break;
        if constexpr (Epi::INIT) E.init(acc, nxt, wr, wc, fr, fq);
        else {
#pragma unroll
        for (int a = 0; a < 2; ++a)
#pragma unroll
            for (int b = 0; b < 2; ++b)
#pragma unroll
                for (int m = 0; m < 4; ++m)
#pragma unroll
                    for (int n = 0; n < 2; ++n) acc[a][b][m][n] = (f32x4){0.f, 0.f, 0.f, 0.f};
        }
        cur = nxt; cA = nA; cB = nB; ++ui;
        if constexpr (ALIGN_EPI) { if (wr == 1) PG8_BAR; }
    }
    PG8_WAIT_V(0);
    if constexpr (!ALIGN_EPI) { if (wr == 0) PG8_BAR; }
    PG8_BAR;
    if constexpr (Epi::AFTER_DRAIN) { E.fused(acc, cur, wr, wc, fr, fq, lds, wid, lane); S.done(cur); }
#undef PG8_SA
#undef PG8_SB
#undef PG8_STAGE
#undef PG8_LDA
#undef PG8_LDB
#undef PG8_MMA
#undef PG8_WAIT_V
#undef PG8_WAIT_VC
#undef PG8_CP_DMA
#undef PG8_CP_RD
#undef PG8_CP_ST
#undef PG8_WAIT_L
#undef PG8_BAR
#undef PG8_SCHED
}
}
#define GAS __attribute__((address_space(1)))
#define LAS __attribute__((address_space(3)))
typedef unsigned short bf16;
typedef unsigned v4u __attribute__((ext_vector_type(4)));
typedef float f32x4 __attribute__((ext_vector_type(4)));
typedef short bf16x8 __attribute__((ext_vector_type(8)));
typedef GAS unsigned gu32;
typedef GAS unsigned long long gu64;
#define RLX_AGENT __ATOMIC_RELAXED, __HIP_MEMORY_SCOPE_AGENT
#define LDS_WAIT() asm volatile("s_waitcnt lgkmcnt(0)" ::: "memory")
#define VM_WAIT() asm volatile("s_waitcnt vmcnt(0)" ::: "memory")
__device__ __forceinline__ unsigned long long rt() { return __builtin_amdgcn_s_memrealtime(); }
__device__ __forceinline__ unsigned f2bf(float f) { unsigned u = __builtin_bit_cast(unsigned, f); return (u + 0x7fffu + ((u >> 16) & 1u)) >> 16; }
__device__ __forceinline__ unsigned pk2(float lo, float hi) { return f2bf(lo) | (f2bf(hi) << 16); }
#define XB_TMO      128
#define XB_XCNT(j)  (256  + 64 * (j))
#define XB_XSUB(j)  (1280 + 64 * (j))
#define XB_XGEN(j)  (2304 + 64 * (j))
#define XB_TOP      3328
#define XB_TOPGEN   3392
#define XCD_BAR_WORDS 3456
#define XB_SPIN_CAP (1u << 18)

__device__ __forceinline__ unsigned xb_ld(unsigned* p)              { return __hip_atomic_load(p, __ATOMIC_RELAXED, __HIP_MEMORY_SCOPE_AGENT); }
__device__ __forceinline__ unsigned xb_add(unsigned* p, unsigned v) { return __hip_atomic_fetch_add(p, v, __ATOMIC_RELAXED, __HIP_MEMORY_SCOPE_AGENT); }
__device__ __forceinline__ unsigned xb_xcc_id() { return (unsigned)__builtin_amdgcn_s_getreg((3 << 11) | 20) & 0xFu; }
#define XB_SPIN(cond, bar) do { unsigned _sp = 0; while (cond) { __builtin_amdgcn_s_sleep(1); \
    if ((++_sp & 255u) == 0u) { if (xb_ld(&(bar)[XB_TMO])) break; if (_sp > XB_SPIN_CAP) { atomicAdd(&(bar)[XB_TMO], 1u); break; } } } } while (0)

struct XcdBarrier {
    unsigned* bar; unsigned x;
    volatile LAS unsigned* st;
};

__device__ __forceinline__ XcdBarrier xcd_barrier_post(unsigned* bar, volatile LAS unsigned* st) {
    XcdBarrier b; b.bar = bar; b.x = xb_xcc_id(); b.st = st;
    if (threadIdx.x == 0) (void)xb_add(&bar[XB_XCNT(b.x)], 1u);
    return b;
}
__device__ __forceinline__ void xcd_barrier_complete(unsigned* bar, unsigned x, unsigned& nloc, unsigned& nx) {
    const unsigned G = gridDim.x * gridDim.y * gridDim.z;
    unsigned sum, cnt, mine, sp = 0u;
    for (;;) {
        sum = 0u; cnt = 0u; mine = 0u;
#pragma unroll
        for (unsigned j = 0; j < 16; ++j) { const unsigned c = xb_ld(&bar[XB_XCNT(j)]); sum += c; cnt += (c > 0u) ? 1u : 0u; mine = (j == x) ? c : mine; }
        if (sum == G) break;
        __builtin_amdgcn_s_sleep(1);
        if ((++sp & 255u) == 0u) { if (xb_ld(&bar[XB_TMO])) break; if (sp > XB_SPIN_CAP) { atomicAdd(&bar[XB_TMO], 1u); break; } }
    }
    nloc = mine > 0u ? mine : 1u; nx = cnt > 0u ? cnt : 1u;
}

__device__ __forceinline__ void xcd_barrier(const XcdBarrier& b) {
    asm volatile("s_waitcnt vmcnt(0)" ::: "memory");
    __syncthreads();
    if (threadIdx.x == 0) {
        unsigned* bar = b.bar;
        __builtin_amdgcn_s_waitcnt(0);
        unsigned nloc = b.st[0], nx = b.st[1];
        if (nloc == 0u) { xcd_barrier_complete(bar, b.x, nloc, nx); b.st[0] = nloc; b.st[1] = nx; }
        const unsigned old = xb_add(&bar[XB_XSUB(b.x)], 1u);
        const unsigned gen = old / nloc;
        if (old + 1u == (gen + 1u) * nloc) {
            __builtin_amdgcn_fence(__ATOMIC_RELEASE, "agent");
            asm volatile("s_waitcnt vmcnt(0)" ::: "memory");
            const unsigned og = xb_add(&bar[XB_TOP], 1u);
            const unsigned tg = og / nx;
            if (og + 1u == (tg + 1u) * nx) xb_add(&bar[XB_TOPGEN], 1u);
            else XB_SPIN(xb_ld(&bar[XB_TOPGEN]) == tg, bar);
            __builtin_amdgcn_fence(__ATOMIC_ACQUIRE, "agent");
            xb_add(&bar[XB_XGEN(b.x)], 1u);
            asm volatile("s_waitcnt vmcnt(0)" ::: "memory");
        } else {
            XB_SPIN(xb_ld(&bar[XB_XGEN(b.x)]) == gen, bar);
            __builtin_amdgcn_fence(__ATOMIC_ACQUIRE, "agent");
            asm volatile("s_waitcnt vmcnt(0)" ::: "memory");
        }
    }
    __syncthreads();
}

constexpr int NWAVES = 8;
constexpr int MP = 16384, MS = 256, MT = MP + MS;
constexpr int DMOD = 1024, DIN = 9216, DQKV = 1536, DAO = 512, NHEAD = 12, KCAT = 1536;
constexpr float LOG2E = 1.4426950408889634f, LN2 = 0.6931471805599453f;
constexpr float QSCALE = 0.08838834764831845f * LOG2E;
constexpr int TABW = 192;
constexpr size_t O_YP = 0, O_YS = O_YP + (size_t)MP * 1024, O_KV128P = O_YS + (size_t)MS * 1024, O_KV512P = O_KV128P + (size_t)8 * 128 * 1024,
                 O_KV2048P = O_KV512P + (size_t)8 * 512 * 1024, O_CONVP = O_KV2048P + (size_t)8 * 2048 * 1024, O_HP = O_CONVP + 8 * 3 * 1024,
                 O_KV128S = O_HP + 8 * 1024, O_KV512S = O_KV128S + (size_t)32 * 128 * 1024, O_KV2048S = O_KV512S + (size_t)32 * 512 * 1024,
                 O_CONVS = O_KV2048S + (size_t)32 * 2048 * 1024, O_HS = O_CONVS + 32 * 3 * 1024, O_END = O_HS + 32 * 1024;
constexpr size_t MiB = 1u << 20;
constexpr size_t WS_CTL = 0, CTL_ZERO_BYTES = 64 * 1024;
constexpr size_t WS_BT = 1 * MiB, WS_WIN = 2 * MiB, WS_WLRU = 20 * MiB, WS_WATT = 22 * MiB, WS_WOUT = 23 * MiB, WS_WA = 25 * MiB, WS_WX = 25 * MiB + 512 * 1024,
                 WS_PEND = 26 * MiB, WS_HEND = 27 * MiB, WS_LSE = 28 * MiB,
                 WS_XN = 32 * MiB, WS_XA = 65 * MiB, WS_SGA = 98 * MiB, WS_Q = 131 * MiB, WS_K = 180 * MiB, WS_V = 229 * MiB, WS_SGB = 278 * MiB, WS_GM = 295 * MiB,
                 WS_O = 360 * MiB, WS_HL = 409 * MiB, WS_PP = 442 * MiB, WS_A1 = 475 * MiB, WS_A2 = 508 * MiB, WS_T1 = 525 * MiB, WS_MG = 590 * MiB, WS_PART = 623 * MiB, WS_DUMMY = 636 * MiB, WS_WCAT = 639 * MiB, WS_ACAT = 409 * MiB  , WS_END = 643 * MiB;
constexpr int CW_BAR = 1024, CW_Q2 = 512, CW_MRG = 896, CW_LFLAG = 8192, CW_Q3 = 640;
constexpr int CW_CHAIN = 5120, CH_A2 = 0, CH_M = 64 * 16, CH_5 = 72 * 16, CH_S = 136 * 16, CH_S1 = 144 * 16, CH_P2 = 145 * 16  , CH_P3 = 146 * 16, CH_P2X = 147 * 16  , CH_1A = 163 * 16, CH_1AX = 164 * 16, CH_1B = 180 * 16, CH_1BX = 181 * 16, CH_0A = 320 * 16, CH_0AX = 321 * 16, CH_0B = 337 * 16, CH_0BX = 338 * 16  ;
constexpr int PSLOTS = 21, PSTRIDE = 132;
static_assert((CW_BAR + XCD_BAR_WORDS) * 4 <= (int)CTL_ZERO_BYTES, "ctl");
constexpr int RING_OFF = 0, RING_BYTES = 131072, CPR_OFF = 131072  , EPI_OFF = CPR_OFF + 24576  ,
              SCR_OFF = CPR_OFF, TAB_OFF = EPI_OFF + 4096, MISC_OFF = TAB_OFF + 1024, LDS_BYTES = 163840;
static_assert(MISC_OFF + 128 <= LDS_BYTES, "LDS map");

typedef unsigned u32x2 __attribute__((ext_vector_type(2)));
typedef short v4i16_t __attribute__((ext_vector_type(4)));
typedef float f32x2 __attribute__((ext_vector_type(2)));

struct Args {
    const float* in[23]; float* out; unsigned char* ws; int ph_lo, ph_hi, qslot, sub;
};
struct Frame {
    LAS unsigned char* lds; int tid, lane, wave, vcu, G;
};
__device__ __forceinline__ float wave_sum(float v) {
#pragma unroll
    for (int o = 1; o < 64; o <<= 1) v += __shfl_xor(v, o);
    return v;
}
__device__ __forceinline__ unsigned cvtpk(float lo, float hi) { return pg8::cvt_pk_bf16(lo, hi); }
__device__ __forceinline__ float bflo(unsigned w) { return __uint_as_float(w << 16); }
__device__ __forceinline__ float bfhi(unsigned w) { return __uint_as_float(w & 0xffff0000u); }
__device__ __forceinline__ float silu_lo(unsigned w) { return pg8::silu_f(bflo(w)); }
__device__ __forceinline__ float silu_hi(unsigned w) { return pg8::silu_f(bfhi(w)); }
__device__ __forceinline__ unsigned off_b(unsigned row, unsigned ch) { return 256u * row + 16u * (ch ^ (((row & 3u) << 2) | ((row >> 2) & 3u))); }

struct BgCopy { v4u r[16]; };
__device__ __forceinline__ void bg_addr(const Args& A, int c, const float*& src, float*& dst) {
    if (c < 1920) { const int db = c / 60, r = c - db * 60; src = A.in[2] + ((size_t)db * 128 + 8) * 1024 + (size_t)r * 2048; dst = A.out + O_KV128S + (size_t)db * 128 * 1024 + (size_t)r * 2048; }
    else if (c < 1920 + 8064) { c -= 1920; const int db = c / 252, r = c - db * 252; src = A.in[3] + ((size_t)db * 512 + 8) * 1024 + (size_t)r * 2048; dst = A.out + O_KV512S + (size_t)db * 512 * 1024 + (size_t)r * 2048; }
    else { c -= 9984; const int db = c / 1020, r = c - db * 1020; src = A.in[4] + ((size_t)db * 2048 + 8) * 1024 + (size_t)r * 2048; dst = A.out + O_KV2048S + (size_t)db * 2048 * 1024 + (size_t)r * 2048; }
}
__device__ __forceinline__ void bg_load(const Args& A, int cu, int tid, BgCopy& B) {
#pragma unroll
    for (int i = 0; i < 16; ++i) { const float* src; float* dst; bg_addr(A, 16 * cu + i, src, dst); B.r[i] = __builtin_nontemporal_load((const v4u*)src + tid); }
}
__device__ __forceinline__ void bg_store(const Args& A, int cu, int tid, const BgCopy& B) {
#pragma unroll
    for (int i = 0; i < 16; ++i) { const float* src; float* dst; bg_addr(A, 16 * cu + i, src, dst); __builtin_nontemporal_store(B.r[i], (v4u*)dst + tid); }
}
constexpr int BG_UNITS = 2664;
struct BgHalf { v4u r[8]; };
__device__ __forceinline__ void bg2h_load(const Args& A, int u, int hf, int tid, BgHalf& B) {
    const int db = u >> 5, rg0 = 4 * (u & 31) + 2 * hf;
#pragma unroll
    for (int i = 0; i < 2 - hf; ++i) { const v4u* src = (const v4u*)(A.in[4] + ((size_t)db * 2048 + 16 * (rg0 + i) + 8) * 1024);
#pragma unroll
        for (int j = 0; j < 4; ++j) B.r[4 * i + j] = __builtin_nontemporal_load(src + tid + 512 * j); }
}
__device__ __forceinline__ void bg2h_store(const Args& A, int u, int hf, int tid, const BgHalf& B) {
    const int db = u >> 5, rg0 = 4 * (u & 31) + 2 * hf;
#pragma unroll
    for (int i = 0; i < 2 - hf; ++i) { v4u* dst = (v4u*)(A.out + O_KV2048S + ((size_t)db * 2048 + 16 * (rg0 + i)) * 1024);
#pragma unroll
        for (int j = 0; j < 4; ++j) __builtin_nontemporal_store(B.r[4 * i + j], dst + tid + 512 * j); }
}
__device__ __forceinline__ void bg2_load(const Args& A, int u, int tid, BgCopy& B) {
    const int db = u >> 5, rg0 = 4 * (u & 31);
#pragma unroll
    for (int i = 0; i < 4; ++i) { const v4u* src = (const v4u*)(A.in[4] + ((size_t)db * 2048 + 16 * (rg0 + i) + 8) * 1024);
#pragma unroll
        for (int j = 0; j < 4; ++j) B.r[4 * i + j] = __builtin_nontemporal_load(src + tid + 512 * j); }
}
__device__ __forceinline__ void bg2_store(const Args& A, int u, int tid, const BgCopy& B) {
    const int db = u >> 5, rg0 = 4 * (u & 31);
#pragma unroll
    for (int i = 0; i < 4; ++i) { v4u* dst = (v4u*)(A.out + O_KV2048S + ((size_t)db * 2048 + 16 * (rg0 + i)) * 1024);
#pragma unroll
        for (int j = 0; j < 4; ++j) __builtin_nontemporal_store(B.r[4 * i + j], dst + tid + 512 * j); }
}

__device__ __forceinline__ void p0_transpose_item(const float* W, int K, int N, bf16* WT, LAS float* scr, int item, int lane, int ldo = 0, int koff = 0, bool gmil = false) {
    if (ldo == 0) ldo = K;
    const int nblk = N / 32, kb = item / nblk, nb = item % nblk, k0 = 64 * kb, n0 = 32 * nb;
    int nd0 = n0;
    if (gmil && n0 >= 7168) { const int cc = n0 - 7168, sel = cc >> 10, chn = cc & 1023; nd0 = 7168 + 256 * (chn >> 7) + 128 * sel + (chn & 127); }
#pragma unroll 8
    for (int i = 0; i < 32; ++i) { const int kk = 2 * i + (lane >> 5); scr[kk * 33 + (lane & 31)] = __builtin_nontemporal_load(W + (size_t)(k0 + kk) * N + n0 + (lane & 31)); }
    LDS_WAIT(); asm volatile("" ::: "memory");
    const int c = lane & 7;
#pragma unroll
    for (int j = 0; j < 4; ++j) { const int n = (lane >> 3) + 8 * j; const LAS float* s = scr + (8 * c) * 33 + n;
        v4u o; o.x = pk2(s[0 * 33], s[1 * 33]); o.y = pk2(s[2 * 33], s[3 * 33]); o.z = pk2(s[4 * 33], s[5 * 33]); o.w = pk2(s[6 * 33], s[7 * 33]);
        *(GAS v4u*)(WT + (size_t)(nd0 + n) * ldo + koff + k0 + 8 * c) = o; }
    LDS_WAIT(); asm volatile("" ::: "memory");
}
__device__ __forceinline__ int t5_bucket(int dist) {
    if (dist < 16) return dist;
    const int large = 16 + (int)(log((double)dist / 16.0) / log(128.0) * 16.0);
    return large < 31 ? large : 31;
}
template <int L>
__device__ __forceinline__ void copy_region(const float* src, float* dst, unsigned gt, unsigned nt) {
    constexpr unsigned per = (unsigned)(L - 8) * 256u, total = 32u * per;
    for (unsigned i = gt; i < total; i += 4 * nt) {
        f32x4 v[4];
#pragma unroll
        for (int k = 0; k < 4; ++k) { const unsigned j = i + k * nt; if (j < total) { const unsigned db = j / per, rem = j - db * per; v[k] = __builtin_nontemporal_load((const f32x4*)(src + ((size_t)db * L + 8) * 1024) + rem); } }
#pragma unroll
        for (int k = 0; k < 4; ++k) { const unsigned j = i + k * nt; if (j < total) { const unsigned db = j / per, rem = j - db * per; __builtin_nontemporal_store(v[k], (f32x4*)(dst + (size_t)db * L * 1024) + rem); } }
    }
}
template <int PART>
__device__ __forceinline__ void p0_prologue(const Frame& F, const Args& A) {
    unsigned char* ws = A.ws;
    LAS float* scr = (LAS float*)(F.lds + RING_OFF + F.wave * 16384);
    const int gw = F.vcu * NWAVES + F.wave, NGW = F.G * NWAVES;
    constexpr int I_IN = (1024 / 64) * (DIN / 32), I_LRU = 16 * 32, I_ATT = (512 / 64) * 32, I_OUT = 16 * 32, I_G = 8 * (2 * 4);
    constexpr int NITEMS = I_IN + I_LRU + I_ATT + I_OUT + 2 * I_G;
    const int rot = I_IN % NGW;
    for (int it = (PART == 0 ? gw : I_IN + (gw + NGW - rot) % NGW); it < (PART == 0 ? I_IN : NITEMS); it += NGW) {
        int r = it;
        if (r < I_IN) { p0_transpose_item(A.in[8], 1024, DIN, (bf16*)(ws + WS_WIN), scr, r, F.lane, 0, 0, true); continue; } r -= I_IN;
        if (r < I_LRU) { p0_transpose_item(A.in[20], 1024, 1024, (bf16*)(ws + WS_WCAT), scr, r, F.lane, KCAT, 0); continue; } r -= I_LRU;
        if (r < I_ATT) { p0_transpose_item(A.in[21], 512, 1024, (bf16*)(ws + WS_WCAT), scr, r, F.lane, KCAT, 1024); continue; } r -= I_ATT;
        if (r < I_OUT) { p0_transpose_item(A.in[22], 1024, 1024, (bf16*)(ws + WS_WOUT), scr, r, F.lane); continue; } r -= I_OUT;
        if (r < I_G) { const int n = r >> 3; p0_transpose_item(A.in[12] + n * 16384, 128, 128, (bf16*)(ws + WS_WA) + n * 16384, scr, r & 7, F.lane); continue; } r -= I_G;
        { const int n = r >> 3; p0_transpose_item(A.in[14] + n * 16384, 128, 128, (bf16*)(ws + WS_WX) + n * 16384, scr, r & 7, F.lane); }
    }
    if (PART == 0) {
        const float* gn = A.in[7]; bf16* XN = (bf16*)(ws + WS_XN);
        f32x4 gv[4];
#pragma unroll
        for (int j = 0; j < 4; ++j) gv[j] = ((const f32x4*)gn)[F.lane + 64 * j];
        for (int m = gw; m < MT; m += NGW) {
            const float* xrow = (m < MP) ? A.in[0] + (size_t)m * 1024 : A.in[1] + (size_t)(m - MP) * 1024;
            const f32x4* xr = (const f32x4*)xrow + F.lane;
            f32x4 v[4]; float s = 0.f;
#pragma unroll
            for (int j = 0; j < 4; ++j) { v[j] = __builtin_nontemporal_load(xr + 64 * j); s += (v[j].x * v[j].x + v[j].y * v[j].y) + (v[j].z * v[j].z + v[j].w * v[j].w); }
            const float rs = 1.f / sqrtf(wave_sum(s) * (1.f / 1024.f) + 1e-6f);
            unsigned long long* o8 = (unsigned long long*)(XN + (size_t)m * 1024) + F.lane;
#pragma unroll
            for (int j = 0; j < 4; ++j) { const f32x4 y = v[j] * rs * gv[j]; o8[64 * j] = (unsigned long long)cvtpk(y.x, y.y) | ((unsigned long long)cvtpk(y.z, y.w) << 32); }
        }
    }
    if (PART == 1) {
        const int gt = F.vcu * 512 + F.tid;
        if (gt < NHEAD * TABW) {
            const int h = gt / TABW, idx = gt % TABW, dist = idx - 31, g = h >> 2, dil = 1 << (2 * g);
            float v = -INFINITY;
            if (dist >= 0 && dist <= 128) v = A.in[19][t5_bucket(dist * dil) * NHEAD + h] * LOG2E;
            ((float*)(ws + WS_BT))[gt] = v;
        }
    }
}

constexpr int AT_K = 0, AT_V = 65536;
__device__ __forceinline__ void attn_prompt_unit(const Frame& F, const Args& A, int u, int cu) {
    unsigned char* ws = A.ws;
    const bf16* Qb = (const bf16*)(ws + WS_Q); const bf16* Kb = (const bf16*)(ws + WS_K); const bf16* Vb = (const bf16*)(ws + WS_V);
    bf16* Ob = (bf16*)(ws + WS_O); float* LSE = (float*)(ws + WS_LSE);
    const int b = u / 192, rem = u % 192, h = rem >> 4, x = rem & 15, g = h >> 2, dsh = 2 * g, dil = 1 << dsh, r = x & (dil - 1), n = x >> dsh;
    int tid_o = F.tid; asm volatile("" : "+v"(tid_o));
    const int lane = tid_o & 63, wave = F.wave, l15 = lane & 15, g4 = lane >> 4;
    LAS float* TAB = (LAS float*)(F.lds + TAB_OFF);
    if (tid_o < TABW) TAB[tid_o] = ((const float*)(ws + WS_BT))[h * TABW + tid_o];
    const int klo = (n == 0) ? 128 : 0;
    BgCopy bgc; if (cu >= 0) bg_load(A, cu, tid_o, bgc);
#pragma unroll
    for (int i = 0; i < 8; ++i) {
        const int inst = wave * 8 + i, row0 = 4 * inst;
        if (row0 >= klo) {
            const int row = row0 + g4, ch = l15 ^ (((row & 3) << 2) | ((row >> 2) & 3));
            const int t = (((n - 1) * 128 + row) << dsh) + r;
            const size_t eoff = ((size_t)(b * 2048 + t) * DQKV + h * 128) + ch * 8;
            __builtin_amdgcn_global_load_lds((const unsigned*)(Kb + eoff), (LAS unsigned*)(F.lds + AT_K + inst * 1024), 16, 0, 0);
            __builtin_amdgcn_global_load_lds((const unsigned*)(Vb + eoff), (LAS unsigned*)(F.lds + AT_V + inst * 1024), 16, 0, 0);
        }
    }
    const int qi = 16 * wave + l15, tq = ((n * 128 + qi) << dsh) + r;
    const size_t qrow = (size_t)(b * 2048 + tq);
    bf16x8 qf[4];
#pragma unroll
    for (int s = 0; s < 4; ++s) qf[s] = *(const bf16x8*)(Qb + qrow * DQKV + h * 128 + 32 * s + 8 * g4);
    VM_WAIT(); __syncthreads();
    if (cu >= 0) bg_store(A, cu, tid_o, bgc);
    const int kb0 = 32 * (wave >> 1);
    f32x4 sc[5][2];
#pragma unroll
    for (int ss = 0; ss < 5; ++ss) {
        const int kb = kb0 + 32 * ss;
        if (kb < klo) { sc[ss][0] = (f32x4){-INFINITY, -INFINITY, -INFINITY, -INFINITY}; sc[ss][1] = sc[ss][0]; continue; }
#pragma unroll
        for (int t = 0; t < 2; ++t) {
            const unsigned key = kb + 8 * (l15 >> 2) + 4 * t + (l15 & 3);
            f32x4 acc = (f32x4){0.f, 0.f, 0.f, 0.f};
#pragma unroll
            for (int s = 0; s < 4; ++s) { const bf16x8 a = *(const LAS bf16x8*)(F.lds + AT_K + off_b(key, 4 * s + g4)); acc = __builtin_amdgcn_mfma_f32_16x16x32_bf16(a, qf[s], acc, 0, 0, 0); }
            const int d0 = qi + 128 - (kb + 8 * g4 + 4 * t) + 31;
#pragma unroll
            for (int e = 0; e < 4; ++e) acc[e] += TAB[d0 - e];
            sc[ss][t] = acc;
        }
    }
    float mx = -INFINITY;
#pragma unroll
    for (int ss = 0; ss < 5; ++ss)
#pragma unroll
        for (int t = 0; t < 2; ++t)
#pragma unroll
            for (int e = 0; e < 4; ++e) mx = fmaxf(mx, sc[ss][t][e]);
    mx = fmaxf(mx, __shfl_xor(mx, 16)); mx = fmaxf(mx, __shfl_xor(mx, 32));
    float sum = 0.f; bf16x8 pf[5];
#pragma unroll
    for (int ss = 0; ss < 5; ++ss) {
        float p[8];
#pragma unroll
        for (int t = 0; t < 2; ++t)
#pragma unroll
            for (int e = 0; e < 4; ++e) { p[4 * t + e] = __builtin_amdgcn_exp2f(sc[ss][t][e] - mx); sum += p[4 * t + e]; }
        v4u w; w.x = cvtpk(p[0], p[1]); w.y = cvtpk(p[2], p[3]); w.z = cvtpk(p[4], p[5]); w.w = cvtpk(p[6], p[7]);
        pf[ss] = __builtin_bit_cast(bf16x8, w);
    }
    sum += __shfl_xor(sum, 16); sum += __shfl_xor(sum, 32);
    const float inv = 1.0f / sum;
    const unsigned q4 = l15 >> 2, p4 = lane & 3;
#pragma unroll
    for (int c = 0; c < 8; ++c) {
        f32x4 acc = (f32x4){0.f, 0.f, 0.f, 0.f};
#pragma unroll
        for (int ss = 0; ss < 5; ++ss) {
            const int kb = kb0 + 32 * ss;
            if (kb < klo) continue;
            const unsigned a0 = AT_V + off_b(kb + 8 * g4 + q4, 2 * c + (p4 >> 1)) + 8 * (p4 & 1);
            const unsigned a1 = AT_V + off_b(kb + 8 * g4 + 4 + q4, 2 * c + (p4 >> 1)) + 8 * (p4 & 1);
            const v4i16_t lo = __builtin_amdgcn_ds_read_tr16_b64_v4i16((LAS v4i16_t*)(F.lds + a0));
            const v4i16_t hi = __builtin_amdgcn_ds_read_tr16_b64_v4i16((LAS v4i16_t*)(F.lds + a1));
            const bf16x8 vf = (bf16x8){lo[0], lo[1], lo[2], lo[3], hi[0], hi[1], hi[2], hi[3]};
            acc = __builtin_amdgcn_mfma_f32_16x16x32_bf16(vf, pf[ss], acc, 0, 0, 0);
        }
        acc = acc * inv;
        u32x2 w; w.x = cvtpk(acc[0], acc[1]); w.y = cvtpk(acc[2], acc[3]);
        *(u32x2*)(Ob + qrow * DQKV + h * 128 + 16 * c + 4 * g4) = w;
    }
    if (g4 == 0) LSE[qrow * NHEAD + h] = (mx + __builtin_amdgcn_logf(sum)) * LN2;
    __syncthreads();
}

struct AUnit { int b, h, dsh, r, n, klo; };
__device__ __forceinline__ AUnit attn_decode(int u) { AUnit d; d.b = u / 192; const int rem = u % 192; d.h = rem >> 4; const int x = rem & 15, g = d.h >> 2; d.dsh = 2 * g; const int dil = 1 << d.dsh; d.r = x & (dil - 1); d.n = x >> d.dsh; d.klo = (d.n == 0) ? 128 : 0; return d; }
__device__ __forceinline__ void attn_dma_tile(const Frame& F, const bf16* base, const AUnit& d, int lds_off, int wave, int l15, int g4) {
#pragma unroll
    for (int i = 0; i < 8; ++i) {
        const int inst = wave * 8 + i, row0 = 4 * inst;
        if (row0 >= d.klo) {
            const int row = row0 + g4, ch = l15 ^ (((row & 3) << 2) | ((row >> 2) & 3));
            const int t = (((d.n - 1) * 128 + row) << d.dsh) + d.r;
            const size_t eoff = ((size_t)(d.b * 2048 + t) * DQKV + d.h * 128) + ch * 8;
            __builtin_amdgcn_global_load_lds((const unsigned*)(base + eoff), (LAS unsigned*)(F.lds + lds_off + inst * 1024), 16, 0, 0);
        }
    }
}
__device__ __forceinline__ void attn_prompt_wg(const Frame& F, const Args& A, int u0, int ustride) {
    unsigned char* ws = A.ws;
    const bf16* Qb = (const bf16*)(ws + WS_Q); const bf16* Kb = (const bf16*)(ws + WS_K); const bf16* Vb = (const bf16*)(ws + WS_V);
    bf16* Ob = (bf16*)(ws + WS_O); float* LSE = (float*)(ws + WS_LSE); const float* BT = (const float*)(ws + WS_BT);
    if (u0 >= 1536) return;
    int tid_o = F.tid; asm volatile("" : "+v"(tid_o));
    const int lane = tid_o & 63, wave = F.wave, l15 = lane & 15, g4 = lane >> 4;
    constexpr int TABC = 196;
    LAS float* TAB2 = (LAS float*)(F.lds + SCR_OFF + 8192);
    int u = u0, pb = 0;
    AUnit d = attn_decode(u);
    bf16x8 qf[4];
    {
        attn_dma_tile(F, Kb, d, AT_K, wave, l15, g4);
        const int qi = 16 * wave + l15, tq = ((d.n * 128 + qi) << d.dsh) + d.r; const size_t qrow = (size_t)(d.b * 2048 + tq);
#pragma unroll
        for (int s2 = 0; s2 < 4; ++s2) qf[s2] = *(const bf16x8*)(Qb + qrow * DQKV + d.h * 128 + 32 * s2 + 8 * g4);
        if (tid_o < TABW) { const float tv0 = BT[d.h * TABW + tid_o];
#pragma unroll
            for (int sh = 0; sh < 4; ++sh) if (tid_o >= sh) TAB2[sh * TABC + tid_o - sh] = tv0; }
        VM_WAIT(); __syncthreads();
    }
#pragma unroll 1
    for (;;) {
        const LAS float* TAB = TAB2 + pb * (4 * TABC);
        const int klo = d.klo;
        const int qi = 16 * wave + l15, tq = ((d.n * 128 + qi) << d.dsh) + d.r; const size_t qrow = (size_t)(d.b * 2048 + tq);
        attn_dma_tile(F, Vb, d, AT_V, wave, l15, g4);
        const int kb0 = 32 * (wave >> 1);
        f32x4 sc[5][2];
#pragma unroll
        for (int ss = 0; ss < 5; ++ss) {
            const int kb = kb0 + 32 * ss;
            if (kb < klo) { sc[ss][0] = (f32x4){-INFINITY, -INFINITY, -INFINITY, -INFINITY}; sc[ss][1] = sc[ss][0]; continue; }
#pragma unroll
            for (int t = 0; t < 2; ++t) {
                const unsigned key = kb + 8 * (l15 >> 2) + 4 * t + (l15 & 3);
                f32x4 acc = (f32x4){0.f, 0.f, 0.f, 0.f};
#pragma unroll
                for (int s2 = 0; s2 < 4; ++s2) { const bf16x8 a = *(const LAS bf16x8*)(F.lds + AT_K + off_b(key, 4 * s2 + g4)); acc = __builtin_amdgcn_mfma_f32_16x16x32_bf16(a, qf[s2], acc, 0, 0, 0); }
                const int a0 = qi + 128 - (kb + 8 * g4 + 4 * t) + 31 - 3;
                const f32x4 tb = *(const LAS f32x4*)(TAB + (a0 & 3) * TABC + (a0 & ~3));
#pragma unroll
                for (int e = 0; e < 4; ++e) acc[e] += tb[3 - e];
                sc[ss][t] = acc;
            }
        }
        float mx = -INFINITY;
#pragma unroll
        for (int ss = 0; ss < 5; ++ss)
#pragma unroll
            for (int t = 0; t < 2; ++t)
#pragma unroll
                for (int e = 0; e < 4; ++e) mx = fmaxf(mx, sc[ss][t][e]);
        mx = fmaxf(mx, __shfl_xor(mx, 16)); mx = fmaxf(mx, __shfl_xor(mx, 32));
        float sum = 0.f; bf16x8 pf[5];
#pragma unroll
        for (int ss = 0; ss < 5; ++ss) {
            float pv[8];
#pragma unroll
            for (int t = 0; t < 2; ++t)
#pragma unroll
                for (int e = 0; e < 4; ++e) { pv[4 * t + e] = __builtin_amdgcn_exp2f(sc[ss][t][e] - mx); sum += pv[4 * t + e]; }
            v4u w; w.x = cvtpk(pv[0], pv[1]); w.y = cvtpk(pv[2], pv[3]); w.z = cvtpk(pv[4], pv[5]); w.w = cvtpk(pv[6], pv[7]);
            pf[ss] = __builtin_bit_cast(bf16x8, w);
        }
        sum += __shfl_xor(sum, 16); sum += __shfl_xor(sum, 32);
        const float inv = 1.0f / sum;
        VM_WAIT(); __syncthreads();
        const int un = u + ustride; const bool has_next = un < 1536;
        AUnit dn = d; bf16x8 qn[4]; float tabn = 0.f;
        if (has_next) {
            dn = attn_decode(un);
            attn_dma_tile(F, Kb, dn, AT_K, wave, l15, g4);
            const int tqn = ((dn.n * 128 + qi) << dn.dsh) + dn.r; const size_t qrn = (size_t)(dn.b * 2048 + tqn);
#pragma unroll
            for (int s2 = 0; s2 < 4; ++s2) qn[s2] = *(const bf16x8*)(Qb + qrn * DQKV + dn.h * 128 + 32 * s2 + 8 * g4);
            if (tid_o < TABW) tabn = BT[dn.h * TABW + tid_o];
        }
        const unsigned q4 = l15 >> 2, p4 = lane & 3;
        v4u wq = (v4u){0u, 0u, 0u, 0u};
#pragma unroll
        for (int c = 0; c < 8; ++c) {
            f32x4 acc = (f32x4){0.f, 0.f, 0.f, 0.f};
#pragma unroll
            for (int ss = 0; ss < 5; ++ss) {
                const int kb = kb0 + 32 * ss;
                if (kb < klo) continue;
                const unsigned a0 = AT_V + off_b(kb + 8 * g4 + q4, 4 * (c >> 1) + p4) + 8 * (c & 1);
                const unsigned a1 = AT_V + off_b(kb + 8 * g4 + 4 + q4, 4 * (c >> 1) + p4) + 8 * (c & 1);
                const v4i16_t lo = __builtin_amdgcn_ds_read_tr16_b64_v4i16((LAS v4i16_t*)(F.lds + a0));
                const v4i16_t hi = __builtin_amdgcn_ds_read_tr16_b64_v4i16((LAS v4i16_t*)(F.lds + a1));
                const bf16x8 vf = (bf16x8){lo[0], lo[1], lo[2], lo[3], hi[0], hi[1], hi[2], hi[3]};
                acc = __builtin_amdgcn_mfma_f32_16x16x32_bf16(vf, pf[ss], acc, 0, 0, 0);
            }
            acc = acc * inv;
            if ((c & 1) == 0) { wq.x = cvtpk(acc[0], acc[1]); wq.y = cvtpk(acc[2], acc[3]); }
            else { wq.z = cvtpk(acc[0], acc[1]); wq.w = cvtpk(acc[2], acc[3]); *(v4u*)(Ob + qrow * DQKV + d.h * 128 + 32 * (c >> 1) + 8 * g4) = wq; }
        }
        if (g4 == 0) LSE[(size_t)(d.b * NHEAD + d.h) * 2048 + d.r * (2048 >> d.dsh) + d.n * 128 + qi] = (mx + __builtin_amdgcn_logf(sum)) * LN2;
        asm volatile("" ::: "memory");
        if (has_next && tid_o < TABW) {
#pragma unroll
            for (int sh = 0; sh < 4; ++sh) if (tid_o >= sh) TAB2[(pb ^ 1) * (4 * TABC) + sh * TABC + tid_o - sh] = tabn; }
        VM_WAIT(); __syncthreads();
        if (!has_next) break;
        u = un; d = dn; pb ^= 1;
#pragma unroll
        for (int s2 = 0; s2 < 4; ++s2) qf[s2] = qn[s2];
    }
}

constexpr int LR_XCF = 0, LR_XCB = 65536, LR_PPL = 98304;
__device__ __forceinline__ void lru_item(const Frame& F, const Args& A, int it, int cu) {
    unsigned char* ws = A.ws;
    const bf16* XA = (const bf16*)(ws + WS_XA);
    const bool prompt = it < 1024;
    const int n = it & 7; int b = 0, c = 0, cs = 0;
    if (prompt) { c = it >> 6; b = (it >> 3) & 7; } else cs = (it - 1024) >> 3;
    const int m0 = prompt ? b * 2048 + c * 128 : MP + cs * 128, cidx = prompt ? b * 16 + c : 128 + cs;
    int tid = F.tid; asm volatile("" : "+v"(tid));
    const int lane = tid & 63, wave = F.wave, l15 = lane & 15, g4 = lane >> 4;
    LAS float* XCF = (LAS float*)(F.lds + LR_XCF);
    LAS bf16* PPL = (LAS bf16*)(F.lds + LR_PPL);
    BgCopy bgc; if (cu >= 0) bg_load(A, 2 * cu, tid, bgc);
    {
        const int tg = tid >> 4, c8 = tid & 15, ch0 = n * 128 + 8 * c8;
        float xin[7][8];
#pragma unroll
        for (int j = 0; j < 7; ++j) {
            const int trel = 4 * tg - 3 + j;
            const bool from_xa = prompt ? (c * 128 + trel >= 0) : (((tg & 1) != 0) || j >= 3);
            if (from_xa) { const v4u w = *(const v4u*)(XA + (size_t)(m0 + trel) * 1024 + ch0);
                xin[j][0] = bflo(w.x); xin[j][1] = bfhi(w.x); xin[j][2] = bflo(w.y); xin[j][3] = bfhi(w.y); xin[j][4] = bflo(w.z); xin[j][5] = bfhi(w.z); xin[j][6] = bflo(w.w); xin[j][7] = bfhi(w.w); }
            else if (!prompt) { const int db = (cs * 128 + 4 * tg) >> 3; const float* sp = A.in[5] + ((size_t)db * 3 + j) * 1024 + ch0; const f32x4 a = *(const f32x4*)sp, bq = *(const f32x4*)(sp + 4);
                xin[j][0] = a[0]; xin[j][1] = a[1]; xin[j][2] = a[2]; xin[j][3] = a[3]; xin[j][4] = bq[0]; xin[j][5] = bq[1]; xin[j][6] = bq[2]; xin[j][7] = bq[3]; }
            else {
#pragma unroll
                for (int e = 0; e < 8; ++e) xin[j][e] = 0.f; }
        }
        float cw[4][8], cb[8];
#pragma unroll
        for (int jj = 0; jj < 4; ++jj) { const f32x4 a = *(const f32x4*)(A.in[10] + jj * 1024 + ch0), bq = *(const f32x4*)(A.in[10] + jj * 1024 + ch0 + 4);
            cw[jj][0] = a[0]; cw[jj][1] = a[1]; cw[jj][2] = a[2]; cw[jj][3] = a[3]; cw[jj][4] = bq[0]; cw[jj][5] = bq[1]; cw[jj][6] = bq[2]; cw[jj][7] = bq[3]; }
        { const f32x4 a = *(const f32x4*)(A.in[11] + ch0), bq = *(const f32x4*)(A.in[11] + ch0 + 4); cb[0] = a[0]; cb[1] = a[1]; cb[2] = a[2]; cb[3] = a[3]; cb[4] = bq[0]; cb[5] = bq[1]; cb[6] = bq[2]; cb[7] = bq[3]; }
#pragma unroll
        for (int i = 0; i < 4; ++i) {
            float y[8];
#pragma unroll
            for (int e = 0; e < 8; ++e) y[e] = cb[e] + ((cw[0][e] * xin[i][e] + cw[1][e] * xin[i + 1][e]) + (cw[2][e] * xin[i + 2][e] + cw[3][e] * xin[i + 3][e]));
            const int tok = 4 * tg + i;
            *(LAS f32x4*)(XCF + tok * 128 + 8 * c8) = (f32x4){y[0], y[1], y[2], y[3]};
            *(LAS f32x4*)(XCF + tok * 128 + 8 * c8 + 4) = (f32x4){y[4], y[5], y[6], y[7]};
            v4u w; w.x = cvtpk(y[0], y[1]); w.y = cvtpk(y[2], y[3]); w.z = cvtpk(y[4], y[5]); w.w = cvtpk(y[6], y[7]);
            *(LAS v4u*)(F.lds + LR_XCB + off_b(tok, c8)) = w;
        }
    }
    const int chl = 16 * wave + l15, ch = n * 128 + chl;
    bf16x8 wa[4], wx[4];
    {
        const bf16* WA = (const bf16*)(ws + WS_WA) + n * 16384 + chl * 128 + 8 * g4; const bf16* WX = (const bf16*)(ws + WS_WX) + n * 16384 + chl * 128 + 8 * g4;
#pragma unroll
        for (int s = 0; s < 4; ++s) { wa[s] = *(const bf16x8*)(WA + 32 * s); wx[s] = *(const bf16x8*)(WX + 32 * s); }
    }
    const float ba = A.in[13][ch], bx = A.in[15][ch];
    const float lam = A.in[16][ch];
    const float sp8 = -8.0f * log1pf(expf(-lam));
    __syncthreads();
    if (cu >= 0) { bg_store(A, 2 * cu, tid, bgc); bg_load(A, 2 * cu + 1, tid, bgc); }
    float Hin = 0.f, Pin = 1.f;
#pragma unroll 1
    for (int tb = 0; tb < 8; ++tb) {
        if (tb == 4 && cu >= 0) bg_store(A, 2 * cu + 1, tid, bgc);
        f32x4 ga = (f32x4){0.f, 0.f, 0.f, 0.f}, gx = ga;
#pragma unroll
        for (int s = 0; s < 4; ++s) {
            const bf16x8 a = *(const LAS bf16x8*)(F.lds + LR_XCB + off_b(16 * tb + l15, 4 * s + g4));
            ga = __builtin_amdgcn_mfma_f32_16x16x32_bf16(a, wa[s], ga, 0, 0, 0);
            gx = __builtin_amdgcn_mfma_f32_16x16x32_bf16(a, wx[s], gx, 0, 0, 0);
        }
        float av[4], uv[4];
#pragma unroll
        for (int e = 0; e < 4; ++e) {
            const int tok = 16 * tb + 4 * g4 + e;
            const float rr = pg8::sigmoid_f(ga[e] + ba), ii = pg8::sigmoid_f(gx[e] + bx);
            const float la = sp8 * rr;
            float a = __builtin_amdgcn_exp2f(la * LOG2E);
            const float x2 = 2.0f * la;
            const float tay = -x2 * (1.0f + x2 * (0.5f + x2 * (0.16666667f + x2 * (0.041666668f + x2 * (0.0083333338f + x2 * 0.0013888889f)))));
            const float om = (x2 > -0.25f) ? tay : (1.0f - __builtin_amdgcn_exp2f(x2 * LOG2E));
            const float mult = __builtin_amdgcn_sqrtf(om);
            float uu = mult * (ii * XCF[tok * 128 + chl]);
            if (!prompt && e == 0 && (g4 & 1) == 0) { const int db = (cs * 128 + tok) >> 3; uu = a * A.in[6][(size_t)db * 1024 + ch] + uu; a = 0.f; }
            av[e] = a; uv[e] = uu;
        }
        float Ac[4], Uc[4];
        Ac[0] = av[0]; Uc[0] = uv[0];
#pragma unroll
        for (int e = 1; e < 4; ++e) { Ac[e] = av[e] * Ac[e - 1]; Uc[e] = av[e] * Uc[e - 1] + uv[e]; }
        float hst = Hin, pst = Pin, hrun = Hin, prun = Pin;
#pragma unroll
        for (int gg = 0; gg < 4; ++gg) {
            const float ar = __shfl(Ac[3], l15 + 16 * gg), ur = __shfl(Uc[3], l15 + 16 * gg);
            if (g4 == gg) { hst = hrun; pst = prun; }
            hrun = ar * hrun + ur; prun = ar * prun;
        }
        Hin = hrun; Pin = prun;
#pragma unroll
        for (int e = 0; e < 4; ++e) {
            const int tok = 16 * tb + 4 * g4 + e;
            const float hh = Ac[e] * hst + Uc[e], pp = Ac[e] * pst;
            if (prompt) {
                XCF[tok * 128 + chl] = hh;
                PPL[tok * 128 + chl] = (bf16)(cvtpk(pp, 0.f) & 0xffffu);
            } else {
                const size_t o1 = (size_t)(m0 + tok) * 1024 + ch;
                const float sg = pg8::silu_f(__uint_as_float((unsigned)((const bf16*)(ws + WS_SGA))[o1] << 16));
                pg8::st_wt2((unsigned short*)(ws + WS_ACAT) + (size_t)(m0 + tok) * KCAT + ch, cvtpk(hh * sg, 0.f) & 0xffffu);
                if (e == 3 && (g4 & 1) == 1) { const int db = (cs * 128 + tok) >> 3; A.out[O_HS + (size_t)db * 1024 + ch] = hh; }
            }
        }
    }
    if (!prompt) { __syncthreads(); return; }
    typedef float f32x2_ __attribute__((ext_vector_type(2)));
    f32x2_* AGG = (f32x2_*)(ws + WS_PEND);
    unsigned* FLG = (unsigned*)(ws + WS_CTL) + CW_LFLAG;
    if (g4 == 0) __hip_atomic_store((unsigned long long*)(AGG + cidx * 1024 + ch), ((unsigned long long)__float_as_uint(Hin) << 32) | __float_as_uint(Pin), RLX_AGENT);
    const int tg = tid >> 4, c8 = tid & 15;
    v4u sg4[4];
#pragma unroll
    for (int i = 0; i < 4; ++i) sg4[i] = *(const v4u*)((const bf16*)(ws + WS_SGA) + (size_t)(m0 + 4 * tg + i) * 1024 + n * 128 + 8 * c8);
    VM_WAIT(); __syncthreads();
    if (tid == 0) __hip_atomic_store(FLG + it, 1u, RLX_AGENT);
    float Hc = 0.f;
    if (c > 0) {
        if (wave == 0) {
            unsigned* barw = (unsigned*)(ws + WS_CTL) + CW_BAR; unsigned sp = 0;
            const int cc = lane < c ? lane : 0;
            for (;;) {
                const bool ok = (lane >= c) || (xb_ld(FLG + (cc * 64 + b * 8 + n)) != 0u);
                if (__all(ok)) break;
                __builtin_amdgcn_s_sleep(1);
                if ((++sp & 1023u) == 0u) { if (xb_ld(&barw[XB_TMO])) break; if (sp > (1u << 22)) { atomicAdd(&barw[XB_TMO], 1u); break; } }
            }
        }
        __syncthreads();
        f32x2_ ag[4];
#pragma unroll
        for (int k = 0; k < 4; ++k) { const int cc = g4 + 4 * k; ag[k] = (f32x2_){1.f, 0.f};
            if (cc < c) { const unsigned long long w = __hip_atomic_load((unsigned long long*)(AGG + (b * 16 + cc) * 1024 + ch), RLX_AGENT); ag[k] = (f32x2_){__uint_as_float((unsigned)w), __uint_as_float((unsigned)(w >> 32))}; } }
#pragma unroll
        for (int cc = 0; cc < 15; ++cc) {
            const float pc = __shfl(ag[cc >> 2][0], l15 + 16 * (cc & 3)), hc = __shfl(ag[cc >> 2][1], l15 + 16 * (cc & 3));
            if (cc < c) Hc = pc * Hc + hc;
        }
    }
    if (c == 15 && g4 == 0) A.out[O_HP + (size_t)b * 1024 + ch] = Pin * Hc + Hin;
    LAS float* HCL = (LAS float*)(F.lds + SCR_OFF);
    if (g4 == 0) HCL[chl] = Hc;
    __syncthreads();
    {
        const f32x4 h0 = *(const LAS f32x4*)(HCL + 8 * c8), h1 = *(const LAS f32x4*)(HCL + 8 * c8 + 4);
#pragma unroll
        for (int i = 0; i < 4; ++i) {
            const int tok = 4 * tg + i;
            const f32x4 l0 = *(const LAS f32x4*)(XCF + tok * 128 + 8 * c8), l1 = *(const LAS f32x4*)(XCF + tok * 128 + 8 * c8 + 4);
            const v4u pw = *(const LAS v4u*)(PPL + tok * 128 + 8 * c8); const v4u sw = sg4[i];
            v4u w;
            w.x = cvtpk((l0[0] + bflo(pw.x) * h0[0]) * silu_lo(sw.x), (l0[1] + bfhi(pw.x) * h0[1]) * silu_hi(sw.x));
            w.y = cvtpk((l0[2] + bflo(pw.y) * h0[2]) * silu_lo(sw.y), (l0[3] + bfhi(pw.y) * h0[3]) * silu_hi(sw.y));
            w.z = cvtpk((l1[0] + bflo(pw.z) * h1[0]) * silu_lo(sw.z), (l1[1] + bfhi(pw.z) * h1[1]) * silu_hi(sw.z));
            w.w = cvtpk((l1[2] + bflo(pw.w) * h1[2]) * silu_lo(sw.w), (l1[3] + bfhi(pw.w) * h1[3]) * silu_hi(sw.w));
            *(v4u*)((bf16*)(ws + WS_ACAT) + (size_t)(m0 + tok) * KCAT + n * 128 + 8 * c8) = w;
        }
    }
    __syncthreads();
}

__device__ __forceinline__ void lru_prompt_wg(const Frame& F, const Args& A, int w) {
    unsigned char* ws = A.ws;
    const bf16* XA = (const bf16*)(ws + WS_XA);
    const int n = w & 7, b = (w >> 3) & 7, c0 = w >> 6;
    int tid0 = F.tid; asm volatile("" : "+v"(tid0)); const int tid = tid0;
    const int lane = tid & 63, wave = F.wave, l15 = lane & 15, g4 = lane >> 4;
    const int tg = tid >> 4, c8 = tid & 15, ch0 = n * 128 + 8 * c8;
    LAS float* XCF = (LAS float*)(F.lds + LR_XCF);
    LAS bf16* PPL = (LAS bf16*)(F.lds + LR_PPL);
    LAS float* HCL = (LAS float*)(F.lds + SCR_OFF);
    typedef float f32x2_ __attribute__((ext_vector_type(2)));
    f32x2_* AGG = (f32x2_*)(ws + WS_PEND);
    unsigned* FLG = (unsigned*)(ws + WS_CTL) + CW_LFLAG;
    LAS float* CWL = (LAS float*)(F.lds + SCR_OFF + 1024);
    for (int i = tid; i < 640; i += 512) CWL[i] = (i < 512) ? A.in[10][(i >> 7) * 1024 + n * 128 + (i & 127)] : A.in[11][n * 128 + (i - 512)];
    __syncthreads();
    const int chl = 16 * wave + l15, ch = n * 128 + chl;
    bf16x8 wa[4], wx[4];
    {
        const bf16* WA = (const bf16*)(ws + WS_WA) + n * 16384 + chl * 128 + 8 * g4; const bf16* WX = (const bf16*)(ws + WS_WX) + n * 16384 + chl * 128 + 8 * g4;
#pragma unroll
        for (int s2 = 0; s2 < 4; ++s2) { wa[s2] = *(const bf16x8*)(WA + 32 * s2); wx[s2] = *(const bf16x8*)(WX + 32 * s2); }
    }
    const float ba = A.in[13][ch], bx = A.in[15][ch];
    const float sp8 = -8.0f * log1pf(expf(-A.in[16][ch]));
    v4u xr[7];
    {
        const int m0 = b * 2048 + c0 * 128;
#pragma unroll
        for (int j = 0; j < 7; ++j) { const int trel = 4 * tg - 3 + j; const bool ok = (c0 * 128 + trel >= 0); xr[j] = *(const v4u*)(XA + (size_t)(m0 + (ok ? trel : 0)) * 1024 + ch0); if (!ok) xr[j] = (v4u){0u, 0u, 0u, 0u}; }
    }
#pragma unroll 1
    for (int k = 0; k < 4; ++k) {
        const int c = c0 + 4 * k, it = c * 64 + b * 8 + n, m0 = b * 2048 + c * 128, cidx = b * 16 + c;
        int tid = tid0; asm volatile("" : "+v"(tid));
        const int lane = tid & 63, l15 = lane & 15, g4 = lane >> 4, tg = tid >> 4, c8 = tid & 15, ch0 = n * 128 + 8 * c8, chl = 16 * wave + l15, ch = n * 128 + chl;
        {
            float cw[4][8], cb[8];
#pragma unroll
            for (int jj = 0; jj < 5; ++jj) { const f32x4 a = *(const LAS f32x4*)(CWL + jj * 128 + 8 * c8), bq = *(const LAS f32x4*)(CWL + jj * 128 + 8 * c8 + 4);
                float* d = (jj < 4) ? cw[jj < 4 ? jj : 0] : cb;
                d[0] = a[0]; d[1] = a[1]; d[2] = a[2]; d[3] = a[3]; d[4] = bq[0]; d[5] = bq[1]; d[6] = bq[2]; d[7] = bq[3]; }
            float xin[7][8];
#pragma unroll
            for (int j = 0; j < 7; ++j) { const v4u wv = xr[j];
                xin[j][0] = bflo(wv.x); xin[j][1] = bfhi(wv.x); xin[j][2] = bflo(wv.y); xin[j][3] = bfhi(wv.y); xin[j][4] = bflo(wv.z); xin[j][5] = bfhi(wv.z); xin[j][6] = bflo(wv.w); xin[j][7] = bfhi(wv.w); }
#pragma unroll
            for (int i = 0; i < 4; ++i) {
                float y[8];
#pragma unroll
                for (int e = 0; e < 8; ++e) y[e] = cb[e] + ((cw[0][e] * xin[i][e] + cw[1][e] * xin[i + 1][e]) + (cw[2][e] * xin[i + 2][e] + cw[3][e] * xin[i + 3][e]));
                const int tok = 4 * tg + i;
                *(LAS f32x4*)(XCF + tok * 128 + 8 * c8) = (f32x4){y[0], y[1], y[2], y[3]};
                *(LAS f32x4*)(XCF + tok * 128 + 8 * c8 + 4) = (f32x4){y[4], y[5], y[6], y[7]};
                v4u wv; wv.x = cvtpk(y[0], y[1]); wv.y = cvtpk(y[2], y[3]); wv.z = cvtpk(y[4], y[5]); wv.w = cvtpk(y[6], y[7]);
                *(LAS v4u*)(F.lds + LR_XCB + off_b(tok, c8)) = wv;
            }
        }
        v4u sg4[4];
        __syncthreads();
        BgHalf bgc; bg2h_load(A, it, 0, tid, bgc);
        float Hin = 0.f, Pin = 1.f;
#pragma unroll 4
        for (int tb = 0; tb < 8; ++tb) {
            if (tb == 2) { bg2h_store(A, it, 0, tid, bgc); bg2h_load(A, it, 1, tid, bgc); }
            if (tb == 5) {
                bg2h_store(A, it, 1, tid, bgc);
                if (k < 3) {
                    const int m1 = m0 + 512;
#pragma unroll
                    for (int j = 0; j < 7; ++j) xr[j] = *(const v4u*)(XA + (size_t)(m1 + 4 * tg - 3 + j) * 1024 + ch0);
                }
#pragma unroll
                for (int i = 0; i < 4; ++i) sg4[i] = __builtin_nontemporal_load((const v4u*)((const bf16*)(ws + WS_SGA) + (size_t)(m0 + 4 * tg + i) * 1024 + n * 128 + 8 * c8));
            }
            f32x4 ga = (f32x4){0.f, 0.f, 0.f, 0.f}, gx = ga;
#pragma unroll
            for (int s2 = 0; s2 < 4; ++s2) {
                const bf16x8 a = *(const LAS bf16x8*)(F.lds + LR_XCB + off_b(16 * tb + l15, 4 * s2 + g4));
                ga = __builtin_amdgcn_mfma_f32_16x16x32_bf16(a, wa[s2], ga, 0, 0, 0);
                gx = __builtin_amdgcn_mfma_f32_16x16x32_bf16(a, wx[s2], gx, 0, 0, 0);
            }
            float Ac[4], Uc[4];
#pragma unroll
            for (int e = 0; e < 4; ++e) {
                const int tok = 16 * tb + 4 * g4 + e;
                const float rr = pg8::sigmoid_f(ga[e] + ba), ii = pg8::sigmoid_f(gx[e] + bx);
                const float la = sp8 * rr;
                const float a = __builtin_amdgcn_exp2f(la * LOG2E);
                const float x2 = 2.0f * la;
                const float tay = -x2 * (1.0f + x2 * (0.5f + x2 * (0.16666667f + x2 * (0.041666668f + x2 * (0.0083333338f + x2 * 0.0013888889f)))));
                const float om = (x2 > -0.25f) ? tay : (1.0f - __builtin_amdgcn_exp2f(x2 * LOG2E));
                const float uu = __builtin_amdgcn_sqrtf(om) * (ii * XCF[tok * 128 + chl]);
                if (e == 0) { Ac[0] = a; Uc[0] = uu; } else { Ac[e] = a * Ac[e - 1]; Uc[e] = a * Uc[e - 1] + uu; }
            }
            float hst = Hin, pst = Pin, hrun = Hin, prun = Pin;
#pragma unroll
            for (int gg = 0; gg < 4; ++gg) {
                const float ar = __shfl(Ac[3], l15 + 16 * gg), ur = __shfl(Uc[3], l15 + 16 * gg);
                if (g4 == gg) { hst = hrun; pst = prun; }
                hrun = ar * hrun + ur; prun = ar * prun;
            }
            Hin = hrun; Pin = prun;
#pragma unroll
            for (int e = 0; e < 4; ++e) {
                const int tok = 16 * tb + 4 * g4 + e;
                XCF[tok * 128 + chl] = Ac[e] * hst + Uc[e];
                PPL[tok * 128 + chl] = (bf16)(cvtpk(Ac[e] * pst, 0.f) & 0xffffu);
            }
        }
        if (g4 == 0) __hip_atomic_store((unsigned long long*)(AGG + cidx * 1024 + ch), ((unsigned long long)__float_as_uint(Hin) << 32) | __float_as_uint(Pin), RLX_AGENT);
        VM_WAIT(); __syncthreads();
        if (tid == 0) __hip_atomic_store(FLG + it, 1u, RLX_AGENT);
        float Hc = 0.f;
        if (c > 0) {
            if (wave == 0) {
                unsigned* barw = (unsigned*)(ws + WS_CTL) + CW_BAR; unsigned sp = 0;
                const int cc = lane < c ? lane : 0;
                for (;;) {
                    const bool ok = (lane >= c) || (xb_ld(FLG + (cc * 64 + b * 8 + n)) != 0u);
                    if (__all(ok)) break;
                    __builtin_amdgcn_s_sleep(1);
                    if ((++sp & 1023u) == 0u) { if (xb_ld(&barw[XB_TMO])) break; if (sp > (1u << 22)) { atomicAdd(&barw[XB_TMO], 1u); break; } }
                }
            }
            __syncthreads();
            f32x2_ ag[4];
#pragma unroll
            for (int q = 0; q < 4; ++q) { const int cc = g4 + 4 * q; ag[q] = (f32x2_){1.f, 0.f};
                if (cc < c) { const unsigned long long wv = __hip_atomic_load((unsigned long long*)(AGG + (b * 16 + cc) * 1024 + ch), RLX_AGENT); ag[q] = (f32x2_){__uint_as_float((unsigned)wv), __uint_as_float((unsigned)(wv >> 32))}; } }
#pragma unroll
            for (int cc = 0; cc < 15; ++cc) {
                const float pc = __shfl(ag[cc >> 2][0], l15 + 16 * (cc & 3)), hc = __shfl(ag[cc >> 2][1], l15 + 16 * (cc & 3));
                if (cc < c) Hc = pc * Hc + hc;
            }
        }
        if (c == 15 && g4 == 0) A.out[O_HP + (size_t)b * 1024 + ch] = Pin * Hc + Hin;
        if (g4 == 0) HCL[chl] = Hc;
        __syncthreads();
        {
            const f32x4 h0 = *(const LAS f32x4*)(HCL + 8 * c8), h1 = *(const LAS f32x4*)(HCL + 8 * c8 + 4);
#pragma unroll
            for (int i = 0; i < 4; ++i) {
                const int tok = 4 * tg + i;
                const f32x4 l0 = *(const LAS f32x4*)(XCF + tok * 128 + 8 * c8), l1 = *(const LAS f32x4*)(XCF + tok * 128 + 8 * c8 + 4);
                const v4u pw = *(const LAS v4u*)(PPL + tok * 128 + 8 * c8); const v4u sw = sg4[i];
                v4u wv;
                wv.x = cvtpk((l0[0] + bflo(pw.x) * h0[0]) * silu_lo(sw.x), (l0[1] + bfhi(pw.x) * h0[1]) * silu_hi(sw.x));
                wv.y = cvtpk((l0[2] + bflo(pw.y) * h0[2]) * silu_lo(sw.y), (l0[3] + bfhi(pw.y) * h0[3]) * silu_hi(sw.y));
                wv.z = cvtpk((l1[0] + bflo(pw.z) * h1[0]) * silu_lo(sw.z), (l1[1] + bfhi(pw.z) * h1[1]) * silu_hi(sw.z));
                wv.w = cvtpk((l1[2] + bflo(pw.w) * h1[2]) * silu_lo(sw.w), (l1[3] + bfhi(pw.w) * h1[3]) * silu_hi(sw.w));
                *(v4u*)((bf16*)(ws + WS_ACAT) + (size_t)(m0 + tok) * KCAT + n * 128 + 8 * c8) = wv;
            }
        }
        __syncthreads();
    }
}

__device__ __forceinline__ float dpp_row_sum(float s) {
    s += __builtin_bit_cast(float, __builtin_amdgcn_update_dpp(0, __builtin_bit_cast(int, s), 0xB1, 0xF, 0xF, false));
    s += __builtin_bit_cast(float, __builtin_amdgcn_update_dpp(0, __builtin_bit_cast(int, s), 0x4E, 0xF, 0xF, false));
    s += __builtin_bit_cast(float, __builtin_amdgcn_update_dpp(0, __builtin_bit_cast(int, s), 0x141, 0xF, 0xF, false));
    s += __builtin_bit_cast(float, __builtin_amdgcn_update_dpp(0, __builtin_bit_cast(int, s), 0x140, 0xF, 0xF, false));
    return s;
}
template <int G, int RB, int COPY>
__device__ __forceinline__ void stream_load(f32x4 (&kv)[RB][4], const float* cache, const float* okv, int bi, int wave, int p, int lane, bool lastp) {
    constexpr int L = 128 << (2 * G);
    const int fo = (lane >> 4) * 32 + (lane & 15);
#pragma unroll
    for (int i = 0; i < RB; ++i) {
        const int slot = RB * bi + i;
        if (COPY == 0 && G == 2 && slot >= 8 && slot < 16) continue;
        if (slot < 16) {
            const int idx = (G == 0) ? wave + 8 * slot : (G == 1 ? 128 * p + (wave & 3) + 4 * (2 * slot + (wave >> 2)) : (COPY == 2 ? 128 * (p + (slot >> 3)) + wave + 16 * (slot & 7) : 128 * p + wave + 16 * (slot & 7) + (slot & 8)));
            const f32x4* rp = (const f32x4*)(cache + (size_t)idx * 1024) + fo;
            kv[i][0] = __builtin_nontemporal_load(rp); kv[i][1] = __builtin_nontemporal_load(rp + 16); kv[i][2] = __builtin_nontemporal_load(rp + 128); kv[i][3] = __builtin_nontemporal_load(rp + 144);
        } else if (slot == 16 && lastp) {
            const f32x4* rp = (const f32x4*)(okv + (size_t)(L + wave - 8) * 1024) + fo;
            kv[i][0] = rp[0]; kv[i][1] = rp[16]; kv[i][2] = rp[128]; kv[i][3] = rp[144];
        }
    }
}
template <int G, int RB, int NT, int COPY>
__device__ __forceinline__ void stream_proc(const f32x4 (&kv)[RB][4], float* okv, int bi, int wave, int p, int lane, bool lastp,
                                            const v4u (&qp)[NT], float (&m)[NT], float (&l)[NT], float (&o)[NT][8], const LAS float* bt) {
    constexpr int DSH = 2 * G, DIL = 1 << DSH, L = 128 * DIL;
    const int fo = (lane >> 4) * 32 + (lane & 15);
#pragma unroll
    for (int i = 0; i < RB; ++i) {
        const int slot = RB * bi + i;
        if (slot > 16 || (slot == 16 && !lastp)) continue;
        const int idx = (slot < 16) ? ((G == 0) ? wave + 8 * slot : (G == 1 ? 128 * p + (wave & 3) + 4 * (2 * slot + (wave >> 2)) : (COPY == 2 ? 128 * (p + (slot >> 3)) + wave + 16 * (slot & 7) : 128 * p + wave + 16 * (slot & 7) + (slot & 8)))) : L + wave;
        if (COPY && slot < 16 && idx >= 8) { f32x4* wp = (f32x4*)(okv + (size_t)(idx - 8) * 1024) + fo;
            __builtin_nontemporal_store(kv[i][0], wp); __builtin_nontemporal_store(kv[i][1], wp + 16); __builtin_nontemporal_store(kv[i][2], wp + 128); __builtin_nontemporal_store(kv[i][3], wp + 144); }
        if (G == 2 && COPY != 2 && slot >= 8 && slot < 16) continue;
#pragma unroll
        for (int ts = 0; ts < NT; ++ts) {
            const int t = (G == 0) ? ts : (G == 1 ? (wave & 3) + 4 * ts : wave);
            const int jn = L + t - idx;
            if (jn >= 0 && jn <= 128 * DIL) {
                const v4u w = qp[ts];
                float s = (bflo(w.x) * kv[i][0][0] + bfhi(w.x) * kv[i][0][1]) + (bflo(w.y) * kv[i][0][2] + bfhi(w.y) * kv[i][0][3])
                        + (bflo(w.z) * kv[i][1][0] + bfhi(w.z) * kv[i][1][1]) + (bflo(w.w) * kv[i][1][2] + bfhi(w.w) * kv[i][1][3]);
                s = dpp_row_sum(s) + bt[jn >> DSH];
                const float mn = fmaxf(m[ts], s), corr = __builtin_amdgcn_exp2f(m[ts] - mn), pw = __builtin_amdgcn_exp2f(s - mn);
                l[ts] = l[ts] * corr + pw; m[ts] = mn;
#pragma unroll
                for (int e = 0; e < 4; ++e) { o[ts][e] = o[ts][e] * corr + pw * kv[i][2][e]; o[ts][4 + e] = o[ts][4 + e] * corr + pw * kv[i][3][e]; }
            }
        }
    }
}
template <int G, int COPY>
__device__ __forceinline__ void stream_item(const Frame& F, const Args& A, int db, int p) {
    constexpr int DSH = 2 * G, DIL = 1 << DSH, L = 128 * DIL, NT = (G == 0) ? 8 : (G == 1 ? 2 : 1), NC = (G == 0) ? 8 : (G == 1 ? 2 : 1), NPART = L / 128;
    constexpr int RB = (G == 0) ? 2 : 4, NB = (17 + RB - 1) / RB;
    unsigned char* ws = A.ws;
    int tid = F.tid; asm volatile("" : "+v"(tid));
    const int lane = tid & 63, wave = F.wave, hh = lane >> 4, c4 = 4 * (lane & 15);
    const float* cache = A.in[2 + G] + (size_t)db * L * 1024;
    float* okv = A.out + (G == 0 ? O_KV128S : (G == 1 ? O_KV512S : O_KV2048S)) + (size_t)db * L * 1024;
    LAS float* TABS = (LAS float*)(F.lds + SCR_OFF + 4096);
    for (int i = tid; i < 4 * 129; i += 512) { const int h_ = i / 129, j_ = i - 129 * h_; TABS[h_ * 132 + j_] = ((const float*)(ws + WS_BT))[(G * 4 + h_) * TABW + 31 + j_]; }
    __syncthreads();
    const LAS float* bt = TABS + hh * 132;
    v4u qp[NT]; float m[NT], l[NT], o[NT][8];
#pragma unroll
    for (int ts = 0; ts < NT; ++ts) {
        const int t = (G == 0) ? ts : (G == 1 ? (wave & 3) + 4 * ts : wave);
        const bf16* qr = (const bf16*)(ws + WS_Q) + (size_t)(MP + db * 8 + t) * DQKV + (G * 4 + hh) * 128 + c4;
        const u32x2 q0 = *(const u32x2*)qr, q1 = *(const u32x2*)(qr + 64);
        qp[ts] = (v4u){q0.x, q0.y, q1.x, q1.y};
        m[ts] = -INFINITY; l[ts] = 0.f;
#pragma unroll
        for (int e = 0; e < 8; ++e) o[ts][e] = 0.f;
    }
    const bool lastp = (G == 2 && COPY == 2) ? (p + 1 == NPART - 1) : (p == NPART - 1);
    f32x4 kvA[RB][4], kvB[RB][4];
    stream_load<G, RB, COPY>(kvA, cache, okv, 0, wave, p, lane, lastp);
#pragma unroll 1
    for (int bi = 0; bi < NB; bi += 2) {
        if (bi + 1 < NB) stream_load<G, RB, COPY>(kvB, cache, okv, bi + 1, wave, p, lane, lastp);
        stream_proc<G, RB, NT, COPY>(kvA, okv, bi, wave, p, lane, lastp, qp, m, l, o, bt);
        if (bi + 2 < NB) stream_load<G, RB, COPY>(kvA, cache, okv, bi + 2, wave, p, lane, lastp);
        if (bi + 1 < NB) stream_proc<G, RB, NT, COPY>(kvB, okv, bi + 1, wave, p, lane, lastp, qp, m, l, o, bt);
    }
    LAS float* LO = (LAS float*)(F.lds);
    LAS float* LM = (LAS float*)(F.lds + SCR_OFF);
    LAS float* LL = LM + 8 * NC * 4;
#pragma unroll
    for (int ts = 0; ts < NT; ++ts) {
        const int t = (G == 0) ? ts : (G == 1 ? (wave & 3) + 4 * ts : wave), c = (G == 0) ? wave : (G == 1 ? (wave >> 2) : 0);
        *(LAS f32x4*)(LO + (t * NC + c) * 512 + hh * 128 + c4) = (f32x4){o[ts][0], o[ts][1], o[ts][2], o[ts][3]};
        *(LAS f32x4*)(LO + (t * NC + c) * 512 + hh * 128 + 64 + c4) = (f32x4){o[ts][4], o[ts][5], o[ts][6], o[ts][7]};
        if ((lane & 15) == 0) { LM[(t * NC + c) * 4 + hh] = m[ts]; LL[(t * NC + c) * 4 + hh] = l[ts]; }
    }
    __syncthreads();
    {
        const int h2 = tid >> 7, d = tid & 127, slot = (G == 0) ? 0 : (G == 1 ? 1 + p : 5 + p);
        float* PART = (float*)(ws + WS_PART);
#pragma unroll 1
        for (int t = 0; t < 8; ++t) {
            float M = -INFINITY;
#pragma unroll
            for (int c = 0; c < NC; ++c) M = fmaxf(M, LM[(t * NC + c) * 4 + h2]);
            float Ls = 0.f, os = 0.f;
            if (M > -INFINITY) {
#pragma unroll
                for (int c = 0; c < NC; ++c) { const float f = __builtin_amdgcn_exp2f(LM[(t * NC + c) * 4 + h2] - M); Ls += LL[(t * NC + c) * 4 + h2] * f; os += LO[(t * NC + c) * 512 + tid] * f; }
            }
            float* pp = PART + ((size_t)((db * 8 + t) * 4 + h2) * PSLOTS + slot) * PSTRIDE;
            pg8::st_wt4((unsigned*)(pp + d), __float_as_uint(os));
            if (d == 0) { pg8::st_wt4((unsigned*)(pp + 128), __float_as_uint(M)); pg8::st_wt4((unsigned*)(pp + 129), __float_as_uint(Ls)); }
            if (G == 2 && COPY == 2) { pg8::st_wt4((unsigned*)(pp + PSTRIDE + d), 0u); if (d == 0) { pg8::st_wt4((unsigned*)(pp + PSTRIDE + 128), __float_as_uint(-INFINITY)); pg8::st_wt4((unsigned*)(pp + PSTRIDE + 129), 0u); } }
        }
    }
    __syncthreads();
}
__device__ __forceinline__ void merge_unit(const Frame& F, const Args& A, int r) {
    unsigned char* ws = A.ws;
    const int h2 = F.tid >> 7, d = F.tid & 127;
    const float* pp = (const float*)(ws + WS_PART) + (size_t)(r * 4 + h2) * PSLOTS * PSTRIDE;
    float ms[PSLOTS], M = -INFINITY;
#pragma unroll
    for (int s2 = 0; s2 < PSLOTS; ++s2) { ms[s2] = pp[s2 * PSTRIDE + 128]; M = fmaxf(M, ms[s2]); }
    float Ls = 0.f, os = 0.f;
#pragma unroll
    for (int s2 = 0; s2 < PSLOTS; ++s2) { const float f = __builtin_amdgcn_exp2f(ms[s2] - M); Ls += pp[s2 * PSTRIDE + 129] * f; os += pp[s2 * PSTRIDE + d] * f; }
    const size_t o2 = (size_t)(MP + r) * DAO + F.tid;
    const float sg = pg8::silu_f(__uint_as_float((unsigned)((const bf16*)(ws + WS_SGB))[o2] << 16));
    pg8::st_wt2((unsigned short*)(ws + WS_ACAT) + (size_t)(MP + r) * KCAT + 1024 + F.tid, cvtpk(os / Ls * sg, 0.f) & 0xffffu);
}

template <int MODE>
__device__ __forceinline__ void skinny_unit(const Frame& F, const Args& A, int unit) {
    typedef float f32x16 __attribute__((ext_vector_type(16)));
    unsigned char* ws = A.ws;
    const int rb = unit >> 5, cb = unit & 31, row0 = MP + 32 * rb, col0 = 32 * cb;
    int tid = F.tid; asm volatile("" : "+v"(tid));
    const int lane = tid & 63, wave = F.wave, r = lane & 31, h = lane >> 5;
    LAS float* RED = (LAS float*)(F.lds);
    const int idx = 2 * tid, orow = idx >> 5, ocol = idx & 31;
    const size_t grow = (size_t)(row0 + orow);
    unsigned gr = 0, g2 = 0; f32x2 xres = (f32x2){0.f, 0.f};
    if (MODE == 0) { const bf16* GM = (const bf16*)(ws + WS_GM); gr = *(const unsigned*)(GM + grow * 2048 + col0 + ocol); g2 = *(const unsigned*)(GM + grow * 2048 + 1024 + col0 + ocol); }
    else xres = *(const f32x2*)(A.in[1] + (grow - MP) * 1024 + col0 + ocol);
    const bf16* Ap = (MODE == 0 ? (const bf16*)(ws + WS_ACAT) + (size_t)(row0 + r) * KCAT : (const bf16*)(ws + WS_MG) + (size_t)(row0 + r) * 1024) + 128 * wave + 8 * h;
    const bf16* Wp = (MODE == 0 ? (const bf16*)(ws + WS_WCAT) + (size_t)(col0 + r) * KCAT : (const bf16*)(ws + WS_WOUT) + (size_t)(col0 + r) * 1024) + 128 * wave + 8 * h;
    bf16x8 a[8], b[8], a2[4], b2[4];
#pragma unroll
    for (int s2 = 0; s2 < 8; ++s2) { a[s2] = *(const bf16x8*)(Ap + 16 * s2); b[s2] = *(const bf16x8*)(Wp + 16 * s2); }
    if (MODE == 0) {
        const bf16* Ap2 = (const bf16*)(ws + WS_ACAT) + (size_t)(row0 + r) * KCAT + 1024 + 64 * wave + 8 * h;
        const bf16* Wp2 = (const bf16*)(ws + WS_WCAT) + (size_t)(col0 + r) * KCAT + 1024 + 64 * wave + 8 * h;
#pragma unroll
        for (int s2 = 0; s2 < 4; ++s2) { a2[s2] = *(const bf16x8*)(Ap2 + 16 * s2); b2[s2] = *(const bf16x8*)(Wp2 + 16 * s2); }
    }
    f32x16 acc1, acc2;
#pragma unroll
    for (int e = 0; e < 16; ++e) { acc1[e] = 0.f; acc2[e] = 0.f; }
#pragma unroll
    for (int s2 = 0; s2 < 8; ++s2) acc1 = __builtin_amdgcn_mfma_f32_32x32x16_bf16(a[s2], b[s2], acc1, 0, 0, 0);
    if (MODE == 0) {
#pragma unroll
        for (int s2 = 0; s2 < 4; ++s2) acc2 = __builtin_amdgcn_mfma_f32_32x32x16_bf16(a2[s2], b2[s2], acc2, 0, 0, 0);
    }
#pragma unroll
    for (int e = 0; e < 16; ++e) { const int row = (e & 3) + 8 * (e >> 2) + 4 * h;
        RED[(wave * 2 + 0) * 1024 + row * 32 + r] = acc1[e];
        if (MODE == 0) RED[(wave * 2 + 1) * 1024 + row * 32 + r] = acc2[e]; }
    __syncthreads();
    {
        f32x2 ya = (f32x2){0.f, 0.f}, yb = ya;
#pragma unroll
        for (int w = 0; w < 8; ++w) { ya += *(const LAS f32x2*)(RED + (w * 2 + 0) * 1024 + idx); if (MODE == 0) yb += *(const LAS f32x2*)(RED + (w * 2 + 1) * 1024 + idx); }
        if (MODE == 0) pg8::st_wt4((unsigned*)((bf16*)(ws + WS_MG) + grow * 1024 + col0 + ocol), cvtpk(bflo(g2) * (bflo(gr) * ya[0] + yb[0]), bfhi(g2) * (bfhi(gr) * ya[1] + yb[1])));
        else *(f32x2*)(A.out + grow * 1024 + col0 + ocol) = xres + ya;
    }
    __syncthreads();
}

__device__ __forceinline__ void a1_item(const Frame& F, const Args& A, int cidx) {
    unsigned char* ws = A.ws;
    const bf16* HL = (const bf16*)(ws + WS_HL); const bf16* PP = (const bf16*)(ws + WS_PP); const bf16* SGA = (const bf16*)(ws + WS_SGA); bf16* A1 = (bf16*)(ws + WS_A1);
    const float* PEND = (const float*)(ws + WS_PEND); const float* HEND = (const float*)(ws + WS_HEND);
    const bool prompt = cidx < 128; const int b = cidx >> 4, c = cidx & 15;
    const int m0 = prompt ? b * 2048 + c * 128 : MP + (cidx - 128) * 128;
    const int ch0 = 4 * (F.tid & 255), half = F.tid >> 8;
    f32x4 H = (f32x4){0.f, 0.f, 0.f, 0.f};
    if (prompt) {
        for (int cc = 0; cc < c; ++cc) { const f32x4 p = *(const f32x4*)(PEND + (b * 16 + cc) * 1024 + ch0), hh = *(const f32x4*)(HEND + (b * 16 + cc) * 1024 + ch0); H = p * H + hh; }
        if (c == 15 && half == 0) { const f32x4 p = *(const f32x4*)(PEND + cidx * 1024 + ch0), hh = *(const f32x4*)(HEND + cidx * 1024 + ch0); *(f32x4*)(A.out + O_HP + b * 1024 + ch0) = p * H + hh; }
    }
#pragma unroll 4
    for (int i = 0; i < 64; ++i) {
        const size_t off = (size_t)(m0 + half * 64 + i) * 1024 + ch0;
        const u32x2 hl = *(const u32x2*)(HL + off), pp = *(const u32x2*)(PP + off), sg = *(const u32x2*)(SGA + off);
        const float h0 = (bflo(hl.x) + bflo(pp.x) * H[0]) * silu_lo(sg.x), h1 = (bfhi(hl.x) + bfhi(pp.x) * H[1]) * silu_hi(sg.x);
        const float h2 = (bflo(hl.y) + bflo(pp.y) * H[2]) * silu_lo(sg.y), h3 = (bfhi(hl.y) + bfhi(pp.y) * H[3]) * silu_hi(sg.y);
        u32x2 w; w.x = cvtpk(h0, h1); w.y = cvtpk(h2, h3);
        *(u32x2*)(A1 + off) = w;
    }
}
__device__ __forceinline__ void a2_item(const Frame& F, const Args& A, int it) {
    unsigned char* ws = A.ws;
    const bf16* Ob = (const bf16*)(ws + WS_O); const float* LSE = (const float*)(ws + WS_LSE); const bf16* SGB = (const bf16*)(ws + WS_SGB); bf16* A2 = (bf16*)(ws + WS_ACAT);
    const int tl = F.tid >> 6, k = F.tid & 63, hh = k >> 4, d0 = 8 * (k & 15);
    const pg8::wt_rsrc rsA = pg8::wt_make(A2, (unsigned)((size_t)MT * KCAT * 2));
#pragma unroll
    for (int i = 0; i < 8; ++i) {
        const size_t m = (size_t)it * 64 + i * 8 + tl;
        const int bb = (int)(m >> 11), tt = (int)(m & 2047);
        const float l0 = LSE[(size_t)(bb * NHEAD + hh) * 2048 + tt], l1 = LSE[(size_t)(bb * NHEAD + 4 + hh) * 2048 + (tt & 3) * 512 + (tt >> 2)], l2 = LSE[(size_t)(bb * NHEAD + 8 + hh) * 2048 + (tt & 15) * 128 + (tt >> 4)];
        const float mx = fmaxf(l0, fmaxf(l1, l2));
        float w0 = __builtin_amdgcn_exp2f((l0 - mx) * LOG2E), w1 = __builtin_amdgcn_exp2f((l1 - mx) * LOG2E), w2 = __builtin_amdgcn_exp2f((l2 - mx) * LOG2E);
        const float inv = 1.0f / (w0 + w1 + w2); w0 *= inv; w1 *= inv; w2 *= inv;
        const v4u o0 = __builtin_nontemporal_load((const v4u*)(Ob + m * DQKV + hh * 128 + d0)), o1 = __builtin_nontemporal_load((const v4u*)(Ob + m * DQKV + (4 + hh) * 128 + d0)), o2 = __builtin_nontemporal_load((const v4u*)(Ob + m * DQKV + (8 + hh) * 128 + d0));
        const v4u sg = __builtin_nontemporal_load((const v4u*)(SGB + m * DAO + hh * 128 + d0));
        v4u w;
        w.x = cvtpk((w0 * bflo(o0.x) + w1 * bflo(o1.x) + w2 * bflo(o2.x)) * silu_lo(sg.x), (w0 * bfhi(o0.x) + w1 * bfhi(o1.x) + w2 * bfhi(o2.x)) * silu_hi(sg.x));
        w.y = cvtpk((w0 * bflo(o0.y) + w1 * bflo(o1.y) + w2 * bflo(o2.y)) * silu_lo(sg.y), (w0 * bfhi(o0.y) + w1 * bfhi(o1.y) + w2 * bfhi(o2.y)) * silu_hi(sg.y));
        w.z = cvtpk((w0 * bflo(o0.z) + w1 * bflo(o1.z) + w2 * bflo(o2.z)) * silu_lo(sg.z), (w0 * bfhi(o0.z) + w1 * bfhi(o1.z) + w2 * bfhi(o2.z)) * silu_hi(sg.z));
        w.w = cvtpk((w0 * bflo(o0.w) + w1 * bflo(o1.w) + w2 * bflo(o2.w)) * silu_lo(sg.w), (w0 * bfhi(o0.w) + w1 * bfhi(o1.w) + w2 * bfhi(o2.w)) * silu_hi(sg.w));
        pg8::st_wt16(rsA, (unsigned)(m * KCAT + 1024 + hh * 128 + d0) * 2u, w);
    }
}

__device__ __forceinline__ void chain_signal(unsigned* c0, unsigned* c1) {
    asm volatile("s_waitcnt vmcnt(0)" ::: "memory");
    __syncthreads();
    if (threadIdx.x == 0) {
        (void)xb_add(c0, 1u); if (c1 != nullptr) (void)xb_add(c1, 1u);
    }
}
__device__ __forceinline__ void chain_signal_rel(unsigned* c0) {
    asm volatile("s_waitcnt vmcnt(0)" ::: "memory");
    __syncthreads();
    if (threadIdx.x == 0) {
        __builtin_amdgcn_fence(__ATOMIC_RELEASE, "agent");
        asm volatile("s_waitcnt vmcnt(0)" ::: "memory");
        (void)xb_add(c0, 1u);
    }
}
__device__ __forceinline__ void split_arrive(const XcdBarrier& b, unsigned* cx, unsigned* top) {
    asm volatile("s_waitcnt vmcnt(0)" ::: "memory");
    __syncthreads();
    if (threadIdx.x == 0) {
        unsigned nloc = b.st[0];
        if (nloc == 0u) { unsigned nx; xcd_barrier_complete(b.bar, b.x, nloc, nx); b.st[0] = nloc; b.st[1] = nx; }
        const unsigned old = xb_add(cx + 16 * b.x, 1u);
        if (old + 1u == nloc) {
            __builtin_amdgcn_fence(__ATOMIC_RELEASE, "agent");
            asm volatile("s_waitcnt vmcnt(0)" ::: "memory");
            (void)xb_add(top, 1u);
        }
    }
}
__device__ __forceinline__ void chain_wait(unsigned* c, unsigned target, unsigned* bar) {
    if (threadIdx.x == 0) {
        XB_SPIN(xb_ld(c) < target, bar);
        __builtin_amdgcn_fence(__ATOMIC_ACQUIRE, "agent");
        asm volatile("s_waitcnt vmcnt(0)" ::: "memory");
    }
    __syncthreads();
}
__device__ __forceinline__ pg8::EpiIn make_epi_in(const Frame& F, const Args& args) {
    unsigned char* ws = args.ws; pg8::EpiIn E;
    E.XA = (bf16*)(ws + WS_XA); E.SGA = (bf16*)(ws + WS_SGA); E.Q = (bf16*)(ws + WS_Q); E.Kb = (bf16*)(ws + WS_K); E.Vb = (bf16*)(ws + WS_V); E.SGB = (bf16*)(ws + WS_SGB); E.GM = (bf16*)(ws + WS_GM);
    E.out = args.out; E.b_merge = args.in[9]; E.g_q = args.in[17]; E.g_k = args.in[18]; E.scr = (LAS float*)(F.lds + EPI_OFF); E.qscale = QSCALE;
    E.o_kv128p = O_KV128P; E.o_kv512p = O_KV512P; E.o_kv2048p = O_KV2048P; E.o_convp = O_CONVP; E.o_kv128s = O_KV128S; E.o_kv512s = O_KV512S; E.o_kv2048s = O_KV2048S; E.o_convs = O_CONVS;
    return E;
}
constexpr int NPHASE = 7;
#ifndef P1_SP2
#define P1_SP2 true
#endif
#ifdef PROBE_EXTRA
#define MK_N_LAUNCHES 6
#endif
#ifndef MK_N_LAUNCHES
#define MK_N_LAUNCHES 1
#endif
__global__ void __launch_bounds__(NWAVES * 64, 2) mixer_fwd(Args args) {
    extern __shared__ __attribute__((aligned(16))) unsigned char lds[];
    Frame F;
    F.lds = (LAS unsigned char*)lds;
    F.tid = threadIdx.x; F.lane = F.tid & 63; F.wave = __builtin_amdgcn_readfirstlane(F.tid >> 6);
    F.G = gridDim.x; { const int bx = blockIdx.x; F.vcu = (F.G % 8 == 0) ? (bx % 8) * (F.G / 8) + bx / 8 : bx; }
    unsigned char* ws = args.ws;
    volatile LAS unsigned* MISC = (volatile LAS unsigned*)(F.lds + MISC_OFF);
    if (F.tid < 32) MISC[F.tid] = 0u;
    __syncthreads();
    XcdBarrier bar; bar.bar = (unsigned*)(ws + WS_CTL) + CW_BAR; bar.x = 0; bar.st = nullptr;
    if (MK_N_LAUNCHES == 1) bar = xcd_barrier_post((unsigned*)(ws + WS_CTL) + CW_BAR, MISC + 8);
    const int lo = args.ph_lo, hi = args.ph_hi;
#ifndef PROBE_REP
#define PROBE_REP 0
#endif
#define IN(k) (lo <= (k) && (k) < hi)
#define REP(k) for (int rep_ = 0; rep_ < 1 + ((PROBE_REP >> (k)) & 1); ++rep_, (rep_ < 1 + ((PROBE_REP >> (k)) & 1)) ? xcd_barrier(bar) : (void)0)
#ifdef PROBE_DBLBAR
#define SEAM(k) do { if (IN(k) && IN((k) + 1)) { xcd_barrier(bar); xcd_barrier(bar); } } while (0)
#else
#define SEAM(k) do { if (IN(k) && IN((k) + 1)) xcd_barrier(bar); } while (0)
#endif

    unsigned* const chain = (unsigned*)(ws + WS_CTL) + CW_CHAIN;
    const bool chain01 = MK_N_LAUNCHES == 1 && IN(0) && IN(1), chain12 = IN(0) && IN(1) && IN(2), chain23 = IN(0) && IN(2) && IN(3), chain24 = IN(0) && IN(2) && IN(4), chain34 = IN(3) && IN(4), chain45 = IN(4) && IN(5), chain56 = IN(5) && IN(6);
    if (IN(0)) REP(0) {
        p0_prologue<0>(F, args); if (chain01) split_arrive(bar, chain + CH_0AX, chain + CH_0A);
        p0_prologue<1>(F, args); if (chain01) split_arrive(bar, chain + CH_0BX, chain + CH_0B);
    }
    if (!chain01) SEAM(0);
    if (IN(1)) REP(1) {
        if (chain01) chain_wait(chain + CH_0A, bar.st[1], bar.bar);
#ifdef P1_STAGGER
        { const unsigned long long t0 = __builtin_amdgcn_s_memrealtime(), dl = (unsigned long long)(((blockIdx.x >> 3) & 3) * P1_STAGGER);
          while (__builtin_amdgcn_s_memrealtime() - t0 < dl) __builtin_amdgcn_s_sleep(8); }
#endif
        pg8::Gemm g{(const bf16*)(ws + WS_XN), (const bf16*)(ws + WS_WIN), MP, DIN, 1024}; pg8::TileOrder S; S.init(MP, DIN, F.G, (int)blockIdx.x); S.single = false;
        if (chain12) { S.arr_ui = 8; S.arr_cx = chain + CH_1AX; S.arr_top = chain + CH_1A; S.arr_x = bar.x; S.arr_st = bar.st; }
        S.park_src = args.in[4]; S.park_dst = args.out + O_KV2048S; S.park_lds = F.lds + SCR_OFF;
        const pg8::EpiIn E = make_epi_in(F, args);
        pg8::gemm_phase<pg8::EpiIn, pg8::TileOrder, true, P1_SP2>(F.lds + RING_OFF, g, S, E);
        { pg8::Unit lastu; if (S.next(8, lastu)) S.park_store(lastu); }
    }
    if (chain12) split_arrive(bar, chain + CH_1BX, chain + CH_1B); else SEAM(1);
    if (IN(2)) {
        if (chain01) chain_wait(chain + CH_0B, bar.st[1], bar.bar);
        if (chain12) chain_wait(chain + CH_1A, bar.st[1], bar.bar);
        if (args.sub & 2) lru_prompt_wg(F, args, (int)blockIdx.x);
        if (chain12) chain_wait(chain + CH_1B, bar.st[1], bar.bar);
        if (blockIdx.x < 36 && (args.sub & 4)) {
            pg8::Gemm g{(const bf16*)(ws + WS_XN), (const bf16*)(ws + WS_WIN), MT, DIN, 1024}; pg8::TileOrder S; S.init(MT, DIN, F.G, (int)blockIdx.x); S.single = true; S.spm = 64; S.spn = (int)blockIdx.x;
            const pg8::EpiIn E = make_epi_in(F, args);
            pg8::gemm_phase<pg8::EpiIn, pg8::TileOrder, true, true>(F.lds + RING_OFF, g, S, E);
            if (chain23) chain_signal_rel(chain + CH_S1);
        }
        if ((args.sub & 1) && blockIdx.x >= 36) attn_prompt_wg(F, args, (int)blockIdx.x - 36, (int)F.G - 36);
        if (chain24) split_arrive(bar, chain + CH_P2X, chain + CH_P2);
    }
    if (!chain23) SEAM(2);
    if (IN(3)) REP(3) {
        if (chain23) chain_wait(chain + CH_S1, 36u, bar.bar);
        unsigned* qctr = (unsigned*)(ws + WS_CTL) + CW_Q3 + 64 * args.qslot;
        if (F.tid == 0) MISC[16] = atomicAdd(qctr, 1u);
        __syncthreads();
        int cur = (int)MISC[16];
        while (cur < 416 + 16) {
            unsigned nxt = 0; if (F.tid == 0) nxt = atomicAdd(qctr, 1u);
            if (cur < 416) {
                if (args.sub & 2) {
                    if (cur < 32) stream_item<0, 1>(F, args, cur, 0);
                    else if (cur < 160) stream_item<1, 1>(F, args, (cur - 32) >> 2, (cur - 32) & 3);
                    else stream_item<2, 2>(F, args, (cur - 160) >> 3, 2 * ((cur - 160) & 7));
                }
            } else { if (args.sub & 4) lru_item(F, args, 1024 + (cur - 416), -1); }
            __syncthreads();
            if (F.tid == 0) MISC[16] = nxt;
            __syncthreads();
            cur = (int)MISC[16];
        }
        if (chain34) chain_signal(chain + CH_P3, nullptr);
    }
    pg8::Unit u56; { pg8::TileOrder S; S.init(MP, 1024, F.G, (int)blockIdx.x); S.single = false; if (!S.next(0, u56)) { u56.pm = 0; u56.pn = 0; } }
    if (IN(4)) REP(4) {
        for (int it = blockIdx.x; it < 256; it += F.G) {
            if (chain24) chain_wait(chain + CH_P2, bar.st[1], bar.bar);
            const int ia = (F.G == 256) ? 4 * u56.pm + u56.pn : it;
            a2_item(F, args, ia);
            if (chain45) chain_signal(chain + CH_A2 + 16 * (ia >> 2), nullptr);
            if (chain34) chain_wait(chain + CH_P3, F.G, bar.bar);
            merge_unit(F, args, it);
            if (chain45) chain_signal(chain + CH_M + 16 * (it >> 5), nullptr);
        }
    }
    if (IN(5)) REP(5) {
        if (chain45) chain_wait(chain + CH_A2 + 16 * u56.pm, 4u, bar.bar);
        {
          pg8::Gemm g{(const bf16*)(ws + WS_ACAT), (const bf16*)(ws + WS_WCAT), MP, 1024, KCAT}; pg8::TileOrder S; S.init(MP, 1024, F.G, (int)blockIdx.x); S.single = false;
          pg8::EpiMerge E{(const bf16*)(ws + WS_GM), (bf16*)(ws + WS_MG)};
          pg8::gemm_phase<pg8::EpiMerge, pg8::TileOrder, true, true>(F.lds + RING_OFF, g, S, E);
        }
        for (int u = blockIdx.x; u < 256; u += F.G) { if (chain45) chain_wait(chain + CH_M + 16 * (u >> 5), 32u, bar.bar); skinny_unit<0>(F, args, u); if (chain56) chain_signal(chain + CH_5 + 16 * u56.pm, chain + CH_S + 16 * (u >> 5)); }
    }
    if (IN(6)) REP(6) {
        pg8::Gemm g{(const bf16*)(ws + WS_MG), (const bf16*)(ws + WS_WOUT), MP, 1024, 1024}; pg8::TileOrder S; S.init(MP, 1024, F.G, (int)blockIdx.x); S.single = false;
        if (chain56) { S.rdy = chain + CH_5 + 16 * u56.pm; S.rdy_target = 4u; S.rdy_tmo = bar.bar + XB_TMO; }
        pg8::EpiOut E{args.in[0], args.in[1], args.out};
        pg8::gemm_phase<pg8::EpiOut, pg8::TileOrder, true, true>(F.lds + RING_OFF, g, S, E);
        for (int u = blockIdx.x; u < 256; u += F.G) { if (chain56) chain_wait(chain + CH_S + 16 * (u >> 5), 32u, bar.bar); skinny_unit<1>(F, args, u); }
    }
#undef IN
#undef SEAM
}

extern "C" void kernel_launch(void* const* d_in, const int* in_sizes, int n_in, void* d_out, int out_size, void* d_ws, size_t ws_size, hipStream_t stream) {
    static int grid = 0;
    if (grid == 0) {
        if (n_in != 23 || (size_t)out_size != O_END || ws_size < WS_END) { fprintf(stderr, "kernel_launch: unexpected shapes: n_in %d out %d (want %zu) ws %zu (want >= %zu)\n", n_in, out_size, (size_t)O_END, ws_size, (size_t)WS_END); grid = -1; return; }
        int dev = 0, cus = 0;
        if (hipGetDevice(&dev) != hipSuccess || hipDeviceGetAttribute(&cus, hipDeviceAttributeMultiprocessorCount, dev) != hipSuccess) { grid = -1; return; }
        if (hipFuncSetAttribute((const void*)mixer_fwd, hipFuncAttributeMaxDynamicSharedMemorySize, LDS_BYTES) != hipSuccess) { fprintf(stderr, "kernel_launch: hipFuncSetAttribute failed\n"); grid = -1; return; }
        (void)hipGetLastError();
        if (cus != 256) { fprintf(stderr, "kernel_launch: built for a 256-CU device (one workgroup per CU), found %d CUs; nothing launched\n", cus); grid = -1; return; }
        grid = cus;
    }
    if (grid < 0) return;
    if (hipMemsetAsync((char*)d_ws + WS_CTL, 0, CTL_ZERO_BYTES, stream) != hipSuccess) return;
    Args a{};
    for (int i = 0; i < 23; ++i) a.in[i] = (const float*)d_in[i];
    a.out = (float*)d_out; a.ws = (unsigned char*)d_ws;
#ifdef PROBE_EXTRA
#ifndef PROBE_SUB
#define PROBE_SUB 7
#endif
    for (int p = 0; p < NPHASE; ++p) for (int k = 0; k < 1 + (p == PROBE_EXTRA ? 1 : 0); ++k) { a.ph_lo = p; a.ph_hi = p + 1; a.qslot = k; a.sub = k ? PROBE_SUB : 7; hipLaunchKernelGGL(mixer_fwd, dim3(grid), dim3(NWAVES * 64), LDS_BYTES, stream, a); }
#else
    a.sub = 7;
    if (MK_N_LAUNCHES == 1) { a.ph_lo = 0; a.ph_hi = NPHASE; hipLaunchKernelGGL(mixer_fwd, dim3(grid), dim3(NWAVES * 64), LDS_BYTES, stream, a); }
    else for (int p = 0; p < NPHASE; ++p) { a.ph_lo = p; a.ph_hi = p + 1; hipLaunchKernelGGL(mixer_fwd, dim3(grid), dim3(NWAVES * 64), LDS_BYTES, stream, a); }
#endif
}
```
